# Optimizing an MI355X kernel written in HIP

```python
import jax, jax.numpy as jnp
from jax import lax
import numpy as np

D_MODEL = 1024
BATCH = 16
SEQ = 2048
DEPTH = 2

CHUNK = 64
Q_BLOCK = 128
NORM_EPS = 1e-6
MASK_VALUE = -1e30
TINY = 1e-30

MIX_WIDTH = D_MODEL
HGRN_HEADS = 4
HGRN_WIDTH = MIX_WIDTH // 4
HGRN_KEY_DIM = HGRN_WIDTH // HGRN_HEADS
HGRN_VAL_DIM = HGRN_WIDTH // HGRN_HEADS
POOL_WINDOWS = (2, 4, 8, 16)
POOL_GROUPS = len(POOL_WINDOWS)
POOL_WIDTH = MIX_WIDTH // 4
POOL_GROUP_DIM = POOL_WIDTH // POOL_GROUPS
FOX_HEADS = 8
FOX_WIDTH = MIX_WIDTH // 2
FOX_HEAD_DIM = FOX_WIDTH // FOX_HEADS

IN_WIDTHS = (HGRN_WIDTH, HGRN_WIDTH, HGRN_WIDTH, HGRN_WIDTH,
             POOL_WIDTH, POOL_WIDTH,
             FOX_WIDTH, FOX_WIDTH, FOX_WIDTH, FOX_WIDTH, FOX_HEADS)
IN_WIDTH = int(sum(IN_WIDTHS))
IN_SPLIT_POINTS = tuple(int(v) for v in np.cumsum(IN_WIDTHS)[:-1])

kernel_name = "hybrid_hgrn2_pool_fox_stream_encoder"


def _rmsnorm(x, g):
    xf = x.astype(jnp.float32)
    y = xf * lax.rsqrt(jnp.mean(xf * xf, axis=-1, keepdims=True) + NORM_EPS)
    return (y * g.astype(jnp.float32)).astype(x.dtype)


def _hgrn2_chunkwise(q, k, v, log_f):
    B, T, H, dk = q.shape
    dv = v.shape[-1]
    n = T // CHUNK

    def to_chunks(a):
        return a.astype(jnp.float32).reshape(B, n, CHUNK, H, a.shape[-1]).transpose(1, 0, 3, 2, 4)

    qc, kc, vc, gc = to_chunks(q), to_chunks(k), to_chunks(v), to_chunks(log_f)
    pos = jnp.arange(CHUNK)
    causal = (pos[:, None] >= pos[None, :])[:, :, None]
    causal_f = causal.astype(jnp.float32)

    def step(S, inp):
        qi, ki, vi, gi = inp
        b = jnp.cumsum(gi, axis=2)
        diff = b[:, :, :, None, :] - b[:, :, None, :, :]
        decay = jnp.exp(jnp.where(causal, diff, 0.0)) * causal_f
        attn = jnp.einsum('bhtd,bhsd,bhtsd->bhts', qi, ki, decay)
        o = (jnp.einsum('bhts,bhsv->bhtv', attn, vi)
             + jnp.einsum('bhtd,bhdv->bhtv', qi * jnp.exp(b), S))
        b_last = b[:, :, -1, :]
        S = (jnp.exp(b_last)[..., None] * S
             + jnp.einsum('bhsd,bhsv->bhdv', ki * jnp.exp(b_last[:, :, None, :] - b), vi))
        return S, o

    S0 = jnp.zeros((B, H, dk, dv), jnp.float32)
    _, o = lax.scan(step, S0, (qc, kc, vc, gc))
    return o.transpose(1, 0, 3, 2, 4).reshape(B, T, H, dv)


def _multiscale_pool(u):
    B, T, _ = u.shape
    uf = u.astype(jnp.float32).reshape(B, T, POOL_GROUPS, POOL_GROUP_DIM)
    cs = jnp.pad(jnp.cumsum(uf, axis=1), ((0, 0), (1, 0), (0, 0), (0, 0)))
    t = jnp.arange(T, dtype=jnp.float32)
    outs = []
    for g, w in enumerate(POOL_WINDOWS):
        c = cs[:, :, g]
        upper = c[:, 1:]
        lower = jnp.pad(c[:, :T + 1 - w], ((0, 0), (w - 1, 0), (0, 0)))
        count = jnp.minimum(t + 1.0, float(w))[None, :, None]
        outs.append((upper - lower) / count - uf[:, :, g])
    return jnp.stack(outs, axis=2)


def _forgetting_attention(q, k, v, log_f):
    B, T, H, D = q.shape
    c = jnp.cumsum(log_f, axis=1).transpose(0, 2, 1)
    scale = D ** -0.5
    outs = []
    for i in range(T // Q_BLOCK):
        q0, q1 = i * Q_BLOCK, (i + 1) * Q_BLOCK
        s = jnp.einsum('bqhd,bkhd->bhqk', q[:, q0:q1], k[:, :q1]).astype(jnp.float32) * scale
        mask = (q0 + jnp.arange(Q_BLOCK))[:, None] >= jnp.arange(q1)[None, :]
        bias = jnp.where(mask, c[:, :, q0:q1, None] - c[:, :, None, :q1], 0.0)
        p = jax.nn.softmax(jnp.where(mask, s + bias, MASK_VALUE), axis=-1)
        outs.append(jnp.einsum('bhqk,bkhd->bqhd', p.astype(v.dtype), v[:, :q1]))
    return jnp.concatenate(outs, axis=1)


def setup_inputs(seed: int = 0) -> dict:
    key = jax.random.key(seed)
    ks = jax.random.split(key, 11)
    f32 = jnp.float32
    x = jax.random.normal(ks[0], (BATCH, SEQ, D_MODEL), f32)
    lower_bounds = jax.random.normal(ks[1], (DEPTH, HGRN_WIDTH), f32)
    pre_norm_g = 1.0 + 0.05 * jax.random.normal(ks[2], (DEPTH, D_MODEL), f32)
    w_in = jax.random.normal(ks[3], (DEPTH, D_MODEL, IN_WIDTH), f32) * D_MODEL ** -0.5
    hgrn_norm_g = 1.0 + 0.05 * jax.random.normal(ks[4], (DEPTH, HGRN_WIDTH), f32)
    fox_f_bias = jax.random.uniform(ks[5], (DEPTH, FOX_HEADS), f32, minval=1.0, maxval=4.0)
    pool_w = jax.random.normal(ks[6], (DEPTH, POOL_GROUPS, POOL_GROUP_DIM, POOL_GROUP_DIM), f32) * POOL_GROUP_DIM ** -0.5
    pool_scale = jax.random.uniform(ks[7], (DEPTH, POOL_WIDTH), f32, minval=0.5, maxval=1.5)
    w_out = jax.random.normal(ks[8], (DEPTH, MIX_WIDTH, D_MODEL), f32) * MIX_WIDTH ** -0.5
    post_norm_g = 1.0 + 0.05 * jax.random.normal(ks[9], (DEPTH, D_MODEL), f32)
    return {"x": x, "lower_bounds": lower_bounds, "pre_norm_g": pre_norm_g, "w_in": w_in,
            "hgrn_norm_g": hgrn_norm_g, "fox_f_bias": fox_f_bias, "pool_w": pool_w,
            "pool_scale": pool_scale, "w_out": w_out, "post_norm_g": post_norm_g}


def reference(x, lower_bounds, pre_norm_g, w_in, hgrn_norm_g, fox_f_bias, pool_w, pool_scale, w_out, post_norm_g):
    B, T, _ = x.shape
    p = jax.nn.softmax(lower_bounds.astype(jnp.float32), axis=0)
    lbs = jnp.cumsum(p, axis=0) - p[0]
    for l in range(DEPTH):
        h = _rmsnorm(x, pre_norm_g[l])
        proj = jnp.einsum('btd,de->bte', h, w_in[l])
        q_a, f_a, i_a, g_a, u_b, g_b, q_c, k_c, v_c, g_c, f_c = jnp.split(proj, IN_SPLIT_POINTS, axis=-1)

        lb = lbs[l]
        z = f_a.astype(jnp.float32)
        f_gate = lb + (1.0 - lb) * jax.nn.sigmoid(z)
        log_f_a = jnp.log(jnp.maximum(f_gate, TINY))
        k_a = (1.0 - lb) * jax.nn.sigmoid(-z)
        hshape = (B, T, HGRN_HEADS, HGRN_KEY_DIM)
        o_a = _hgrn2_chunkwise(jax.nn.silu(q_a).reshape(hshape), k_a.reshape(hshape),
                               i_a.reshape(B, T, HGRN_HEADS, HGRN_VAL_DIM), log_f_a.reshape(hshape))
        o_a = _rmsnorm(o_a, hgrn_norm_g[l].reshape(HGRN_HEADS, HGRN_VAL_DIM)).reshape(B, T, HGRN_WIDTH)
        o_a = o_a.astype(x.dtype) * jax.nn.silu(g_a)

        pooled = _multiscale_pool(u_b)
        o_b = jnp.einsum('btgc,gcd->btgd', pooled, pool_w[l].astype(jnp.float32)).reshape(B, T, POOL_WIDTH)
        o_b = (o_b * pool_scale[l].astype(jnp.float32)).astype(x.dtype) * jax.nn.silu(g_b)

        log_f_c = jax.nn.log_sigmoid((f_c + fox_f_bias[l]).astype(jnp.float32))
        fshape = (B, T, FOX_HEADS, FOX_HEAD_DIM)
        o_c = _forgetting_attention(q_c.reshape(fshape), k_c.reshape(fshape), v_c.reshape(fshape), log_f_c)
        o_c = o_c.reshape(B, T, FOX_WIDTH).astype(x.dtype) * jax.nn.silu(g_c)

        mixed = jnp.concatenate([o_a, o_b, o_c], axis=-1)
        y = jnp.einsum('bte,ed->btd', mixed, w_out[l])
        x = x + _rmsnorm(y, post_norm_g[l])
    return x
```

```cpp
#include <hip/hip_runtime.h>
#include <cstdio>
#include <cstdint>
#include <cmath>
#include <hip/hip_bf16.h>

typedef unsigned short bf16;
constexpr int BATCH = 16, SEQ = 2048, DM = 1024, DEPTH = 2, M = BATCH * SEQ;
constexpr int NIN = 3592;
constexpr float NORM_EPS = 1e-6f, TINY = 1e-30f, LOG2E = 1.4426950408889634f;
constexpr float C2 = 0.125f * LOG2E;

constexpr size_t MiB = 1u << 20;
constexpr size_t WS_CTL = 0;
constexpr size_t WS_WIN = 1 * MiB;
constexpr size_t WS_WOUT = 17 * MiB;
constexpr size_t WS_SMALL = 21 * MiB;
constexpr size_t WS_WFC = WS_SMALL, WS_LBS = WS_SMALL + 65536, WS_PWT = WS_SMALL + 131072;
constexpr size_t WS_LFC = 22 * MiB;
constexpr size_t WS_CC = 23 * MiB;
constexpr size_t WS_XN = 24 * MiB;
constexpr size_t WS_ACT = 88 * MiB;
constexpr size_t WS_QA = WS_ACT, WS_LF = WS_QA + 16 * MiB, WS_IA = WS_LF + 32 * MiB, WS_GA = WS_IA + 16 * MiB, WS_UB = WS_GA + 16 * MiB, WS_GB = WS_UB + 16 * MiB;
constexpr size_t WS_QC = WS_GB + 16 * MiB, WS_KC = WS_QC + 32 * MiB, WS_VC = WS_KC + 32 * MiB, WS_GC = WS_VC + 32 * MiB;
constexpr size_t WS_Y = WS_ACT;
constexpr size_t WS_X1 = WS_ACT + 240 * MiB + 64 * MiB;
constexpr size_t WS_MIX = WS_ACT + 240 * MiB;
constexpr size_t WS_END = WS_MIX + 128 * MiB;

__device__ __forceinline__ float bf2f(bf16 v) { return __uint_as_float((unsigned)v << 16); }
__device__ __forceinline__ bf16 f2bf(float f) { unsigned u = __float_as_uint(f); return (bf16)((u + 0x7fffu + ((u >> 16) & 1u)) >> 16); }
__device__ __forceinline__ float sigmoidf_(float x) { return 1.f / (1.f + __expf(-x)); }
__device__ __forceinline__ float siluf_(float x) { return x * sigmoidf_(x); }
__device__ __forceinline__ float logsigmoidf_(float x) { return fminf(x, 0.f) - log1pf(__expf(-fabsf(x))); }
template <int CTRL> __device__ __forceinline__ float dpp_add(float v) { return v + __uint_as_float(__builtin_amdgcn_update_dpp(0u, __float_as_uint(v), CTRL, 0xf, 0xf, false)); }
__device__ __forceinline__ float wave_sum(float v) {
    v = dpp_add<0xB1>(v); v = dpp_add<0x4E>(v); v = dpp_add<0x124>(v); v = dpp_add<0x128>(v);
    { auto r = __builtin_amdgcn_permlane16_swap(__float_as_uint(v), __float_as_uint(v), false, false); v = __uint_as_float(r[0]) + __uint_as_float(r[1]); }
    { auto r = __builtin_amdgcn_permlane32_swap(__float_as_uint(v), __float_as_uint(v), false, false); v = __uint_as_float(r[0]) + __uint_as_float(r[1]); }
    return v;
}

#define GAS __attribute__((address_space(1)))
#define LAS __attribute__((address_space(3)))
typedef unsigned v4u __attribute__((ext_vector_type(4)));
typedef float f32x4 __attribute__((ext_vector_type(4)));
typedef short bf16x8 __attribute__((ext_vector_type(8)));
typedef GAS unsigned gu32;
typedef GAS unsigned long long gu64;
#define RLX_AGENT __ATOMIC_RELAXED, __HIP_MEMORY_SCOPE_AGENT
#define LDS_WAIT() asm volatile("s_waitcnt lgkmcnt(0)" ::: "memory")
#define VM_WAIT() asm volatile("s_waitcnt vmcnt(0)" ::: "memory")
__device__ __forceinline__ unsigned pk2(float lo, float hi) { return (unsigned)f2bf(lo) | ((unsigned)f2bf(hi) << 16); }
namespace pg8 {
#define PG8_LAS __attribute__((address_space(3)))
typedef unsigned short bf16_t;
typedef short bf16x8 __attribute__((ext_vector_type(8)));
typedef float f32x4 __attribute__((ext_vector_type(4)));
typedef unsigned u32x4 __attribute__((ext_vector_type(4)));
constexpr int BM = 256, BK = 64, HALF = 128, HTB = HALF * BK * 2  , STAGE_BYTES = 8 * HTB, NXCD = 8, WGM = 4;

__host__ __device__ __forceinline__ int lds_byte(int r, int c) { const int st = (r >> 4) * 2 + (c >> 5), rr = r & 15, cc = c & 31, ob = rr * 64 + cc * 2; return st * 1024 + (ob ^ (((ob >> 9) & 1) << 5)); }
__host__ __device__ __forceinline__ void stage_rc(int b, int& R, int& C) { const int st = b / 1024, sb = b % 1024, swz = sb ^ (((sb >> 9) & 1) << 5); R = (st >> 1) * 16 + swz / 64; C = (st & 1) * 32 + (swz % 64) / 2; }
__host__ __device__ __forceinline__ int perm32(int rho) { const int n = rho >> 4, i = rho & 15; return 8 * (i >> 2) + 4 * n + (i & 3); }

struct Unit { int pm, pn; };
struct Gemm { const bf16_t* A; const bf16_t* Bt; int M, N, K; };

struct StaticOrder {
    int nM, nN, nwg, G, c;
    __host__ __device__ void init(int M, int N, int G_, int c_) { nM = M / BM; nN = N / BM; nwg = nM * nN; G = G_; c = c_; }
    __host__ __device__ bool next(int i, Unit& u) const {
        const long L = (long)i * G + c; if (L >= nwg) return false;
        int wgid = (int)L; { const int q = nwg / NXCD, r = nwg % NXCD, xcd = wgid % NXCD, off = wgid / NXCD; wgid = (xcd < r ? xcd * (q + 1) : r * (q + 1) + (xcd - r) * q) + off; }
        const int nig = WGM * nN, gid = wgid / nig, fm = gid * WGM, gsz = (nM - fm) < WGM ? (nM - fm) : WGM;
        u.pm = fm + ((wgid % nig) % gsz); u.pn = (wgid % nig) / gsz; return true;
    }
    __device__ __forceinline__ void a_ready(const Unit&) const {}
    __device__ __forceinline__ void done(const Unit&) const {}
};

__device__ __forceinline__ unsigned cvt_pk_bf16(float lo, float hi) { unsigned r; asm volatile("v_cvt_pk_bf16_f32 %0, %1, %2" : "=v"(r) : "v"(lo), "v"(hi)); return r; }
typedef float f32x2 __attribute__((ext_vector_type(2)));
#ifndef LOGF
#define LOGF logf
#endif
typedef unsigned u32x4 __attribute__((ext_vector_type(4)));
__device__ __forceinline__ float silu_fast(float x) { return x * __builtin_amdgcn_rcpf(1.0f + __expf(-x)); }
struct EpiIn {
    static constexpr bool PERM = true, AFTER_DRAIN = false;
    unsigned char* ws; const float* lbs;
    unsigned* qm; unsigned* km;
    __device__ __forceinline__ void operator()(const f32x4 (&acc)[2][2][4][2], const Unit& u, int wr, int wc, int fr, int fq) const {
        const int pn = u.pn;
        size_t off; int ldc = 256, cb = 0, mode = 0;
        switch (pn) {
            case 0: off = WS_QA; mode = 1; break;
            case 1: off = WS_LF; mode = 3; break;
            case 2: off = WS_IA; break;
            case 3: off = WS_GA; mode = 1; break;
            case 4: off = WS_UB; break;
            case 5: off = WS_GB; mode = 1; break;
            case 6: case 7: off = WS_QC; ldc = 512; cb = (pn - 6) * 256; mode = 2; break;
            case 8: case 9: off = WS_KC; ldc = 512; cb = (pn - 8) * 256; break;
            case 10: case 11: off = WS_VC; ldc = 512; cb = (pn - 10) * 256; break;
            default: off = WS_GC; ldc = 512; cb = (pn - 12) * 256; mode = 1; break;
        }
        const int row0 = u.pm * BM + wr * 64 + fr, col0 = cb + wc * 32 + 8 * fq;
        if (mode == 3) {
            float* base = (float*)(ws + off);
            f32x4 lb[2][2];
#pragma unroll
            for (int bj = 0; bj < 2; ++bj)
#pragma unroll
                for (int n = 0; n < 2; ++n) lb[bj][n] = *(const f32x4*)(lbs + col0 + bj * HALF + 4 * n);
#pragma unroll
            for (int ai = 0; ai < 2; ++ai)
#pragma unroll
                for (int m = 0; m < 4; ++m) { float* rowp = base + (size_t)(row0 + ai * HALF + m * 16) * 256 + col0;
#pragma unroll
                    for (int bj = 0; bj < 2; ++bj)
#pragma unroll
                        for (int n = 0; n < 2; ++n) { const f32x4 z = acc[ai][bj][m][n]; f32x4 o;
#pragma unroll
                            for (int i = 0; i < 4; ++i) { const float sg = __builtin_amdgcn_rcpf(1.0f + __expf(-z[i])); const float f = lb[bj][n][i] + (1.0f - lb[bj][n][i]) * sg; o[i] = LOGF(fmaxf(f, TINY)); }
                            *(f32x4*)(rowp + bj * HALF + 4 * n) = o; } }
        } else {
            bf16_t* base = (bf16_t*)(ws + off); float nmax[2] = {0.f, 0.f};
#pragma unroll
            for (int ai = 0; ai < 2; ++ai)
#pragma unroll
                for (int m = 0; m < 4; ++m) { bf16_t* rowp = base + (size_t)(row0 + ai * HALF + m * 16) * ldc + col0;
#pragma unroll
                    for (int bj = 0; bj < 2; ++bj) { f32x4 v0 = acc[ai][bj][m][0], v1 = acc[ai][bj][m][1];
                        if (mode == 1) {
#pragma unroll
                            for (int i = 0; i < 4; ++i) { v0[i] = silu_fast(v0[i]); v1[i] = silu_fast(v1[i]); } }
                        else if (mode == 2) { v0 = v0 * C2; v1 = v1 * C2; }
                        u32x4 w; w.x = cvt_pk_bf16(v0[0], v0[1]); w.y = cvt_pk_bf16(v0[2], v0[3]); w.z = cvt_pk_bf16(v1[0], v1[1]); w.w = cvt_pk_bf16(v1[2], v1[3]);
                        *(u32x4*)(rowp + bj * HALF) = w;
                        if (pn >= 6 && pn <= 9) {
                            float sq = 0.f;
#pragma unroll
                            for (int i = 0; i < 4; ++i) { const float a = __uint_as_float(w[i] << 16), b = __uint_as_float(w[i] & 0xffff0000u); sq += a * a + b * b; }
                            sq += __shfl_xor(sq, 16); sq += __shfl_xor(sq, 32);
                            nmax[bj] = fmaxf(nmax[bj], sq); } } }
            if (pn >= 6 && pn <= 9) {
#pragma unroll
                for (int bj = 0; bj < 2; ++bj) { float v = nmax[bj];
                    v = fmaxf(v, __shfl_xor(v, 1)); v = fmaxf(v, __shfl_xor(v, 2)); v = fmaxf(v, __shfl_xor(v, 4)); v = fmaxf(v, __shfl_xor(v, 8));
                    if (fr == 0 && fq == 0) { const int h = (pn & 1) * 4 + 2 * bj + (wc >> 1), b = u.pm >> 3, qb = u.pm & 7;
                        unsigned* dst = pn < 8 ? qm + (b * 8 + h) * 8 + qb : km + b * 8 + h;
                        __hip_atomic_fetch_max(dst, __float_as_uint(v), __ATOMIC_RELAXED, __HIP_MEMORY_SCOPE_AGENT); } } }
        }
    }
};
struct EpiY {
    static constexpr bool PERM = true, AFTER_DRAIN = false;
    bf16_t* Y; int ldc;
    __device__ __forceinline__ void operator()(const f32x4 (&acc)[2][2][4][2], const Unit& u, int wr, int wc, int fr, int fq) const {
        const int row0 = u.pm * BM + wr * 64 + fr, col0 = u.pn * BM + wc * 32 + 8 * fq;
#pragma unroll
        for (int ai = 0; ai < 2; ++ai)
#pragma unroll
            for (int m = 0; m < 4; ++m) { bf16_t* rowp = Y + (size_t)(row0 + ai * HALF + m * 16) * ldc + col0;
#pragma unroll
                for (int bj = 0; bj < 2; ++bj) { const f32x4 v0 = acc[ai][bj][m][0], v1 = acc[ai][bj][m][1];
                    u32x4 w; w.x = cvt_pk_bf16(v0[0], v0[1]); w.y = cvt_pk_bf16(v0[2], v0[3]); w.z = cvt_pk_bf16(v1[0], v1[1]); w.w = cvt_pk_bf16(v1[2], v1[3]);
                    *(u32x4*)(rowp + bj * HALF) = w; } }
    }
};
template <class Epi, class Sched, bool ALIGN_EPI = false, bool SP2 = false>
__device__ __forceinline__ void gemm_phase(PG8_LAS unsigned char* lds, const Gemm g, const Sched& S, const Epi& E) {
    const int tid = threadIdx.x, wid = __builtin_amdgcn_readfirstlane(tid >> 6), lane = tid & 63, wr = wid >> 2, wc = wid & 3, fr = lane & 15, fq = lane >> 4;
    const int K = g.K, nt = K / BK;
    unsigned voffA[2], voffB[2];
#pragma unroll
    for (int i = 0; i < 2; ++i) { int R, C; stage_rc(tid * 16 + i * 8192, R, C); const int Rb = Epi::PERM ? ((R & ~31) + perm32(R & 31)) : R;
        voffA[i] = (unsigned)(R * K + C) * 2u; voffB[i] = (unsigned)(Rb * K + C) * 2u; }
    const size_t kstep = (size_t)(BK * 2);
    const size_t hstep = (size_t)HALF * K * 2;
    const size_t tstep = 2 * hstep;
    const unsigned ldsw = (unsigned)wid * 1024u;
    const int aoff = lds_byte(wr * 64 + fr, fq * 8), boff = lds_byte(wc * 32 + fr, fq * 8);
#define PG8_SA(b, h) (((b) * 2 + (h)) * HTB)
#define PG8_SB(b, h) ((4 + (b) * 2 + (h)) * HTB)
#define PG8_STAGE(bufoff, gbase, voff) do { _Pragma("unroll") for (int _i = 0; _i < 2; ++_i) \
        __builtin_amdgcn_global_load_lds((const unsigned*)((const char*)(gbase) + (voff)[_i]), (PG8_LAS unsigned*)(lds + (bufoff) + ldsw + _i * 8192), 16, 0, 0); } while (0)
#define PG8_LDA(dst, b, h) do { _Pragma("unroll") for (int m = 0; m < 4; ++m) _Pragma("unroll") for (int k = 0; k < 2; ++k) dst[m][k] = *(const PG8_LAS bf16x8*)(lds + PG8_SA(b, h) + aoff + m * 2048 + k * 1024); } while (0)
#define PG8_LDB(dst, b, h) do { _Pragma("unroll") for (int n = 0; n < 2; ++n) _Pragma("unroll") for (int k = 0; k < 2; ++k) dst[n][k] = *(const PG8_LAS bf16x8*)(lds + PG8_SB(b, h) + boff + n * 2048 + k * 1024); } while (0)
#define PG8_MMA(ai, bj, At, Bt) do { __builtin_amdgcn_s_setprio(1); _Pragma("unroll") for (int m = 0; m < 4; ++m) _Pragma("unroll") for (int n = 0; n < 2; ++n) _Pragma("unroll") for (int k = 0; k < 2; ++k) \
        acc[ai][bj][m][n] = __builtin_amdgcn_mfma_f32_16x16x32_bf16(Bt[n][k], At[m][k], acc[ai][bj][m][n], 0, 0, 0); __builtin_amdgcn_s_setprio(0); } while (0)
#define PG8_WAIT_V(n) asm volatile("s_waitcnt vmcnt(" #n ")" ::: "memory")
#define PG8_WAIT_L(n) asm volatile("s_waitcnt lgkmcnt(" #n ")" ::: "memory")
#define PG8_BAR __builtin_amdgcn_s_barrier()
#define PG8_SCHED __builtin_amdgcn_sched_barrier(0)
    Unit cur, nxt; int ui = 0;
    if (!S.next(0, cur)) return;
    f32x4 acc[2][2][4][2];
#pragma unroll
    for (int a = 0; a < 2; ++a)
#pragma unroll
        for (int b = 0; b < 2; ++b)
#pragma unroll
            for (int m = 0; m < 4; ++m)
#pragma unroll
                for (int n = 0; n < 2; ++n) acc[a][b][m][n] = (f32x4){0.f, 0.f, 0.f, 0.f};
    bf16x8 At[4][2], B0[2][2], B1[2][2];
    const char* cA = (const char*)g.A + (size_t)cur.pm * tstep; const char* cB = (const char*)g.Bt + (size_t)cur.pn * tstep;
    S.a_ready(cur);
    if constexpr (SP2) {
        PG8_STAGE(PG8_SB(0, 0), cB, voffB); PG8_STAGE(PG8_SB(0, 1), cB + hstep, voffB); PG8_STAGE(PG8_SA(0, 0), cA, voffA); PG8_STAGE(PG8_SA(0, 1), cA + hstep, voffA);
        if (wr == 1) PG8_BAR;
        PG8_WAIT_V(2); PG8_BAR;
        PG8_STAGE(PG8_SB(1, 0), cB + kstep, voffB); PG8_STAGE(PG8_SA(1, 0), cA + kstep, voffA); PG8_STAGE(PG8_SB(1, 1), cB + hstep + kstep, voffB);
        PG8_WAIT_V(6); PG8_BAR;
    } else {
        PG8_STAGE(PG8_SB(0, 0), cB, voffB); PG8_STAGE(PG8_SA(0, 0), cA, voffA); PG8_STAGE(PG8_SB(0, 1), cB + hstep, voffB); PG8_STAGE(PG8_SA(0, 1), cA + hstep, voffA);
        if (wr == 1) PG8_BAR;
        PG8_WAIT_V(4); PG8_BAR;
        PG8_STAGE(PG8_SB(1, 0), cB + kstep, voffB); PG8_STAGE(PG8_SA(1, 0), cA + kstep, voffA); PG8_STAGE(PG8_SB(1, 1), cB + hstep + kstep, voffB);
        PG8_WAIT_V(6); PG8_BAR;
    }
    for (;;) {
        const bool has_next = S.next(ui + 1, nxt);
        const char* nA = has_next ? (const char*)g.A + (size_t)nxt.pm * tstep : cA; const char* nB = has_next ? (const char*)g.Bt + (size_t)nxt.pn * tstep : cB;
        for (int t = 0; t < nt; t += 2) {
            const bool last = (t == nt - 2);
            const char* a1 = cA + (size_t)(t + 1) * kstep;
            const char* a2 = last ? nA : cA + (size_t)(t + 2) * kstep; const char* b2 = last ? nB : cB + (size_t)(t + 2) * kstep;
            const char* a3 = a2 + kstep; const char* b3 = b2 + kstep;
            if (last && has_next) S.a_ready(nxt);
            if constexpr (SP2) {
            PG8_LDB(B0, 0, 0); PG8_LDB(B1, 0, 1); PG8_SCHED; PG8_LDA(At, 0, 0); PG8_STAGE(PG8_SA(1, 1), a1 + hstep, voffA);
            PG8_WAIT_V(8); PG8_WAIT_L(0); PG8_BAR; PG8_MMA(0, 0, At, B0); PG8_MMA(0, 1, At, B1); PG8_BAR; PG8_SCHED;
            PG8_LDA(At, 0, 1); PG8_STAGE(PG8_SB(0, 0), b2, voffB); PG8_STAGE(PG8_SB(0, 1), b2 + hstep, voffB); PG8_STAGE(PG8_SA(0, 0), a2, voffA);
            PG8_WAIT_V(8); PG8_WAIT_L(0); PG8_BAR; PG8_MMA(1, 0, At, B0); PG8_MMA(1, 1, At, B1); PG8_BAR; PG8_SCHED;
            PG8_LDB(B0, 1, 0); PG8_LDB(B1, 1, 1); PG8_SCHED; PG8_LDA(At, 1, 0); PG8_STAGE(PG8_SA(0, 1), a2 + hstep, voffA);
            PG8_WAIT_V(8); PG8_WAIT_L(0); PG8_BAR; PG8_MMA(0, 0, At, B0); PG8_MMA(0, 1, At, B1); PG8_BAR; PG8_SCHED;
            PG8_LDA(At, 1, 1); PG8_STAGE(PG8_SB(1, 0), b3, voffB); PG8_STAGE(PG8_SB(1, 1), b3 + hstep, voffB); PG8_STAGE(PG8_SA(1, 0), a3, voffA);
            PG8_WAIT_V(8); PG8_WAIT_L(0); PG8_BAR; PG8_MMA(1, 0, At, B0); PG8_MMA(1, 1, At, B1); PG8_BAR; PG8_SCHED;
            } else {
            PG8_LDB(B0, 0, 0); PG8_SCHED; PG8_LDA(At, 0, 0); PG8_STAGE(PG8_SA(1, 1), a1 + hstep, voffA);
            PG8_WAIT_L(8); PG8_BAR; PG8_WAIT_L(0); PG8_MMA(0, 0, At, B0); PG8_BAR; PG8_SCHED;
            PG8_LDB(B1, 0, 1); PG8_STAGE(PG8_SB(0, 0), b2, voffB);
            PG8_BAR; PG8_WAIT_L(0); PG8_MMA(0, 1, At, B1); PG8_BAR;
            PG8_LDA(At, 0, 1); PG8_STAGE(PG8_SA(0, 0), a2, voffA);
            PG8_BAR; PG8_WAIT_L(0); PG8_MMA(1, 0, At, B0); PG8_BAR; PG8_SCHED;
            PG8_STAGE(PG8_SB(0, 1), b2 + hstep, voffB);
            PG8_WAIT_V(6); PG8_BAR; PG8_MMA(1, 1, At, B1); PG8_BAR;
            PG8_LDB(B0, 1, 0); PG8_SCHED; PG8_LDA(At, 1, 0); PG8_STAGE(PG8_SA(0, 1), a2 + hstep, voffA);
            PG8_WAIT_L(8); PG8_BAR; PG8_WAIT_L(0); PG8_MMA(0, 0, At, B0); PG8_BAR; PG8_SCHED;
            PG8_LDB(B1, 1, 1); PG8_STAGE(PG8_SB(1, 0), b3, voffB);
            PG8_BAR; PG8_WAIT_L(0); PG8_MMA(0, 1, At, B1); PG8_BAR;
            PG8_LDA(At, 1, 1); PG8_STAGE(PG8_SA(1, 0), a3, voffA);
            PG8_BAR; PG8_WAIT_L(0); PG8_MMA(1, 0, At, B0); PG8_BAR; PG8_SCHED;
            PG8_STAGE(PG8_SB(1, 1), b3 + hstep, voffB);
            PG8_WAIT_V(6); PG8_BAR; PG8_MMA(1, 1, At, B1); PG8_BAR;
            }
        }
        if constexpr (ALIGN_EPI) { if (wr == 0) PG8_BAR; }
        if constexpr (!Epi::AFTER_DRAIN) { E(acc, cur, wr, wc, fr, fq); S.done(cur); }
        if (!has_next) break;
#pragma unroll
        for (int a = 0; a < 2; ++a)
#pragma unroll
            for (int b = 0; b < 2; ++b)
#pragma unroll
                for (int m = 0; m < 4; ++m)
#pragma unroll
                    for (int n = 0; n < 2; ++n) acc[a][b][m][n] = (f32x4){0.f, 0.f, 0.f, 0.f};
        cur = nxt; cA = nA; cB = nB; ++ui;
        if constexpr (ALIGN_EPI) { if (wr == 1) PG8_BAR; }
    }
    PG8_WAIT_V(0);
    if constexpr (!ALIGN_EPI) { if (wr == 0) PG8_BAR; }
    PG8_BAR;
    if constexpr (Epi::AFTER_DRAIN) { E.fused(acc, cur, wr, wc, fr, fq, lds, wid, lane); S.done(cur); }
#undef PG8_SA
#undef PG8_SB
#undef PG8_STAGE
#undef PG8_LDA
#undef PG8_LDB
#undef PG8_MMA
#undef PG8_WAIT_V
#undef PG8_WAIT_L
#undef PG8_BAR
#undef PG8_SCHED
}
}
namespace attn_body {
using bf16=__hip_bfloat16;
using bf16x8=__attribute__((ext_vector_type(8)))short;
using s16x4=__attribute__((ext_vector_type(4)))short;
using f32x16=__attribute__((ext_vector_type(16)))float;
using u32x4=__attribute__((ext_vector_type(4)))unsigned;
constexpr int BATCH=16,NHEAD=8,SEQ=2048,D=64,DM=NHEAD*D;
constexpr int OPITCH=1024,OCOL=512;
constexpr int NW=8,QBLK=32,QB=QBLK*NW,KVBLK=64,NQB=SEQ/QB;
constexpr int ATTN_PITCH=DM, ATTN_UNIT_ROWS=QB;
__device__ __forceinline__ int crow(int r,int hi){return (r&3)+8*(r>>2)+4*hi;}
#define SBAR() __builtin_amdgcn_sched_barrier(0)
__device__ __forceinline__ void cmask(f32x16&p0,f32x16&p1,int jb,int qrel,int hi){
  const float NEG=-INFINITY; int kb=64*jb+4*hi; asm volatile("":"+v"(kb));
  #pragma unroll
  for(int r=0;r<16;++r){int kv=kb+(r&3)+8*(r>>2); if(kv>qrel)p0[r]=NEG; if(kv+32>qrel)p1[r]=NEG;}
}

constexpr int NSLOT=3, SLOTB=8192;
constexpr int LDS_K=0, LDS_V=NSLOT*SLOTB, LDS_WS=2*NSLOT*SLOTB, LDS_OST=LDS_WS+NW*64*4, LDS_KB=LDS_OST+NW*4096, LDS_BYTES=LDS_KB+SEQ*4;
constexpr float FLOOR=-2048.f, LOG2E_=1.4426950408889634f, ACP_T=24.f;
constexpr float C2=0.125f*1.4426950408889634f;
__device__ __forceinline__ void glds16(const void*gsrc,unsigned lds_dst){unsigned keep;
  asm volatile("s_mov_b32 %0, m0\n\ts_mov_b32 m0, %2\n\ts_nop 0\n\tglobal_load_lds_dwordx4 %1, off\n\ts_mov_b32 m0, %0":"=&s"(keep):"v"(gsrc),"s"(lds_dst):"memory");}
__device__ __forceinline__ void glds16s(const void*sbase,unsigned voff,unsigned lds_dst){unsigned keep;
  asm volatile("s_mov_b32 %0, m0\n\ts_mov_b32 m0, %3\n\ts_nop 0\n\tglobal_load_lds_dwordx4 %1, %2\n\ts_mov_b32 m0, %0":"=&s"(keep):"v"(voff),"s"(sbase),"s"(lds_dst):"memory");}
__device__ __forceinline__ float max3f(float a,float b,float c){float r;asm("v_max3_f32 %0, %1, %2, %3":"=v"(r):"v"(a),"v"(b),"v"(c));return r;}
__device__ __forceinline__ float max2f(float a,float b){float r;asm("v_max_f32_e32 %0, %1, %2":"=v"(r):"v"(a),"v"(b));return r;}
__device__ __forceinline__ float fadd_s(float a,float b){float r;asm("v_add_f32_e32 %0, %1, %2":"=v"(r):"v"(a),"v"(b));return r;}
__device__ __forceinline__ float fsub_s(float a,float b){float r;asm("v_sub_f32_e32 %0, %1, %2":"=v"(r):"v"(a),"v"(b));return r;}
typedef float f32x2_t __attribute__((ext_vector_type(2))); typedef float f32x4_t __attribute__((ext_vector_type(4))); typedef __bf16 bf16x2_t __attribute__((ext_vector_type(2)));
__device__ __forceinline__ unsigned cvtpk_s(float lo,float hi){f32x2_t v={lo,hi};bf16x2_t b=__builtin_convertvector(v,bf16x2_t);return __builtin_bit_cast(unsigned,b);}
#define WAIT_BAR(N) asm volatile("s_waitcnt vmcnt(" #N ") lgkmcnt(0)\n\ts_barrier":::"memory")

__device__ __forceinline__ void qkt(f32x16&p0,f32x16&p1,const char*Kslot,const bf16x8*qr,int r32,int hi){
  const char*kb=Kslot+hi*1024+r32*16;
  #pragma unroll
  for(int d0=0;d0<4;++d0){
    const bf16x8 b0=*reinterpret_cast<const bf16x8*>(kb+d0*2048);
    const bf16x8 b1=*reinterpret_cast<const bf16x8*>(kb+d0*2048+512);
    {p0=__builtin_amdgcn_mfma_f32_32x32x16_bf16(b0,qr[d0],p0,0,0,0);p1=__builtin_amdgcn_mfma_f32_32x32x16_bf16(b1,qr[d0],p1,0,0,0);}}
}
typedef __attribute__((address_space(3))) const char* lds_cptr;
typedef short v4i16_t __attribute__((ext_vector_type(4)));
__device__ __forceinline__ void kload8(bf16x8*kf,lds_cptr kp){
  kf[0]=*(const __attribute__((address_space(3))) bf16x8*)(kp);      kf[1]=*(const __attribute__((address_space(3))) bf16x8*)(kp+512);
  kf[2]=*(const __attribute__((address_space(3))) bf16x8*)(kp+2048); kf[3]=*(const __attribute__((address_space(3))) bf16x8*)(kp+2560);
  kf[4]=*(const __attribute__((address_space(3))) bf16x8*)(kp+4096); kf[5]=*(const __attribute__((address_space(3))) bf16x8*)(kp+4608);
  kf[6]=*(const __attribute__((address_space(3))) bf16x8*)(kp+6144); kf[7]=*(const __attribute__((address_space(3))) bf16x8*)(kp+6656);
}
__device__ __forceinline__ void kload2(bf16x8*kf,lds_cptr kp,int j){ kf[2*j]=*(const __attribute__((address_space(3))) bf16x8*)(kp+j*2048); kf[2*j+1]=*(const __attribute__((address_space(3))) bf16x8*)(kp+j*2048+512); }
__device__ __forceinline__ s16x4 vtr(lds_cptr p){ return __builtin_bit_cast(s16x4,__builtin_amdgcn_ds_read_tr16_b64_v4i16((__attribute__((address_space(3))) v4i16_t*)p)); }
__device__ __forceinline__ float rowmax(const f32x16&p0,const f32x16&p1){
  float a=max3f(p0[0],p0[1],p1[0]),b=max3f(p0[2],p0[3],p1[1]);a=max3f(a,p1[2],p1[3]);
  #pragma unroll
  for(int r=4;r<16;r+=4){a=max3f(a,p0[r],p0[r+1]);b=max3f(b,p0[r+2],p0[r+3]);a=max3f(a,p1[r],p1[r+1]);b=max3f(b,p1[r+2],p1[r+3]);}
  const float m=max2f(a,b);
  auto rr=__builtin_amdgcn_permlane32_swap(__float_as_uint(m),__float_as_uint(m),false,false);
  return max2f(__uint_as_float(rr[0]),__uint_as_float(rr[1]));
}
__device__ __forceinline__ void pv(f32x16*o,int vb,bf16x8 pa0,bf16x8 pa1,bf16x8 pa2,bf16x8 pa3){
  #pragma unroll
  for(int d0=0;d0<2;++d0){s16x4 lo[4],hi[4];
    #pragma unroll
    for(int ks=0;ks<4;++ks){
      asm volatile("ds_read_b64_tr_b16 %0,%1 offset:%c2":"=&v"(lo[ks]):"v"(vb),"i"(d0*4096+ks*1024):"memory");
      asm volatile("ds_read_b64_tr_b16 %0,%1 offset:%c2":"=&v"(hi[ks]):"v"(vb),"i"(d0*4096+ks*1024+512):"memory");}
    asm volatile("s_waitcnt lgkmcnt(0)":::"memory");SBAR();
    #define PK(k) (bf16x8){lo[k][0],lo[k][1],lo[k][2],lo[k][3],hi[k][0],hi[k][1],hi[k][2],hi[k][3]}
    o[d0]=__builtin_amdgcn_mfma_f32_32x32x16_bf16(pa0,PK(0),o[d0],0,0,0);
    o[d0]=__builtin_amdgcn_mfma_f32_32x32x16_bf16(pa1,PK(1),o[d0],0,0,0);
    o[d0]=__builtin_amdgcn_mfma_f32_32x32x16_bf16(pa2,PK(2),o[d0],0,0,0);
    o[d0]=__builtin_amdgcn_mfma_f32_32x32x16_bf16(pa3,PK(3),o[d0],0,0,0);
    #undef PK
  }
}

#ifndef ATTN_STORE16
#define ATTN_STORE16(p,v) (*(u32x4*)(p)=(v))
#endif
template<int THRL> __device__ __forceinline__ void attn_unit(int b,int h,int qb,const bf16*Q,const bf16*__restrict__ K,const bf16*__restrict__ V,const bf16*__restrict__ G,const float*__restrict__ CC,const float qm2,const float km2,bf16*O,char*shm){
  int tid_=threadIdx.x; asm volatile("":"+v"(tid_));
  const int tid=tid_,lane=tid&63,r32=lane&31,hi=lane>>5; const int wid=__builtin_amdgcn_readfirstlane(tid>>6);
  const long rowbase=(long)b*SEQ; const int q0=qb*QB;
  const bf16*Qw=Q+(rowbase+q0+wid*QBLK)*DM+h*D;
  const bf16*Kh=K+rowbase*DM+h*D,*Vh=V+rowbase*DM+h*D;
  const unsigned lds0=(unsigned)(uintptr_t)shm;
  float*wsf=(float*)(shm+LDS_WS)+wid*64;
  const unsigned kvoff=(unsigned)(lane*DM+wid*8)*2u, vvoff=(unsigned)((16*(wid&3)+(lane>>2))*DM+(wid>>2)*32+(lane&3)*8)*2u;
  const char*Khb=(const char*)Kh,*Vhb=(const char*)Vh;
  const unsigned kdst=lds0+LDS_K+wid*1024, vdst=lds0+LDS_V+wid*1024;
  #define DMA_K(t,slot) glds16s(Khb+(long)(NT-1-(t))*(KVBLK*DM*2),kvoff,(unsigned)__builtin_amdgcn_readfirstlane(kdst+(slot)))
  #define DMA_V(t,slot) glds16s(Vhb+(long)(NT-1-(t))*(KVBLK*DM*2),vvoff,(unsigned)__builtin_amdgcn_readfirstlane(vdst+(slot)))
  const char*Kbase=shm+LDS_K; bf16x8 kf[8];
  const lds_cptr shm3=(lds_cptr)shm; const lds_cptr kp0=shm3+LDS_K+hi*1024+r32*16; const lds_cptr vp0=shm3+LDS_V+((lane>>4)&1)*32+(lane&3)*8+(4*hi+((lane&15)>>2))*64;
  const int NT=(q0+QB)/KVBLK;
  DMA_K(0,0);DMA_V(0,0);DMA_K(1,SLOTB);
  int NTE=NT;
  { const float*cc=CC+(long)(b*NHEAD+h)*SEQ; const float cref=cc[q0]; float*kbw=(float*)(shm+LDS_KB);
    const float clast=cc[64*(lane<NT?lane:0)+63];
    float cv[4];
    #pragma unroll
    for(int i=0;i<4;++i){const int k=tid+i*NW*64; cv[i]=(k<q0+QB)?cc[k]:0.f;}
    const float QK=2.04f*sqrtf(qm2*km2); const float bound=-(ACP_T+2.f*QK);
    const bool sk=(lane<NT)&&((cref-clast)*LOG2E_<bound);
    const unsigned long long bal=__ballot(sk); const int j0=__builtin_ctzll(~bal);
    NTE=NT-j0; NTE+=NTE&1; if(NTE<4)NTE=4; NTE=__builtin_amdgcn_readfirstlane(NTE);
    #pragma unroll
    for(int i=0;i<4;++i){const int k=tid+i*NW*64; if(k<q0+QB)kbw[k]=(cref-cv[i])*LOG2E_;} }
  const lds_cptr kbp=(lds_cptr)shm+LDS_KB+hi*16;
  #define CINIT(C0,C1,tt) do{ const lds_cptr kq_=kbp+(NT-1-(tt))*256; const float nm_=-mhat; \
    _Pragma("unroll") for(int g_=0;g_<4;++g_){ const f32x4_t a_=*(const __attribute__((address_space(3))) f32x4_t*)(kq_+g_*32); const f32x4_t b_=*(const __attribute__((address_space(3))) f32x4_t*)(kq_+128+g_*32); \
      C0[4*g_]=a_[0]+nm_;C0[4*g_+1]=a_[1]+nm_;C0[4*g_+2]=a_[2]+nm_;C0[4*g_+3]=a_[3]+nm_; C1[4*g_]=b_[0]+nm_;C1[4*g_+1]=b_[1]+nm_;C1[4*g_+2]=b_[2]+nm_;C1[4*g_+3]=b_[3]+nm_; } }while(0)
  bf16x8 qr[4];
  #pragma unroll
  for(int d0=0;d0<4;++d0)qr[d0]=*reinterpret_cast<const bf16x8*>(&Qw[(long)r32*DM+d0*16+hi*8]);
  float mhat=0.f,l_reg=0.f;f32x16 o[2];o[0]=f32x16{};o[1]=f32x16{};
  float qkrow; { float n2=0.f;
    #pragma unroll
    for(int d0=0;d0<4;++d0){
      #pragma unroll
      for(int e=0;e<8;++e){const float x=__uint_as_float((unsigned)(unsigned short)qr[d0][e]<<16); n2+=x*x;} }
    auto rr=__builtin_amdgcn_permlane32_swap(__float_as_uint(n2),__float_as_uint(n2),false,false); n2=__uint_as_float(rr[0])+__uint_as_float(rr[1]);
    qkrow=1.02f*sqrtf(n2)*sqrtf(2.f*km2); }
  const int qrel=wid*QBLK+r32;
  #define CMASK(P0,P1,t) do{int jb_=3-(t); if(jb_>=0)cmask(P0,P1,jb_,qrel,hi);}while(0)
  bool resc=false;
  #define START(P0,P1) do{ const float rm=rowmax(P0,P1); resc=false; \
    { const float dl=__builtin_fmaxf(rm,FLOOR); mhat=fadd_s(mhat,dl); \
      _Pragma("unroll") for(int r=0;r<16;++r){P0[r]=fsub_s(P0[r],dl);P1[r]=fsub_s(P1[r],dl);} } \
    _Pragma("unroll") for(int r=0;r<16;++r)P0[r]=__builtin_amdgcn_exp2f(P0[r]); }while(0)
  #define RESC() do{ if(resc){ asm volatile("s_waitcnt lgkmcnt(0)":::"memory"); \
      _Pragma("unroll") for(int d_=0;d_<2;++d_) _Pragma("unroll") for(int r=0;r<16;++r)o[d_][r]*=wsf[crow(r,hi)]; } }while(0)
  f32x16 pA0,pA1,pB0,pB1;
  int sl_prev=0,sl_cur=0,sl_next=SLOTB;
  #define ROT() do{sl_prev=sl_cur;sl_cur=sl_next;sl_next=(sl_next==(NSLOT-1)*SLOTB)?0:sl_next+SLOTB;}while(0)
  DMA_K(2,2*SLOTB);
  WAIT_BAR(3);
  CINIT(pA0,pA1,0); qkt(pA0,pA1,Kbase,qr,r32,hi);asm volatile("s_nop 15\n\ts_nop 7":"+v"(pA0),"+v"(pA1));CMASK(pA0,pA1,0);
  START(pA0,pA1);
  _Pragma("unroll") for(int r=0;r<16;++r)pA1[r]=__builtin_amdgcn_exp2f(pA1[r]);
  WAIT_BAR(0);
  DMA_K(3,0);DMA_V(1,SLOTB);
  ROT();
  kload8(kf,kp0+sl_cur);
  WAIT_BAR(2);
  s16x4 vlo[8],vhi[8]; u32x4 pw0,pw1,pw2,pw3;
  #define PKW(P,B) cvtpk_s(P[B],P[B+1])
  #define PAF(k) __builtin_bit_cast(bf16x8,pw##k)
  #define VFR(i) (bf16x8){vlo[i][0],vlo[i][1],vlo[i][2],vlo[i][3],vhi[i][0],vhi[i][1],vhi[i][2],vhi[i][3]}
  #define PIN(x) asm volatile("":"+v"(x))
  #define MX3(a,b,c) __builtin_fmaxf(__builtin_fmaxf((a),(b)),(c))
  #define GAPA(MF,A0,A1,A2,A3,W0,W1,PW) do{ MF; sacc+=A0; sacc+=A1; sacc+=A2; sacc+=A3; PIN(sacc); W0; W1; PIN(PW); SBAR(); }while(0)
  #define EX(v) __builtin_amdgcn_exp2f(v)
  #define GAPB(MF,X,B) do{ MF; X[B]=EX(X[B]); X[B+1]=EX(X[B+1]); X[B+2]=EX(X[B+2]); X[B+3]=EX(X[B+3]); PIN(X); SBAR(); }while(0)
  #define VRD(i) do{ vlo[i]=vtr(vp_+(((i)>>2)*4096+((i)&3)*1024)); vhi[i]=vtr(vp_+(((i)>>2)*4096+((i)&3)*1024+512)); }while(0)
  #define KRD(G,j) do{ if(G){ kload2(kf,kp0+sl_next,j); SBAR(); } }while(0)
  #define STEP(C0,C1,P0,P1,t,GK,GV,GL) do{ SBAR(); \
    CINIT(C0,C1,t); SBAR(); \
    const lds_cptr vp_=vp0+sl_prev; \
    VRD(0); SBAR(); float sacc=(P0[0]+P0[1]); \
    GAPA(C0=__builtin_amdgcn_mfma_f32_32x32x16_bf16(kf[0],qr[0],C0,0,0,0), P0[2],P0[3],P0[4],P0[5],     pw0[0]=PKW(P0,0), pw0[1]=PKW(P0,2), pw0); \
    VRD(4); SBAR(); GAPA(C1=__builtin_amdgcn_mfma_f32_32x32x16_bf16(kf[1],qr[0],C1,0,0,0), P0[6],P0[7],P0[8],P0[9],     pw0[2]=PKW(P0,4), pw0[3]=PKW(P0,6), pw0); \
    VRD(1); SBAR(); GAPA(C0=__builtin_amdgcn_mfma_f32_32x32x16_bf16(kf[2],qr[1],C0,0,0,0),   P0[10],P0[11],P0[12],P0[13], pw1[0]=PKW(P0,8), pw1[1]=PKW(P0,10), pw1); \
    VRD(5); SBAR(); GAPA(C1=__builtin_amdgcn_mfma_f32_32x32x16_bf16(kf[3],qr[1],C1,0,0,0),   P0[14],P0[15],P1[0],P1[1],   pw1[2]=PKW(P0,12),pw1[3]=PKW(P0,14), pw1); \
    VRD(2); SBAR(); GAPA(C0=__builtin_amdgcn_mfma_f32_32x32x16_bf16(kf[4],qr[2],C0,0,0,0),   P1[2],P1[3],P1[4],P1[5],     pw2[0]=PKW(P1,0), pw2[1]=PKW(P1,2), pw2); \
    VRD(6); SBAR(); GAPA(C1=__builtin_amdgcn_mfma_f32_32x32x16_bf16(kf[5],qr[2],C1,0,0,0),   P1[6],P1[7],P1[8],P1[9],     pw2[2]=PKW(P1,4), pw2[3]=PKW(P1,6), pw2); \
    VRD(3); SBAR(); GAPA(C0=__builtin_amdgcn_mfma_f32_32x32x16_bf16(kf[6],qr[3],C0,0,0,0),   P1[10],P1[11],P1[12],P1[13], pw3[0]=PKW(P1,8), pw3[1]=PKW(P1,10), pw3); \
    VRD(7); SBAR(); GAPA(C1=__builtin_amdgcn_mfma_f32_32x32x16_bf16(kf[7],qr[3],C1,0,0,0),   P1[14],P1[15],0.f,0.f,       pw3[2]=PKW(P1,12),pw3[3]=PKW(P1,14), pw3); \
    l_reg+=sacc; \
    if(GK){DMA_K((t)+3,sl_cur);} if(GV){DMA_V((t)+1,sl_next);} \
    CMASK(C0,C1,t); \
    { float a=MX3(C0[0],C0[1],C1[0]),b=MX3(C0[2],C0[3],C1[1]); a=MX3(a,C1[2],C1[3]); \
      _Pragma("unroll") for(int r=4;r<16;r+=4){a=MX3(a,C0[r],C0[r+1]);b=MX3(b,C0[r+2],C0[r+3]);a=MX3(a,C1[r],C1[r+1]);b=MX3(b,C1[r+2],C1[r+3]);} \
      float rm=__builtin_fmaxf(a,b); { auto rr=__builtin_amdgcn_permlane32_swap(__float_as_uint(rm),__float_as_uint(rm),false,false); rm=__builtin_fmaxf(__uint_as_float(rr[0]),__uint_as_float(rr[1])); } \
      resc=false; \
      if(__builtin_expect(__any(rm>(float)THRL),0)){ const float dl=__builtin_fmaxf(rm,0.f); mhat+=dl; \
        _Pragma("unroll") for(int r=0;r<16;++r){C0[r]-=dl;C1[r]-=dl;} \
        const float f=__builtin_amdgcn_exp2f(-dl); l_reg*=f; if(hi==0)wsf[r32]=f; resc=true; } } \
    SBAR(); \
    GAPB(o[0]=__builtin_amdgcn_mfma_f32_32x32x16_bf16(PAF(0),VFR(0),o[0],0,0,0), C0,0); \
    GAPB(o[1]=__builtin_amdgcn_mfma_f32_32x32x16_bf16(PAF(0),VFR(4),o[1],0,0,0), C0,4); \
    KRD(GL,0); GAPB(o[0]=__builtin_amdgcn_mfma_f32_32x32x16_bf16(PAF(1),VFR(1),o[0],0,0,0), C0,8); \
    KRD(GL,1); GAPB(o[1]=__builtin_amdgcn_mfma_f32_32x32x16_bf16(PAF(1),VFR(5),o[1],0,0,0), C0,12); \
    KRD(GL,2); GAPB(o[0]=__builtin_amdgcn_mfma_f32_32x32x16_bf16(PAF(2),VFR(2),o[0],0,0,0), C1,0); \
    KRD(GL,3); GAPB(o[1]=__builtin_amdgcn_mfma_f32_32x32x16_bf16(PAF(2),VFR(6),o[1],0,0,0), C1,4); \
    GAPB(o[0]=__builtin_amdgcn_mfma_f32_32x32x16_bf16(PAF(3),VFR(3),o[0],0,0,0), C1,8); \
    GAPB(o[1]=__builtin_amdgcn_mfma_f32_32x32x16_bf16(PAF(3),VFR(7),o[1],0,0,0), C1,12); \
    }while(0)
  int t=1;
  #define ENDW(tt) do{ if((tt)+3<NTE){WAIT_BAR(2);} else if((tt)+2<NTE){WAIT_BAR(1);} else {WAIT_BAR(0);} }while(0)
  for(;t<5&&t+1<NTE;t+=2){
    STEP(pB0,pB1,pA0,pA1,t,(t+3<NTE),(t+1<NTE),(t+1<NTE));       ENDW(t);   RESC(); ROT();
    if(t==3&&NTE>6){
      float sl=mhat-qkrow;
      sl=fminf(sl,__uint_as_float(__builtin_amdgcn_update_dpp(__float_as_uint(sl),__float_as_uint(sl),0xB1,0xf,0xf,false)));
      sl=fminf(sl,__uint_as_float(__builtin_amdgcn_update_dpp(__float_as_uint(sl),__float_as_uint(sl),0x4E,0xf,0xf,false)));
      sl=fminf(sl,__uint_as_float(__builtin_amdgcn_update_dpp(__float_as_uint(sl),__float_as_uint(sl),0x124,0xf,0xf,false)));
      sl=fminf(sl,__uint_as_float(__builtin_amdgcn_update_dpp(__float_as_uint(sl),__float_as_uint(sl),0x128,0xf,0xf,false)));
      { auto r_=__builtin_amdgcn_permlane16_swap(__float_as_uint(sl),__float_as_uint(sl),false,false); sl=fminf(__uint_as_float(r_[0]),__uint_as_float(r_[1])); }
      { auto r_=__builtin_amdgcn_permlane32_swap(__float_as_uint(sl),__float_as_uint(sl),false,false); sl=fminf(__uint_as_float(r_[0]),__uint_as_float(r_[1])); }
      if(lane==0)wsf[32]=sl;
      asm volatile("s_waitcnt lgkmcnt(0)\n\ts_barrier":::"memory");
      float smin=((const float*)(shm+LDS_WS))[32];
      #pragma unroll
      for(int w_=1;w_<NW;++w_)smin=fminf(smin,((const float*)(shm+LDS_WS))[w_*64+32]);
      const float kl=((const float*)(shm+LDS_KB))[64*(lane<NT?lane:0)+63];
      const bool sk2=(lane<NT)&&(kl<smin-ACP_T);
      const unsigned long long bal2=__ballot(sk2); int n2_=NT-__builtin_ctzll(~bal2); n2_+=n2_&1; if(n2_<6)n2_=6;
      n2_=__builtin_amdgcn_readfirstlane(n2_); if(n2_<NTE)NTE=n2_;
    }
    STEP(pA0,pA1,pB0,pB1,t+1,(t+4<NTE),(t+2<NTE),(t+2<NTE));     ENDW(t+1); RESC(); ROT();
  }
  #undef CMASK
  #define CMASK(P0,P1,t) do{}while(0)
  for(;t+5<NTE;t+=2){
    STEP(pB0,pB1,pA0,pA1,t,true,true,true);     WAIT_BAR(2); RESC(); ROT();
    STEP(pA0,pA1,pB0,pB1,t+1,true,true,true);   WAIT_BAR(2); RESC(); ROT();
  }
  #undef CMASK
  #define CMASK(P0,P1,t) do{int jb_=3-(t); if(jb_>=0)cmask(P0,P1,jb_,qrel,hi);}while(0)
  for(;t+1<NTE;t+=2){
    STEP(pB0,pB1,pA0,pA1,t,(t+3<NTE),(t+1<NTE),(t+1<NTE));       ENDW(t);   RESC(); ROT();
    STEP(pA0,pA1,pB0,pB1,t+1,(t+4<NTE),(t+2<NTE),(t+2<NTE));     ENDW(t+1); RESC(); ROT();
  }
  const bf16*Gw=G+(rowbase+q0+wid*QBLK)*DM+h*D; u32x4 gpre[4];
  { int lane_g=lane; asm volatile("":"+v"(lane_g));
    #pragma unroll
    for(int i=0;i<4;++i)gpre[i]=*(const u32x4*)(Gw+(long)(i*8+(lane_g>>3))*DM+(lane_g&7)*8); }
  STEP(pB0,pB1,pA0,pA1,NTE-1,false,false,false); RESC();
  { float sacc=pB0[0]+pB0[1]; _Pragma("unroll") for(int r=2;r<16;++r)sacc+=pB0[r]; _Pragma("unroll") for(int r=0;r<16;++r)sacc+=pB1[r]; l_reg+=sacc;
    pw0=(u32x4){PKW(pB0,0),PKW(pB0,2),PKW(pB0,4),PKW(pB0,6)};pw1=(u32x4){PKW(pB0,8),PKW(pB0,10),PKW(pB0,12),PKW(pB0,14)};pw2=(u32x4){PKW(pB1,0),PKW(pB1,2),PKW(pB1,4),PKW(pB1,6)};pw3=(u32x4){PKW(pB1,8),PKW(pB1,10),PKW(pB1,12),PKW(pB1,14)};
    SBAR(); pv(o,(int)(unsigned)(size_t)vp0+sl_cur,PAF(0),PAF(1),PAF(2),PAF(3)); }
  #undef PKW
  #undef PAF
  #undef VFR
  #undef PIN
  #undef MX3
  #undef GAPA
  #undef GAPB
  #undef EX
  #undef VRD
  #undef KRD
  #undef STEP
  #undef ENDW
  {auto rr=__builtin_amdgcn_permlane32_swap(__float_as_uint(l_reg),__float_as_uint(l_reg),false,false);l_reg=__uint_as_float(rr[0])+__uint_as_float(rr[1]);}
  if(hi==0)wsf[32+r32]=l_reg;asm volatile("s_waitcnt lgkmcnt(0)":::"memory");
  float rli[16];
  #pragma unroll
  for(int r=0;r<16;++r)rli[r]=__builtin_amdgcn_rcpf(wsf[32+crow(r,hi)]);
  bf16*Ow=O+(rowbase+q0+wid*QBLK)*OPITCH+OCOL+h*D;
  { bf16*stg=(bf16*)(shm+LDS_OST)+wid*2048;
    #pragma unroll
    for(int r=0;r<16;++r){const int orow=crow(r,hi);
      #pragma unroll
      for(int d0=0;d0<2;++d0)stg[orow*64+d0*32+r32]=__float2bfloat16(o[d0][r]*rli[r]);}
    asm volatile("s_waitcnt lgkmcnt(0)":::"memory");
    int lane_e=lane; asm volatile("":"+v"(lane_e));
    #pragma unroll
    for(int i=0;i<4;++i){const int row=i*8+(lane_e>>3),ch=lane_e&7; const u32x4 v=*(const u32x4*)(stg+row*64+ch*8); const u32x4 g=gpre[i]; u32x4 w;
      #pragma unroll
      for(int e=0;e<4;++e){ const float lo=__uint_as_float(v[e]<<16)*__uint_as_float(g[e]<<16), hi_=__uint_as_float(v[e]&0xffff0000u)*__uint_as_float(g[e]&0xffff0000u); w[e]=cvtpk_s(lo,hi_); }
      ATTN_STORE16(Ow+(long)row*OPITCH+ch*8,w);} }
  asm volatile("s_waitcnt lgkmcnt(0)\n\ts_barrier":::"memory");
  #undef DMA_K
  #undef DMA_V
  #undef CMASK
  #undef START
  #undef RESC
  #undef ROT
}
constexpr int ATTN_LDS_BYTES=LDS_BYTES;
struct AttnTensors { const bf16* Q; const bf16* K; const bf16* V; const bf16* G; const float* CC; bf16* O; };
struct AttnUnit { int bh; int qb; };
struct StaticOrder {
  int vcu,G;
  __device__ __forceinline__ explicit StaticOrder(int grid,int block):vcu((grid%8==0)?(block%8)*(grid/8)+block/8:block),G(grid){}
  __device__ __forceinline__ bool next(int i,AttnUnit&u)const{ const int v=vcu+(i>>2)*G; if(v>=256)return false; const int s=2*(v&1),j=i&3; u.bh=v>>1; u.qb=(j==0)?7-s:(j==1)?s:(j==2)?6-s:s+1; return true; }
  __device__ __forceinline__ void a_ready(const AttnUnit&)const{}
  __device__ __forceinline__ void done(const AttnUnit&)const{}
};
template<class Sched,int THRL=8> __device__ __forceinline__ void attn_phase(char*lds,const AttnTensors&T,const Sched&S){
  AttnUnit u;
  for(int i=0;S.next(i,u);++i){ S.a_ready(u); attn_unit<THRL>(u.bh/NHEAD,u.bh%NHEAD,u.qb,T.Q,T.K,T.V,T.G,T.CC,T.O,lds); S.done(u); }
}
#undef SBAR
#undef WAIT_BAR
}
namespace hg {
typedef __attribute__((address_space(3))) unsigned char* lptr;
typedef short bf16x8 __attribute__((ext_vector_type(8)));
typedef short s16x4 __attribute__((ext_vector_type(4)));
typedef float f32x16 __attribute__((ext_vector_type(16)));
typedef float f32x4 __attribute__((ext_vector_type(4)));
typedef unsigned u32x4 __attribute__((ext_vector_type(4)));
typedef unsigned u32x2 __attribute__((ext_vector_type(2)));
constexpr int P = 144;
constexpr int L_QD = 0, L_QH = 9216, L_KD = 18432, L_KO = 27648, L_KHT = 32256, L_VT = 41472, L_ST = 50688, L_TOT = 59904, L_EB = 61952, L_SS = 62208, L_END = 62720;
__device__ __forceinline__ int crow(int r, int hi) { return (r & 3) + 8 * (r >> 2) + 4 * hi; }
typedef float f32x2_t __attribute__((ext_vector_type(2))); typedef __bf16 bf16x2_t __attribute__((ext_vector_type(2)));
__device__ __forceinline__ unsigned cvtpk(float lo, float hi) { f32x2_t v = {lo, hi}; bf16x2_t b = __builtin_convertvector(v, bf16x2_t); return __builtin_bit_cast(unsigned, b); }
__device__ __forceinline__ unsigned short cvt1(float x) { return (unsigned short)(cvtpk(x, 0.f) & 0xffffu); }
#define HG_MFMA(a, b, c) __builtin_amdgcn_mfma_f32_32x32x16_bf16((a), (b), (c), 0, 0, 0)

__device__ __forceinline__ void hgrn_item(int b, int h, const unsigned short* QA, const float* LF, const unsigned short* IA, const unsigned short* GA, const float* gnorm, unsigned short* MIX, unsigned char* shm_) {
    int tid_ = threadIdx.x; asm volatile("" : "+v"(tid_));
    const int tid = tid_, lane = tid & 63, w = __builtin_amdgcn_readfirstlane(tid >> 6), r = lane & 31, hh = lane >> 5;
    const lptr shm = (lptr)shm_;
    const int colh = h * 64 + lane;
    for (int e = tid; e < 64 * P / 4; e += 512) ((__attribute__((address_space(3))) unsigned*)(shm + L_ST))[e] = 0u;
    f32x16 S = {};
    const bool outw = w < 4; const int I = (w >> 1) & 1, vt = w & 1, dt = (w >> 1) & 1;
    f32x4 gnv[4];
    { const float* gn = gnorm + h * 64 + 32 * vt + 4 * hh;
#pragma unroll
      for (int g = 0; g < 4; ++g) gnv[g] = *(const f32x4*)(gn + 8 * g); }
    float nlf[8]; unsigned short nq[8], nv[8];
    { const size_t m0 = (size_t)b * SEQ + 8 * w;
#pragma unroll
      for (int i = 0; i < 8; ++i) { nlf[i] = LF[(m0 + i) * 256 + colh]; nq[i] = QA[(m0 + i) * 256 + colh]; nv[i] = IA[(m0 + i) * 256 + colh]; } }
    for (int c = 0; c < SEQ / 64; ++c) {
        const size_t row0 = (size_t)b * SEQ + c * 64;
        float l2[8]; unsigned short qv[8], vv[8];
#pragma unroll
        for (int i = 0; i < 8; ++i) { l2[i] = nlf[i] * LOG2E; qv[i] = nq[i]; vv[i] = nv[i]; }
        float cs[8]; { float s = 0.f;
#pragma unroll
            for (int i = 0; i < 8; ++i) { s += l2[i]; cs[i] = s; } }
        ((__attribute__((address_space(3))) float*)(shm + L_TOT))[w * 64 + lane] = cs[7];
        __syncthreads();
        float pre = 0.f, r1 = 0.f, blast = 0.f;
#pragma unroll
        for (int j = 0; j < 8; ++j) { const float t = ((__attribute__((address_space(3))) const float*)(shm + L_TOT))[j * 64 + lane]; if (j < w) pre += t; if (j < 4) r1 += t; blast += t; }
        const float er1 = __builtin_amdgcn_exp2f(r1), rI = (w >= 4) ? r1 : 0.f, e1 = (w >= 4) ? er1 : 1.0f, e2 = __builtin_amdgcn_exp2f(blast - rI);
        unsigned khp[4];
#pragma unroll
        for (int i = 0; i < 8; i += 2) {
            float qd2[2], qh2[2], kd2[2], ko2[2], kh2[2];
#pragma unroll
            for (int ii = 0; ii < 2; ++ii) {
                const int t = i + ii; const float bt = pre + cs[t]; const float f = __builtin_amdgcn_exp2f(l2[t]); const float k = 1.0f - f; const float q = __uint_as_float((unsigned)qv[t] << 16);
                qd2[ii] = q * __builtin_amdgcn_exp2f(bt - rI); qh2[ii] = qd2[ii] * e1; kd2[ii] = k * __builtin_amdgcn_exp2f(rI - bt);
                kh2[ii] = kd2[ii] * e2; ko2[ii] = kd2[ii] * er1;
            }
            const unsigned pqd = cvtpk(qd2[0], qd2[1]), pqh = cvtpk(qh2[0], qh2[1]), pkd = cvtpk(kd2[0], kd2[1]);
            const int ro = (8 * w + i) * P + lane * 2;
            *(__attribute__((address_space(3))) unsigned short*)(shm + L_QD + ro) = (unsigned short)pqd; *(__attribute__((address_space(3))) unsigned short*)(shm + L_QD + ro + P) = (unsigned short)(pqd >> 16);
            *(__attribute__((address_space(3))) unsigned short*)(shm + L_QH + ro) = (unsigned short)pqh; *(__attribute__((address_space(3))) unsigned short*)(shm + L_QH + ro + P) = (unsigned short)(pqh >> 16);
            *(__attribute__((address_space(3))) unsigned short*)(shm + L_KD + ro) = (unsigned short)pkd; *(__attribute__((address_space(3))) unsigned short*)(shm + L_KD + ro + P) = (unsigned short)(pkd >> 16);
            if (w < 4) { const unsigned pko = cvtpk(ko2[0], ko2[1]);
                *(__attribute__((address_space(3))) unsigned short*)(shm + L_KO + ro) = (unsigned short)pko; *(__attribute__((address_space(3))) unsigned short*)(shm + L_KO + ro + P) = (unsigned short)(pko >> 16); }
            khp[i >> 1] = cvtpk(kh2[0], kh2[1]);
        }
        *(__attribute__((address_space(3))) u32x4*)(shm + L_KHT + lane * P + w * 16) = (u32x4){khp[0], khp[1], khp[2], khp[3]};
        *(__attribute__((address_space(3))) u32x4*)(shm + L_VT + lane * P + w * 16) = (u32x4){(unsigned)vv[0] | ((unsigned)vv[1] << 16), (unsigned)vv[2] | ((unsigned)vv[3] << 16), (unsigned)vv[4] | ((unsigned)vv[5] << 16), (unsigned)vv[6] | ((unsigned)vv[7] << 16)};
        if (w == 0) ((__attribute__((address_space(3))) float*)(shm + L_EB))[lane] = __builtin_amdgcn_exp2f(blast);
        if (c + 1 < SEQ / 64) { const size_t m0 = row0 + 64 + 8 * w;
#pragma unroll
            for (int i = 0; i < 8; ++i) { nlf[i] = LF[(m0 + i) * 256 + colh]; nq[i] = QA[(m0 + i) * 256 + colh]; nv[i] = IA[(m0 + i) * 256 + colh]; } }
        __syncthreads();
        f32x16 OT = {}; u32x2 gt[4];
        if (outw) {
            { const unsigned short* gp = GA + (row0 + 32 * I + r) * 256 + h * 64 + 32 * vt + 4 * hh;
#pragma unroll
              for (int g = 0; g < 4; ++g) gt[g] = *(const u32x2*)(gp + 8 * g); }
#pragma unroll
            for (int J = 0; J < 2; ++J) {
                if (J <= I) {
                    const bool diag = (J == I);
                    const lptr kb = diag ? (shm + L_KD + (32 * J + r) * P + hh * 16) : (shm + L_KO + r * P + hh * 16);
                    const lptr qb = shm + L_QD + (32 * I + r) * P + hh * 16;
                    f32x16 XT = {};
#pragma unroll
                    for (int kk = 0; kk < 4; ++kk) XT = HG_MFMA(*(__attribute__((address_space(3))) const bf16x8*)(kb + kk * 32), *(__attribute__((address_space(3))) const bf16x8*)(qb + kk * 32), XT);
                    if (diag) {
#pragma unroll
                        for (int g = 0; g < 16; ++g) if (crow(g, hh) > r) XT[g] = 0.f;
                    }
                    const lptr vb = shm + L_VT + (32 * vt + r) * P + (32 * J + 4 * hh) * 2;
#pragma unroll
                    for (int sp = 0; sp < 2; ++sp) {
                        const u32x4 xb = {cvtpk(XT[8 * sp], XT[8 * sp + 1]), cvtpk(XT[8 * sp + 2], XT[8 * sp + 3]), cvtpk(XT[8 * sp + 4], XT[8 * sp + 5]), cvtpk(XT[8 * sp + 6], XT[8 * sp + 7])};
                        const u32x2 a0 = *(__attribute__((address_space(3))) const u32x2*)(vb + sp * 32), a1 = *(__attribute__((address_space(3))) const u32x2*)(vb + sp * 32 + 16);
                        const u32x4 av = {a0[0], a0[1], a1[0], a1[1]};
                        OT = HG_MFMA(__builtin_bit_cast(bf16x8, av), __builtin_bit_cast(bf16x8, xb), OT);
                    }
                }
            }
            { const lptr sb = shm + L_ST + (32 * vt + r) * P + hh * 16; const lptr qb = shm + L_QH + (32 * I + r) * P + hh * 16;
#pragma unroll
              for (int kk = 0; kk < 4; ++kk) OT = HG_MFMA(*(__attribute__((address_space(3))) const bf16x8*)(sb + kk * 32), *(__attribute__((address_space(3))) const bf16x8*)(qb + kk * 32), OT); }
            float s = 0.f;
#pragma unroll
            for (int g = 0; g < 16; ++g) s += OT[g] * OT[g];
            s += __shfl_xor(s, 32);
            if (hh == 0) ((__attribute__((address_space(3))) float*)(shm + L_SS))[(I * 2 + vt) * 32 + r] = s;
        } else {
#pragma unroll
            for (int g = 0; g < 4; ++g) { const f32x4 e = *(__attribute__((address_space(3))) const f32x4*)(shm + L_EB + (32 * dt + 8 * g + 4 * hh) * 4);
                S[4 * g] *= e[0]; S[4 * g + 1] *= e[1]; S[4 * g + 2] *= e[2]; S[4 * g + 3] *= e[3]; }
            const lptr ka = shm + L_KHT + (32 * dt + r) * P + hh * 16; const lptr vb = shm + L_VT + (32 * vt + r) * P + hh * 16;
#pragma unroll
            for (int kk = 0; kk < 4; ++kk) S = HG_MFMA(*(__attribute__((address_space(3))) const bf16x8*)(ka + kk * 32), *(__attribute__((address_space(3))) const bf16x8*)(vb + kk * 32), S);
        }
        __syncthreads();
        if (outw) {
            const float ss = ((__attribute__((address_space(3))) const float*)(shm + L_SS))[(I * 2) * 32 + r] + ((__attribute__((address_space(3))) const float*)(shm + L_SS))[(I * 2 + 1) * 32 + r];
            const float rstd = rsqrtf(ss * (1.0f / 64.0f) + NORM_EPS);
            unsigned short* op = MIX + (row0 + 32 * I + r) * DM + h * 64 + 32 * vt + 4 * hh;
#pragma unroll
            for (int g = 0; g < 4; ++g) { const f32x4 gv = gnv[g];
                const float y0 = OT[4 * g] * rstd * gv[0], y1 = OT[4 * g + 1] * rstd * gv[1], y2 = OT[4 * g + 2] * rstd * gv[2], y3 = OT[4 * g + 3] * rstd * gv[3];
                const unsigned p0 = cvtpk(y0, y1), p1 = cvtpk(y2, y3);
                const float z0 = __uint_as_float(p0 << 16) * __uint_as_float(gt[g][0] << 16), z1 = __uint_as_float(p0 & 0xffff0000u) * __uint_as_float(gt[g][0] & 0xffff0000u);
                const float z2 = __uint_as_float(p1 << 16) * __uint_as_float(gt[g][1] << 16), z3 = __uint_as_float(p1 & 0xffff0000u) * __uint_as_float(gt[g][1] & 0xffff0000u);
                *(u32x2*)(op + 8 * g) = (u32x2){cvtpk(z0, z1), cvtpk(z2, z3)}; }
        } else {
            const lptr sp = shm + L_ST + (32 * vt + r) * P + (32 * dt + 4 * hh) * 2;
#pragma unroll
            for (int g = 0; g < 4; ++g) *(__attribute__((address_space(3))) u32x2*)(sp + 16 * g) = (u32x2){cvtpk(S[4 * g], S[4 * g + 1]), cvtpk(S[4 * g + 2], S[4 * g + 3])};
        }
    }
    __syncthreads();
}
#undef HG_MFMA
}
namespace pl {
typedef __attribute__((address_space(3))) unsigned char* lptr;
typedef short bf16x8 __attribute__((ext_vector_type(8)));
typedef float f32x16 __attribute__((ext_vector_type(16)));
typedef float f32x4 __attribute__((ext_vector_type(4)));
typedef unsigned u32x4 __attribute__((ext_vector_type(4)));
typedef unsigned u32x2 __attribute__((ext_vector_type(2)));
constexpr int UP = 528, L_U = 0, L_P = 80 * UP, PP = 144, L_END = L_P + 4 * 64 * PP;
__device__ __forceinline__ float lo16(unsigned x) { return __uint_as_float(x << 16); }
__device__ __forceinline__ float hi16(unsigned x) { return __uint_as_float(x & 0xffff0000u); }
__device__ __forceinline__ void pool_item(int b, int tbeg, int ntile, const unsigned short* UB, const unsigned short* GB, const unsigned short* PWT, const float* pscale, unsigned short* MIX, unsigned char* shm_) {
    int tid_ = threadIdx.x; asm volatile("" : "+v"(tid_));
    const int tid = tid_, lane = tid & 63, w = __builtin_amdgcn_readfirstlane(tid >> 6), r = lane & 31, hh = lane >> 5;
    const lptr shm = (lptr)shm_;
    const int g = w >> 1, tt = w & 1;
    u32x4 uv[5]; u32x2 gtn[2][4];
#define PL_LOAD(T0) do { _Pragma("unroll") for (int i = 0; i < 5; ++i) { const int e = tid + 512 * i, j = e >> 5, ch = e & 31; const int t = (T0) - 16 + j; \
        uv[i] = (u32x4){0u, 0u, 0u, 0u}; if (t >= 0) uv[i] = *(const u32x4*)(UB + ((size_t)b * SEQ + t) * 256 + ch * 8); } \
      const unsigned short* gp_ = GB + ((size_t)b * SEQ + (T0) + 32 * tt + r) * 256 + g * 64 + 4 * hh; \
      _Pragma("unroll") for (int dt = 0; dt < 2; ++dt) _Pragma("unroll") for (int q = 0; q < 4; ++q) gtn[dt][q] = *(const u32x2*)(gp_ + 32 * dt + 8 * q); } while (0)
    PL_LOAD(tbeg);
    bf16x8 wa[2][4];
#pragma unroll
    for (int dt = 0; dt < 2; ++dt)
#pragma unroll
        for (int kk = 0; kk < 4; ++kk) wa[dt][kk] = *(const bf16x8*)(PWT + ((size_t)g * 64 + 32 * dt + r) * 64 + kk * 16 + hh * 8);
    for (int ti = 0; ti < ntile; ++ti) {
    const int t0 = tbeg + 64 * ti; const size_t row0 = (size_t)b * SEQ + t0;
    u32x2 gt[2][4];
#pragma unroll
    for (int dt = 0; dt < 2; ++dt)
#pragma unroll
        for (int q = 0; q < 4; ++q) gt[dt][q] = gtn[dt][q];
#pragma unroll
    for (int i = 0; i < 5; ++i) { const int e = tid + 512 * i, j = e >> 5, ch = e & 31; *(__attribute__((address_space(3))) u32x4*)(shm + L_U + j * UP + ch * 16) = uv[i]; }
    __syncthreads();
    if (ti + 1 < ntile) PL_LOAD(t0 + 64);
    { const int cp = tid & 127, qtr = tid >> 7, gg = cp >> 5, win = 2 << gg, tl0 = 16 * qtr;
      const lptr up = shm + L_U + cp * 4; const lptr pp = shm + L_P + gg * 64 * PP + (cp & 31) * 4;
      float s0 = 0.f, s1 = 0.f;
      for (int j = 0; j < win; ++j) { const unsigned x = *(__attribute__((address_space(3))) const unsigned*)(up + (16 + tl0 - j) * UP); s0 += lo16(x); s1 += hi16(x); }
      const float rw = 1.0f / (float)win;
#pragma unroll 4
      for (int i = 0; i < 16; ++i) { const int tl = tl0 + i; const unsigned x = *(__attribute__((address_space(3))) const unsigned*)(up + (16 + tl) * UP);
          const int ta = t0 + tl + 1; const float rc = ta < win ? __builtin_amdgcn_rcpf((float)ta) : rw;
          *(__attribute__((address_space(3))) unsigned*)(pp + tl * PP) = hg::cvtpk(s0 * rc - lo16(x), s1 * rc - hi16(x));
          const unsigned xn = *(__attribute__((address_space(3))) const unsigned*)(up + (17 + tl) * UP), xo = *(__attribute__((address_space(3))) const unsigned*)(up + (17 + tl - win) * UP);
          s0 += lo16(xn) - lo16(xo); s1 += hi16(xn) - hi16(xo); } }
    __syncthreads();
    { const lptr pb = shm + L_P + g * 64 * PP + (32 * tt + r) * PP + hh * 16;
      bf16x8 pf[4];
#pragma unroll
      for (int kk = 0; kk < 4; ++kk) pf[kk] = *(__attribute__((address_space(3))) const bf16x8*)(pb + kk * 32);
#pragma unroll
      for (int dt = 0; dt < 2; ++dt) {
          f32x16 acc = {};
#pragma unroll
          for (int kk = 0; kk < 4; ++kk) acc = __builtin_amdgcn_mfma_f32_32x32x16_bf16(wa[dt][kk], pf[kk], acc, 0, 0, 0);
          const float* sp = pscale + g * 64 + 32 * dt + 4 * hh; unsigned short* op = MIX + (row0 + 32 * tt + r) * DM + 256 + g * 64 + 32 * dt + 4 * hh;
#pragma unroll
          for (int q = 0; q < 4; ++q) { const f32x4 sc = *(const f32x4*)(sp + 8 * q);
              const unsigned p0 = hg::cvtpk(acc[4 * q] * sc[0], acc[4 * q + 1] * sc[1]), p1 = hg::cvtpk(acc[4 * q + 2] * sc[2], acc[4 * q + 3] * sc[3]);
              *(u32x2*)(op + 8 * q) = (u32x2){hg::cvtpk(lo16(p0) * lo16(gt[dt][q][0]), hi16(p0) * hi16(gt[dt][q][0])), hg::cvtpk(lo16(p1) * lo16(gt[dt][q][1]), hi16(p1) * hi16(gt[dt][q][1]))}; }
      } }
    __syncthreads();
    }
#undef PL_LOAD
}
}
#define XB_TMO      128
#define XB_XCNT(j)  (256  + 64 * (j))
#define XB_XSUB(j)  (1280 + 64 * (j))
#define XB_XGEN(j)  (2304 + 64 * (j))
#define XB_TOP      3328
#define XB_TOPGEN   3392
#define XCD_BAR_WORDS 3456
#define XB_SPIN_CAP (1u << 18)

__device__ __forceinline__ unsigned xb_ld(unsigned* p)              { return __hip_atomic_load(p, __ATOMIC_RELAXED, __HIP_MEMORY_SCOPE_AGENT); }
__device__ __forceinline__ unsigned xb_add(unsigned* p, unsigned v) { return __hip_atomic_fetch_add(p, v, __ATOMIC_RELAXED, __HIP_MEMORY_SCOPE_AGENT); }
__device__ __forceinline__ unsigned xb_xcc_id() { return (unsigned)__builtin_amdgcn_s_getreg((3 << 11) | 20) & 0xFu; }
#define XB_SPIN(cond, bar) do { unsigned _sp = 0; while (cond) { __builtin_amdgcn_s_sleep(1); \
    if ((++_sp & 255u) == 0u) { if (xb_ld(&(bar)[XB_TMO])) break; if (_sp > XB_SPIN_CAP) { atomicAdd(&(bar)[XB_TMO], 1u); break; } } } } while (0)

struct XcdBarrier {
    unsigned* bar; unsigned x;
    volatile LAS unsigned* st;
};

__device__ __forceinline__ XcdBarrier xcd_barrier_post(unsigned* bar, volatile LAS unsigned* st) {
    XcdBarrier b; b.bar = bar; b.x = xb_xcc_id(); b.st = st;
    if (threadIdx.x == 0) (void)xb_add(&bar[XB_XCNT(b.x)], 1u);
    return b;
}
__device__ __forceinline__ void xcd_barrier_complete(unsigned* bar, unsigned x, unsigned& nloc, unsigned& nx) {
    const unsigned G = gridDim.x * gridDim.y * gridDim.z;
    unsigned sum, cnt, mine, sp = 0u;
    for (;;) {
        sum = 0u; cnt = 0u; mine = 0u;
#pragma unroll
        for (unsigned j = 0; j < 16; ++j) { const unsigned c = xb_ld(&bar[XB_XCNT(j)]); sum += c; cnt += (c > 0u) ? 1u : 0u; mine = (j == x) ? c : mine; }
        if (sum == G) break;
        __builtin_amdgcn_s_sleep(1);
        if ((++sp & 255u) == 0u) { if (xb_ld(&bar[XB_TMO])) break; if (sp > XB_SPIN_CAP) { atomicAdd(&bar[XB_TMO], 1u); break; } }
    }
    nloc = mine > 0u ? mine : 1u; nx = cnt > 0u ? cnt : 1u;
}

__device__ __forceinline__ void xcd_barrier(const XcdBarrier& b) {
    asm volatile("s_waitcnt vmcnt(0)" ::: "memory");
    __syncthreads();
    if (threadIdx.x == 0) {
        unsigned* bar = b.bar;
        __builtin_amdgcn_s_waitcnt(0);
        unsigned nloc = b.st[0], nx = b.st[1];
        if (nloc == 0u) { xcd_barrier_complete(bar, b.x, nloc, nx); b.st[0] = nloc; b.st[1] = nx; }
        const unsigned old = xb_add(&bar[XB_XSUB(b.x)], 1u);
        const unsigned gen = old / nloc;
        if (old + 1u == (gen + 1u) * nloc) {
            __builtin_amdgcn_fence(__ATOMIC_RELEASE, "agent");
            asm volatile("s_waitcnt vmcnt(0)" ::: "memory");
            const unsigned og = xb_add(&bar[XB_TOP], 1u);
            const unsigned tg = og / nx;
            if (og + 1u == (tg + 1u) * nx) xb_add(&bar[XB_TOPGEN], 1u);
            else XB_SPIN(xb_ld(&bar[XB_TOPGEN]) == tg, bar);
            __builtin_amdgcn_fence(__ATOMIC_ACQUIRE, "agent");
            xb_add(&bar[XB_XGEN(b.x)], 1u);
            asm volatile("s_waitcnt vmcnt(0)" ::: "memory");
        } else {
            XB_SPIN(xb_ld(&bar[XB_XGEN(b.x)]) == gen, bar);
            __builtin_amdgcn_fence(__ATOMIC_ACQUIRE, "agent");
            asm volatile("s_waitcnt vmcnt(0)" ::: "memory");
        }
    }
    __syncthreads();
}
#ifndef PROBE_REP_IN
#define PROBE_REP_IN 1
#endif
#ifndef PROBE_REP_OUT
#define PROBE_REP_OUT 1
#endif
#ifndef PROBE_REP_MIX
#define PROBE_REP_MIX 1
#endif
constexpr int NWAVES = 8;
constexpr int RING_OFF = 0, RING_BYTES = 131072;
constexpr int LDSCTL_OFF = RING_BYTES, MISC_OFF = LDSCTL_OFF + 320;
constexpr int LDS_BYTES = 147456;
constexpr int CW_TMO = 0, CW_CODE = 1, CW_Q = 2048, CW_BAR = 4096, CW_QM = 8192, CW_KM = 8192 + 2048;
constexpr size_t CTL_ZERO_BYTES = 65536;
constexpr int N_PHASES = 9;

struct Frame {
    LAS unsigned char* lds; volatile LAS unsigned* MISC; gu32* ctl;
    int wave, vcu, G;
};

__device__ __forceinline__ void p0_transpose_item(const float* W, int K, int ldw, int nblk, bf16* WT, LAS float* scr, int item, int lane) {
    const int kb = item / nblk, nb = item % nblk, k0 = 64 * kb, n0 = 32 * nb;
#pragma unroll 8
    for (int i = 0; i < 32; ++i) { const int kk = 2 * i + (lane >> 5); scr[kk * 33 + (lane & 31)] = W[(size_t)(k0 + kk) * ldw + n0 + (lane & 31)]; }
    LDS_WAIT(); asm volatile("" ::: "memory");
    const int c = lane & 7;
#pragma unroll
    for (int j = 0; j < 4; ++j) { const int n = (lane >> 3) + 8 * j; const LAS float* s = scr + (8 * c) * 33 + n;
        v4u o; o.x = pk2(s[0 * 33], s[1 * 33]); o.y = pk2(s[2 * 33], s[3 * 33]); o.z = pk2(s[4 * 33], s[5 * 33]); o.w = pk2(s[6 * 33], s[7 * 33]);
        *(GAS v4u*)(WT + (size_t)(n0 + n) * K + k0 + 8 * c) = o; }
    LDS_WAIT(); asm volatile("" ::: "memory");
}
constexpr int WFC_LDS = 98304;
template <class T> __device__ __forceinline__ T* opq(T* p) { GAS T* g = (GAS T*)p; asm volatile("" : "+s"(g)); return (T*)g; }
__device__ __forceinline__ int opaque_tid() { int t = threadIdx.x; asm volatile("" : "+v"(t)); return t; }
__device__ __forceinline__ void stage_wfc(Frame& F, const float* w_in_l, int tid) {
    LAS float* wf = (LAS float*)(F.lds + WFC_LDS);
    for (int e = tid; e < 8192; e += NWAVES * 64) { const int k = e >> 3, h = e & 7; wf[h * 1024 + k] = w_in_l[(size_t)k * NIN + 3584 + h]; }
}
__device__ __forceinline__ void fc_row(Frame& F, const f32x4 (&v)[4], const float* fbias, float* lfc_row, int lane) {
    const LAS float* wf = (const LAS float*)(F.lds + WFC_LDS);
    float s[8];
#pragma unroll
    for (int h = 0; h < 8; ++h) { float a = 0.f;
#pragma unroll
        for (int j = 0; j < 4; ++j) { const f32x4 w = *(const LAS f32x4*)(wf + h * 1024 + 256 * j + 4 * lane); a += (v[j].x * w.x + v[j].y * w.y) + (v[j].z * w.z + v[j].w * w.w); }
        s[h] = a; }
    float t[4], u[2];
#pragma unroll
    for (int j = 0; j < 4; ++j) { auto r = __builtin_amdgcn_permlane32_swap(__float_as_uint(s[j]), __float_as_uint(s[j + 4]), false, false); t[j] = __uint_as_float(r[0]) + __uint_as_float(r[1]); }
#pragma unroll
    for (int j = 0; j < 2; ++j) { auto r = __builtin_amdgcn_permlane16_swap(__float_as_uint(t[j]), __float_as_uint(t[j + 2]), false, false); u[j] = __uint_as_float(r[0]) + __uint_as_float(r[1]); }
    const bool b3 = (lane & 8) != 0;
    const float keep = b3 ? u[1] : u[0], send = b3 ? u[0] : u[1];
    float tot = keep + __uint_as_float(__builtin_amdgcn_update_dpp(0u, __float_as_uint(send), 0x128, 0xf, 0xf, false));
    tot = dpp_add<0xB1>(tot); tot = dpp_add<0x4E>(tot); tot = dpp_add<0x141>(tot);
    if ((lane & 7) == 0) { const int h = lane >> 3; lfc_row[h] = logsigmoidf_(tot + fbias[h]); }
}
__device__ __forceinline__ float bfround(float f) { return __uint_as_float(f2bf(f) << 16); }
__device__ __forceinline__ void emit_xn_row(Frame& F, f32x4 (&v)[4], bf16* xn_row, const float* fbias, float* lfc_row, int lane) {
    GAS unsigned long long* o8 = (GAS unsigned long long*)xn_row + lane;
#pragma unroll
    for (int j = 0; j < 4; ++j) { const unsigned lo = pk2(v[j].x, v[j].y), hi = pk2(v[j].z, v[j].w); o8[64 * j] = (unsigned long long)lo | ((unsigned long long)hi << 32);
        v[j].x = __uint_as_float(lo << 16); v[j].y = __uint_as_float(lo & 0xffff0000u); v[j].z = __uint_as_float(hi << 16); v[j].w = __uint_as_float(hi & 0xffff0000u); }
    fc_row(F, v, fbias, lfc_row, lane);
}

__device__ __forceinline__ void cumsum_wave(const float* LFC, float* CC, int bh, int lane) {
    const int b = bh >> 3, h = bh & 7;
    float loc[32]; float s = 0.f;
#pragma unroll
    for (int i = 0; i < 32; ++i) { s += LFC[((size_t)b * SEQ + lane * 32 + i) * 8 + h]; loc[i] = s; }
    float incl = s;
#pragma unroll
    for (int o = 1; o < 64; o <<= 1) { const float t = __shfl_up(incl, o); if (lane >= o) incl += t; }
    const float excl = incl - s;
#pragma unroll
    for (int i = 0; i < 32; i += 4) *(f32x4*)(CC + (size_t)bh * SEQ + lane * 32 + i) = (f32x4){excl + loc[i], excl + loc[i + 1], excl + loc[i + 2], excl + loc[i + 3]};
}
struct Args { const float* in[10]; float* out; unsigned char* ws; int ph_lo, ph_hi, li, pad; };

#define GRID_BAR() do { XcdBarrier b_ = bar; asm volatile("" : "+s"(b_.bar), "+s"(b_.x)); xcd_barrier(b_); } while (0)
#define IN(k) (lo <= (k) && (k) < hi)
#define BOTH(k) (IN(k) && IN((k) + 1))
template <int l> __device__ __forceinline__ void layer_phases(const Args& args, Frame& F, const XcdBarrier& bar, unsigned char* lds, int lo, int hi, int gw, int NGW) {
        const int pb = 1 + 4 * l;
        if (IN(pb)) {
            unsigned char* ws = opq(args.ws); bf16* XN = (bf16*)(ws + WS_XN);
            if (gw < BATCH * 8) cumsum_wave((const float*)(ws + WS_LFC), (float*)(ws + WS_CC), gw, opaque_tid() & 63);
            pg8::Gemm g{XN, (const bf16*)(ws + WS_WIN + l * 8 * MiB), M, 3584, DM}; pg8::StaticOrder S; S.init(M, 3584, F.G, (int)blockIdx.x);
            pg8::EpiIn E{ws, (const float*)(ws + WS_LBS) + l * 256, (unsigned*)(F.ctl + CW_QM + l * 1024), (unsigned*)(F.ctl + CW_KM + l * 128)};
            for (int rep_ = 0; rep_ < PROBE_REP_IN; ++rep_) pg8::gemm_phase<pg8::EpiIn, pg8::StaticOrder, true, true>(F.lds + RING_OFF, g, S, E);
            if (BOTH(pb)) GRID_BAR();
        }
        if (IN(pb + 1)) {
            unsigned char* ws = opq(args.ws); bf16* MIX = (bf16*)(ws + WS_MIX);
            for (int rep_ = 0; rep_ < PROBE_REP_MIX; ++rep_) {
            gu32* qctr = F.ctl + CW_Q + 64 * (l + 2 * rep_); volatile LAS unsigned* slot = F.MISC + 16;
            for (;;) {
                if (threadIdx.x == 0) slot[0] = __hip_atomic_fetch_add(qctr, 1u, RLX_AGENT);
                __syncthreads();
                const int idx = __builtin_amdgcn_readfirstlane((int)slot[0]);
                __syncthreads();
                if (idx >= 64 + 128 + 1024) break;
                if (idx < 64) hg::hgrn_item(idx >> 2, idx & 3, (const bf16*)(ws + WS_QA), (const float*)(ws + WS_LF), (const bf16*)(ws + WS_IA), (const bf16*)(ws + WS_GA), args.in[4] + l * 256, MIX, lds + RING_OFF);
                else if (idx < 64 + 128) { const int p = idx - 64;
                    pl::pool_item(p >> 3, (p & 7) * 256, 4, (const bf16*)(ws + WS_UB), (const bf16*)(ws + WS_GB), (const bf16*)(ws + WS_PWT) + l * 4 * 64 * 64, args.in[7] + l * 256, MIX, lds + RING_OFF); }
                else { const int j = idx - 64 - 128, qb = 7 - (j >> 7), bh = j & 127;
                    attn_body::attn_unit<8>(bh >> 3, bh & 7, qb, (const attn_body::bf16*)(ws + WS_QC), (const attn_body::bf16*)(ws + WS_KC), (const attn_body::bf16*)(ws + WS_VC), (const attn_body::bf16*)(ws + WS_GC), (const float*)(ws + WS_CC), __uint_as_float(F.ctl[CW_QM + l * 1024 + bh * 8 + qb]), __uint_as_float(F.ctl[CW_KM + l * 128 + bh]), (attn_body::bf16*)MIX, (char*)lds + RING_OFF); }
            }
            if (rep_ + 1 < PROBE_REP_MIX) GRID_BAR();
            }
            if (BOTH(pb + 1)) GRID_BAR();
        }
        if (IN(pb + 2)) {
            unsigned char* ws = opq(args.ws); bf16* MIX = (bf16*)(ws + WS_MIX); bf16* Y = (bf16*)(ws + WS_Y);
            pg8::Gemm g{MIX, (const bf16*)(ws + WS_WOUT + l * 2 * MiB), M, DM, DM}; pg8::StaticOrder S; S.init(M, DM, F.G, (int)blockIdx.x);
            pg8::EpiY E{Y, DM};
            for (int rep_ = 0; rep_ < PROBE_REP_OUT; ++rep_) pg8::gemm_phase<pg8::EpiY, pg8::StaticOrder, true, true>(F.lds + RING_OFF, g, S, E);
            if (BOTH(pb + 2)) GRID_BAR();
        }
        if (IN(pb + 3)) {
            const int tid = opaque_tid(), lane = tid & 63;
            unsigned char* ws = opq(args.ws); const float* x = args.in[0]; const float* pre_g = args.in[2]; const float* w_in = args.in[3]; const float* fbias = args.in[5]; const float* post_g = args.in[9]; float* out = args.out;
            bf16* XN = (bf16*)(ws + WS_XN); const bf16* Y = (const bf16*)(ws + WS_Y); float* LFC = (float*)(ws + WS_LFC);
            const bool more = l + 1 < DEPTH;
            if (more) { stage_wfc(F, w_in + (size_t)(l + 1) * DM * NIN, tid); __syncthreads(); }
            bf16* X1 = (bf16*)(ws + WS_X1);
            for (int m0 = gw; m0 < M; m0 += 2 * NGW) {
                unsigned long long yy[2][4]; f32x4 xv[2][4];
#pragma unroll
                for (int rr = 0; rr < 2; ++rr) { const int m = m0 + rr * NGW;
                    const GAS unsigned long long* yr = (const GAS unsigned long long*)(Y + (size_t)m * DM) + lane;
                    if (l == 0) { const GAS f32x4* xr = (const GAS f32x4*)(x + (size_t)m * DM) + lane;
#pragma unroll
                        for (int j = 0; j < 4; ++j) { yy[rr][j] = __builtin_nontemporal_load(yr + 64 * j); xv[rr][j] = __builtin_nontemporal_load(xr + 64 * j); } }
                    else { const GAS unsigned long long* xr = (const GAS unsigned long long*)(X1 + (size_t)m * DM) + lane;
#pragma unroll
                        for (int j = 0; j < 4; ++j) { yy[rr][j] = __builtin_nontemporal_load(yr + 64 * j); const unsigned long long xx = __builtin_nontemporal_load(xr + 64 * j); const unsigned xlo = (unsigned)xx, xhi = (unsigned)(xx >> 32);
                            xv[rr][j] = (f32x4){__uint_as_float(xlo << 16), __uint_as_float(xlo & 0xffff0000u), __uint_as_float(xhi << 16), __uint_as_float(xhi & 0xffff0000u)}; } } }
                f32x4 gp[4];
#pragma unroll
                for (int j = 0; j < 4; ++j) gp[j] = *((const f32x4*)(post_g + l * DM) + 64 * j + lane);
#pragma unroll
                for (int rr = 0; rr < 2; ++rr) { const int m = m0 + rr * NGW;
                    f32x4 v[4]; float ss = 0.f;
#pragma unroll
                    for (int j = 0; j < 4; ++j) { const unsigned ylo = (unsigned)yy[rr][j], yhi = (unsigned)(yy[rr][j] >> 32);
                        v[j] = (f32x4){__uint_as_float(ylo << 16), __uint_as_float(ylo & 0xffff0000u), __uint_as_float(yhi << 16), __uint_as_float(yhi & 0xffff0000u)}; ss += (v[j].x * v[j].x + v[j].y * v[j].y) + (v[j].z * v[j].z + v[j].w * v[j].w); }
                    const float rstd = rsqrtf(wave_sum(ss) * (1.f / DM) + NORM_EPS);
                    float s2 = 0.f;
#pragma unroll
                    for (int j = 0; j < 4; ++j) { v[j] = xv[rr][j] + v[j] * rstd * gp[j];
                        s2 += (v[j].x * v[j].x + v[j].y * v[j].y) + (v[j].z * v[j].z + v[j].w * v[j].w);
                        if (more) __builtin_nontemporal_store((unsigned long long)pk2(v[j].x, v[j].y) | ((unsigned long long)pk2(v[j].z, v[j].w) << 32), (GAS unsigned long long*)(X1 + (size_t)m * DM) + 64 * j + lane);
                        else __builtin_nontemporal_store(v[j], (GAS f32x4*)(out + (size_t)m * DM) + 64 * j + lane); }
                    if (more) { const float r2 = rsqrtf(wave_sum(s2) * (1.f / DM) + NORM_EPS);
#pragma unroll
                        for (int j = 0; j < 4; ++j) v[j] = v[j] * r2 * *((const f32x4*)(pre_g + (l + 1) * DM) + 64 * j + lane);
                        emit_xn_row(F, v, XN + (size_t)m * DM, fbias + (l + 1) * 8, LFC + (size_t)m * 8, lane); } }
            }
            if (BOTH(pb + 3)) GRID_BAR();
        }
}
__global__ void __launch_bounds__(NWAVES * 64, 2) fwd(Args args) {
    extern __shared__ __attribute__((aligned(16))) unsigned char lds[];
    Frame F;
    F.lds = (LAS unsigned char*)lds; F.MISC = (volatile LAS unsigned*)(F.lds + MISC_OFF);
    F.wave = __builtin_amdgcn_readfirstlane(threadIdx.x >> 6);
    F.G = gridDim.x; { const int bx = blockIdx.x; F.vcu = (F.G % 8 == 0) ? (bx % 8) * (F.G / 8) + bx / 8 : bx; }
    F.ctl = (gu32*)(args.ws + WS_CTL);
    for (int u = threadIdx.x; u < (LDS_BYTES - LDSCTL_OFF) / 4; u += NWAVES * 64) ((LAS unsigned*)(F.lds + LDSCTL_OFF))[u] = 0u;
    __syncthreads();
    XcdBarrier bar = xcd_barrier_post((unsigned*)(F.ctl + CW_BAR) + args.li * XCD_BAR_WORDS, F.MISC + 8);
    const int lo = args.ph_lo, hi = args.ph_hi;
    const int gw = F.vcu * NWAVES + F.wave, NGW = F.G * NWAVES;

    if (IN(0)) {
        const int tid = opaque_tid(), lane = tid & 63;
        unsigned char* ws = opq(args.ws); const float* x = args.in[0]; const float* lower = args.in[1]; const float* pre_g = args.in[2]; const float* w_in = args.in[3]; const float* fbias = args.in[5]; const float* pool_w = args.in[6]; const float* w_out = args.in[8];
        bf16* XN = (bf16*)(ws + WS_XN); float* LFC = (float*)(ws + WS_LFC);
        stage_wfc(F, w_in, tid);
        __syncthreads();
        LAS float* scr = (LAS float*)(F.lds + RING_OFF + F.wave * 8448);
        constexpr int I_IN = 16 * 112, I_OUT = 16 * 32, NITEMS = 2 * (I_IN + I_OUT);
        for (int it = gw; it < NITEMS; it += NGW) {
            int r = it; const int l = r / (I_IN + I_OUT); r -= l * (I_IN + I_OUT);
            if (r < I_IN) p0_transpose_item(w_in + (size_t)l * DM * NIN, DM, NIN, 112, (bf16*)(ws + WS_WIN + l * 8 * MiB), scr, r, lane);
            else p0_transpose_item(w_out + (size_t)l * DM * DM, DM, DM, 32, (bf16*)(ws + WS_WOUT + l * 2 * MiB), scr, r - I_IN, lane);
        }
        const int gt = F.vcu * NWAVES * 64 + tid, NGT = F.G * NWAVES * 64;
        for (int e = gt; e < 512; e += NGT) { const int l = e >> 8, j = e & 255; ((float*)(ws + WS_LBS))[e] = l == 0 ? 0.f : 1.f / (1.f + __expf(lower[j] - lower[256 + j])); }
        for (int e = gt; e < 2 * 4 * 64 * 64; e += NGT) { const int c = e & 63, d = (e >> 6) & 63, lg = e >> 12; ((bf16*)(ws + WS_PWT))[e] = f2bf(pool_w[((size_t)lg * 64 + c) * 64 + d]); }
        for (int m0 = gw; m0 < M; m0 += 2 * NGW) {
            f32x4 xv[2][4];
#pragma unroll
            for (int rr = 0; rr < 2; ++rr) { const GAS f32x4* xr = (const GAS f32x4*)(x + (size_t)(m0 + rr * NGW) * DM) + lane;
#pragma unroll
                for (int j = 0; j < 4; ++j) xv[rr][j] = __builtin_nontemporal_load(xr + 64 * j); }
#pragma unroll
            for (int rr = 0; rr < 2; ++rr) { const int m = m0 + rr * NGW;
                f32x4 v[4]; float ss = 0.f;
#pragma unroll
                for (int j = 0; j < 4; ++j) { v[j] = xv[rr][j]; ss += (v[j].x * v[j].x + v[j].y * v[j].y) + (v[j].z * v[j].z + v[j].w * v[j].w); }
                const float rstd = rsqrtf(wave_sum(ss) * (1.f / DM) + NORM_EPS);
#pragma unroll
                for (int j = 0; j < 4; ++j) v[j] = v[j] * rstd * *((const f32x4*)pre_g + 64 * j + lane);
                emit_xn_row(F, v, XN + (size_t)m * DM, fbias, LFC + (size_t)m * 8, lane); }
        }
        if (BOTH(0)) GRID_BAR();
    }
    layer_phases<0>(args, F, bar, lds, lo, hi, gw, NGW);
    layer_phases<1>(args, F, bar, lds, lo, hi, gw, NGW);
}

static void launch_fwd(const Args& a0, int lo, int hi, int li, int grid, hipStream_t stream) {
    Args a = a0; a.ph_lo = lo; a.ph_hi = hi; a.li = li;
    hipLaunchKernelGGL(fwd, dim3(grid), dim3(NWAVES * 64), LDS_BYTES, stream, a);
}
extern "C" void kernel_launch(void* const* d_in, const int* in_sizes, int n_in, void* d_out, int out_size, void* d_ws, size_t ws_size, hipStream_t stream) {
    static int grid = 0;
    if (grid == 0) {
        if (n_in != 10 || in_sizes[0] != M * DM || out_size != M * DM || ws_size < WS_END) { fprintf(stderr, "kernel_launch: unexpected shapes / workspace (%zu < %zu)\n", ws_size, (size_t)WS_END); grid = -1; return; }
        int dev = 0, cus = 0, per_cu = 0;
        if (hipGetDevice(&dev) != hipSuccess || hipDeviceGetAttribute(&cus, hipDeviceAttributeMultiprocessorCount, dev) != hipSuccess) { grid = -1; return; }
        if (hipFuncSetAttribute((const void*)fwd, hipFuncAttributeMaxDynamicSharedMemorySize, LDS_BYTES) != hipSuccess) { fprintf(stderr, "kernel_launch: hipFuncSetAttribute failed\n"); grid = -1; return; }
        if (hipOccupancyMaxActiveBlocksPerMultiprocessor(&per_cu, (const void*)fwd, NWAVES * 64, LDS_BYTES) != hipSuccess || per_cu < 1) { fprintf(stderr, "kernel_launch: occupancy query says %d blocks per CU\n", per_cu); (void)hipGetLastError(); grid = -1; return; }
        grid = cus;
    }
    if (grid < 0) return;
    unsigned char* ws = (unsigned char*)d_ws;
    (void)hipMemsetAsync(ws + WS_CTL, 0, CTL_ZERO_BYTES, stream);
    Args a{};
    for (int i = 0; i < 10; ++i) a.in[i] = (const float*)d_in[i];
    a.out = (float*)d_out; a.ws = ws;
    launch_fwd(a, 0, N_PHASES, 0, grid, stream);
}
```

```cpp
#include <hip/hip_runtime.h>
#include <cstdio>
#include <cstdint>
#include <cmath>
#include <hip/hip_bf16.h>

typedef unsigned short bf16;
constexpr int BATCH = 16, SEQ = 2048, DM = 1024, DEPTH = 2, M = BATCH * SEQ;
constexpr int NIN = 3592;
constexpr float NORM_EPS = 1e-6f, TINY = 1e-30f, LOG2E = 1.4426950408889634f;
constexpr float C2 = 0.125f * LOG2E;

constexpr size_t MiB = 1u << 20;
constexpr size_t WS_CTL = 0;
constexpr size_t WS_WIN = 1 * MiB;
constexpr size_t WS_WOUT = 17 * MiB;
constexpr size_t WS_SMALL = 21 * MiB;
constexpr size_t WS_WFC = WS_SMALL, WS_LBS = WS_SMALL + 65536, WS_PWT = WS_SMALL + 131072;
constexpr size_t WS_LFC = 22 * MiB;
constexpr size_t WS_CC = 23 * MiB;
constexpr size_t WS_XN = 24 * MiB;
constexpr size_t WS_ACT = 88 * MiB;
constexpr size_t WS_QA = WS_ACT, WS_LF = WS_QA + 16 * MiB, WS_IA = WS_LF + 32 * MiB, WS_GA = WS_IA + 16 * MiB, WS_UB = WS_GA + 16 * MiB, WS_GB = WS_UB + 16 * MiB;
constexpr size_t WS_QC = WS_GB + 16 * MiB, WS_KC = WS_QC + 32 * MiB, WS_VC = WS_KC + 32 * MiB, WS_GC = WS_VC + 32 * MiB;
constexpr size_t WS_Y = WS_ACT;
constexpr size_t WS_X1 = WS_ACT + 240 * MiB + 64 * MiB;
constexpr size_t WS_MIX = WS_ACT + 240 * MiB;
constexpr size_t WS_END = WS_MIX + 128 * MiB;

__device__ __forceinline__ float bf2f(bf16 v) { return __uint_as_float((unsigned)v << 16); }
__device__ __forceinline__ bf16 f2bf(float f) { unsigned u = __float_as_uint(f); return (bf16)((u + 0x7fffu + ((u >> 16) & 1u)) >> 16); }
__device__ __forceinline__ float sigmoidf_(float x) { return 1.f / (1.f + __expf(-x)); }
__device__ __forceinline__ float siluf_(float x) { return x * sigmoidf_(x); }
__device__ __forceinline__ float logsigmoidf_(float x) { return fminf(x, 0.f) - log1pf(__expf(-fabsf(x))); }
template <int CTRL> __device__ __forceinline__ float dpp_add(float v) { return v + __uint_as_float(__builtin_amdgcn_update_dpp(0u, __float_as_uint(v), CTRL, 0xf, 0xf, false)); }
__device__ __forceinline__ float wave_sum(float v) {
    v = dpp_add<0xB1>(v); v = dpp_add<0x4E>(v); v = dpp_add<0x124>(v); v = dpp_add<0x128>(v);
    { auto r = __builtin_amdgcn_permlane16_swap(__float_as_uint(v), __float_as_uint(v), false, false); v = __uint_as_float(r[0]) + __uint_as_float(r[1]); }
    { auto r = __builtin_amdgcn_permlane32_swap(__float_as_uint(v), __float_as_uint(v), false, false); v = __uint_as_float(r[0]) + __uint_as_float(r[1]); }
    return v;
}

#define GAS __attribute__((address_space(1)))
#define LAS __attribute__((address_space(3)))
typedef unsigned v4u __attribute__((ext_vector_type(4)));
typedef float f32x4 __attribute__((ext_vector_type(4)));
typedef short bf16x8 __attribute__((ext_vector_type(8)));
typedef GAS unsigned gu32;
typedef GAS unsigned long long gu64;
#define RLX_AGENT __ATOMIC_RELAXED, __HIP_MEMORY_SCOPE_AGENT
#define LDS_WAIT() asm volatile("s_waitcnt lgkmcnt(0)" ::: "memory")
#define VM_WAIT() asm volatile("s_waitcnt vmcnt(0)" ::: "memory")
__device__ __forceinline__ unsigned pk2(float lo, float hi) { return (unsigned)f2bf(lo) | ((unsigned)f2bf(hi) << 16); }
namespace pg8 {
#define PG8_LAS __attribute__((address_space(3)))
typedef unsigned short bf16_t;
typedef short bf16x8 __attribute__((ext_vector_type(8)));
typedef float f32x4 __attribute__((ext_vector_type(4)));
typedef unsigned u32x4 __attribute__((ext_vector_type(4)));
constexpr int BM = 256, BK = 64, HALF = 128, HTB = HALF * BK * 2  , STAGE_BYTES = 8 * HTB, NXCD = 8, WGM = 4;

__host__ __device__ __forceinline__ int lds_byte(int r, int c) { const int st = (r >> 4) * 2 + (c >> 5), rr = r & 15, cc = c & 31, ob = rr * 64 + cc * 2; return st * 1024 + (ob ^ (((ob >> 9) & 1) << 5)); }
__host__ __device__ __forceinline__ void stage_rc(int b, int& R, int& C) { const int st = b / 1024, sb = b % 1024, swz = sb ^ (((sb >> 9) & 1) << 5); R = (st >> 1) * 16 + swz / 64; C = (st & 1) * 32 + (swz % 64) / 2; }
__host__ __device__ __forceinline__ int perm32(int rho) { const int n = rho >> 4, i = rho & 15; return 8 * (i >> 2) + 4 * n + (i & 3); }

struct Unit { int pm, pn; };
struct Gemm { const bf16_t* A; const bf16_t* Bt; int M, N, K; };

struct StaticOrder {
    int nM, nN, nwg, G, c;
    __host__ __device__ void init(int M, int N, int G_, int c_) { nM = M / BM; nN = N / BM; nwg = nM * nN; G = G_; c = c_; }
    __host__ __device__ bool next(int i, Unit& u) const {
        const long L = (long)i * G + c; if (L >= nwg) return false;
        int wgid = (int)L; { const int q = nwg / NXCD, r = nwg % NXCD, xcd = wgid % NXCD, off = wgid / NXCD; wgid = (xcd < r ? xcd * (q + 1) : r * (q + 1) + (xcd - r) * q) + off; }
        const int nig = WGM * nN, gid = wgid / nig, fm = gid * WGM, gsz = (nM - fm) < WGM ? (nM - fm) : WGM;
        u.pm = fm + ((wgid % nig) % gsz); u.pn = (wgid % nig) / gsz; return true;
    }
    __device__ __forceinline__ void a_ready(const Unit&) const {}
    __device__ __forceinline__ void done(const Unit&) const {}
};

__device__ __forceinline__ unsigned cvt_pk_bf16(float lo, float hi) { unsigned r; asm volatile("v_cvt_pk_bf16_f32 %0, %1, %2" : "=v"(r) : "v"(lo), "v"(hi)); return r; }
typedef float f32x2 __attribute__((ext_vector_type(2)));
#ifndef LOGF
#define LOGF logf
#endif
typedef unsigned u32x4 __attribute__((ext_vector_type(4)));
__device__ __forceinline__ float silu_fast(float x) { return x * __builtin_amdgcn_rcpf(1.0f + __expf(-x)); }
struct EpiIn {
    static constexpr bool PERM = true, AFTER_DRAIN = false;
    unsigned char* ws; const float* lbs;
    unsigned* qm; unsigned* km;
    __device__ __forceinline__ void operator()(const f32x4 (&acc)[2][2][4][2], const Unit& u, int wr, int wc, int fr, int fq) const {
        const int pn = u.pn;
        size_t off; int ldc = 256, cb = 0, mode = 0;
        switch (pn) {
            case 0: off = WS_QA; mode = 1; break;
            case 1: off = WS_LF; mode = 3; break;
            case 2: off = WS_IA; break;
            case 3: off = WS_GA; mode = 1; break;
            case 4: off = WS_UB; break;
            case 5: off = WS_GB; mode = 1; break;
            case 6: case 7: off = WS_QC; ldc = 512; cb = (pn - 6) * 256; mode = 2; break;
            case 8: case 9: off = WS_KC; ldc = 512; cb = (pn - 8) * 256; break;
            case 10: case 11: off = WS_VC; ldc = 512; cb = (pn - 10) * 256; break;
            default: off = WS_GC; ldc = 512; cb = (pn - 12) * 256; mode = 1; break;
        }
        const int row0 = u.pm * BM + wr * 64 + fr, col0 = cb + wc * 32 + 8 * fq;
        if (mode == 3) {
            float* base = (float*)(ws + off);
            f32x4 lb[2][2];
#pragma unroll
            for (int bj = 0; bj < 2; ++bj)
#pragma unroll
                for (int n = 0; n < 2; ++n) lb[bj][n] = *(const f32x4*)(lbs + col0 + bj * HALF + 4 * n);
#pragma unroll
            for (int ai = 0; ai < 2; ++ai)
#pragma unroll
                for (int m = 0; m < 4; ++m) { float* rowp = base + (size_t)(row0 + ai * HALF + m * 16) * 256 + col0;
#pragma unroll
                    for (int bj = 0; bj < 2; ++bj)
#pragma unroll
                        for (int n = 0; n < 2; ++n) { const f32x4 z = acc[ai][bj][m][n]; f32x4 o;
#pragma unroll
                            for (int i = 0; i < 4; ++i) { const float sg = __builtin_amdgcn_rcpf(1.0f + __expf(-z[i])); const float f = lb[bj][n][i] + (1.0f - lb[bj][n][i]) * sg; o[i] = LOGF(fmaxf(f, TINY)); }
                            *(f32x4*)(rowp + bj * HALF + 4 * n) = o; } }
        } else {
            bf16_t* base = (bf16_t*)(ws + off); float nmax[2] = {0.f, 0.f};
#pragma unroll
            for (int ai = 0; ai < 2; ++ai)
#pragma unroll
                for (int m = 0; m < 4; ++m) { bf16_t* rowp = base + (size_t)(row0 + ai * HALF + m * 16) * ldc + col0;
#pragma unroll
                    for (int bj = 0; bj < 2; ++bj) { f32x4 v0 = acc[ai][bj][m][0], v1 = acc[ai][bj][m][1];
                        if (mode == 1) {
#pragma unroll
                            for (int i = 0; i < 4; ++i) { v0[i] = silu_fast(v0[i]); v1[i] = silu_fast(v1[i]); } }
                        else if (mode == 2) { v0 = v0 * C2; v1 = v1 * C2; }
                        u32x4 w; w.x = cvt_pk_bf16(v0[0], v0[1]); w.y = cvt_pk_bf16(v0[2], v0[3]); w.z = cvt_pk_bf16(v1[0], v1[1]); w.w = cvt_pk_bf16(v1[2], v1[3]);
                        *(u32x4*)(rowp + bj * HALF) = w;
                        if (pn >= 6 && pn <= 9) {
                            float sq = 0.f;
#pragma unroll
                            for (int i = 0; i < 4; ++i) { const float a = __uint_as_float(w[i] << 16), b = __uint_as_float(w[i] & 0xffff0000u); sq += a * a + b * b; }
                            sq += __shfl_xor(sq, 16); sq += __shfl_xor(sq, 32);
                            nmax[bj] = fmaxf(nmax[bj], sq); } } }
            if (pn >= 6 && pn <= 9) {
#pragma unroll
                for (int bj = 0; bj < 2; ++bj) { float v = nmax[bj];
                    v = fmaxf(v, __shfl_xor(v, 1)); v = fmaxf(v, __shfl_xor(v, 2)); v = fmaxf(v, __shfl_xor(v, 4)); v = fmaxf(v, __shfl_xor(v, 8));
                    if (fr == 0 && fq == 0) { const int h = (pn & 1) * 4 + 2 * bj + (wc >> 1), b = u.pm >> 3, qb = u.pm & 7;
                        unsigned* dst = pn < 8 ? qm + (b * 8 + h) * 8 + qb : km + b * 8 + h;
                        __hip_atomic_fetch_max(dst, __float_as_uint(v), __ATOMIC_RELAXED, __HIP_MEMORY_SCOPE_AGENT); } } }
        }
    }
};
struct EpiY {
    static constexpr bool PERM = true, AFTER_DRAIN = false;
    bf16_t* Y; int ldc;
    __device__ __forceinline__ void operator()(const f32x4 (&acc)[2][2][4][2], const Unit& u, int wr, int wc, int fr, int fq) const {
        const int row0 = u.pm * BM + wr * 64 + fr, col0 = u.pn * BM + wc * 32 + 8 * fq;
#pragma unroll
        for (int ai = 0; ai < 2; ++ai)
#pragma unroll
            for (int m = 0; m < 4; ++m) { bf16_t* rowp = Y + (size_t)(row0 + ai * HALF + m * 16) * ldc + col0;
#pragma unroll
                for (int bj = 0; bj < 2; ++bj) { const f32x4 v0 = acc[ai][bj][m][0], v1 = acc[ai][bj][m][1];
                    u32x4 w; w.x = cvt_pk_bf16(v0[0], v0[1]); w.y = cvt_pk_bf16(v0[2], v0[3]); w.z = cvt_pk_bf16(v1[0], v1[1]); w.w = cvt_pk_bf16(v1[2], v1[3]);
                    *(u32x4*)(rowp + bj * HALF) = w; } }
    }
};
template <class Epi, class Sched, bool ALIGN_EPI = false, bool SP2 = false>
__device__ __forceinline__ void gemm_phase(PG8_LAS unsigned char* lds, const Gemm g, const Sched& S, const Epi& E) {
    const int tid = threadIdx.x, wid = __builtin_amdgcn_readfirstlane(tid >> 6), lane = tid & 63, wr = wid >> 2, wc = wid & 3, fr = lane & 15, fq = lane >> 4;
    const int K = g.K, nt = K / BK;
    unsigned voffA[2], voffB[2];
#pragma unroll
    for (int i = 0; i < 2; ++i) { int R, C; stage_rc(tid * 16 + i * 8192, R, C); const int Rb = Epi::PERM ? ((R & ~31) + perm32(R & 31)) : R;
        voffA[i] = (unsigned)(R * K + C) * 2u; voffB[i] = (unsigned)(Rb * K + C) * 2u; }
    const size_t kstep = (size_t)(BK * 2);
    const size_t hstep = (size_t)HALF * K * 2;
    const size_t tstep = 2 * hstep;
    const unsigned ldsw = (unsigned)wid * 1024u;
    const int aoff = lds_byte(wr * 64 + fr, fq * 8), boff = lds_byte(wc * 32 + fr, fq * 8);
#define PG8_SA(b, h) (((b) * 2 + (h)) * HTB)
#define PG8_SB(b, h) ((4 + (b) * 2 + (h)) * HTB)
#define PG8_STAGE(bufoff, gbase, voff) do { _Pragma("unroll") for (int _i = 0; _i < 2; ++_i) \
        __builtin_amdgcn_global_load_lds((const unsigned*)((const char*)(gbase) + (voff)[_i]), (PG8_LAS unsigned*)(lds + (bufoff) + ldsw + _i * 8192), 16, 0, 0); } while (0)
#define PG8_LDA(dst, b, h) do { _Pragma("unroll") for (int m = 0; m < 4; ++m) _Pragma("unroll") for (int k = 0; k < 2; ++k) dst[m][k] = *(const PG8_LAS bf16x8*)(lds + PG8_SA(b, h) + aoff + m * 2048 + k * 1024); } while (0)
#define PG8_LDB(dst, b, h) do { _Pragma("unroll") for (int n = 0; n < 2; ++n) _Pragma("unroll") for (int k = 0; k < 2; ++k) dst[n][k] = *(const PG8_LAS bf16x8*)(lds + PG8_SB(b, h) + boff + n * 2048 + k * 1024); } while (0)
#define PG8_MMA(ai, bj, At, Bt) do { __builtin_amdgcn_s_setprio(1); _Pragma("unroll") for (int m = 0; m < 4; ++m) _Pragma("unroll") for (int n = 0; n < 2; ++n) _Pragma("unroll") for (int k = 0; k < 2; ++k) \
        acc[ai][bj][m][n] = __builtin_amdgcn_mfma_f32_16x16x32_bf16(Bt[n][k], At[m][k], acc[ai][bj][m][n], 0, 0, 0); __builtin_amdgcn_s_setprio(0); } while (0)
#define PG8_WAIT_V(n) asm volatile("s_waitcnt vmcnt(" #n ")" ::: "memory")
#define PG8_WAIT_L(n) asm volatile("s_waitcnt lgkmcnt(" #n ")" ::: "memory")
#define PG8_BAR __builtin_amdgcn_s_barrier()
#define PG8_SCHED __builtin_amdgcn_sched_barrier(0)
    Unit cur, nxt; int ui = 0;
    if (!S.next(0, cur)) return;
    f32x4 acc[2][2][4][2];
#pragma unroll
    for (int a = 0; a < 2; ++a)
#pragma unroll
        for (int b = 0; b < 2; ++b)
#pragma unroll
            for (int m = 0; m < 4; ++m)
#pragma unroll
                for (int n = 0; n < 2; ++n) acc[a][b][m][n] = (f32x4){0.f, 0.f, 0.f, 0.f};
    bf16x8 At[4][2], B0[2][2], B1[2][2];
    const char* cA = (const char*)g.A + (size_t)cur.pm * tstep; const char* cB = (const char*)g.Bt + (size_t)cur.pn * tstep;
    S.a_ready(cur);
    if constexpr (SP2) {
        PG8_STAGE(PG8_SB(0, 0), cB, voffB); PG8_STAGE(PG8_SB(0, 1), cB + hstep, voffB); PG8_STAGE(PG8_SA(0, 0), cA, voffA); PG8_STAGE(PG8_SA(0, 1), cA + hstep, voffA);
        if (wr == 1) PG8_BAR;
        PG8_WAIT_V(2); PG8_BAR;
        PG8_STAGE(PG8_SB(1, 0), cB + kstep, voffB); PG8_STAGE(PG8_SA(1, 0), cA + kstep, voffA); PG8_STAGE(PG8_SB(1, 1), cB + hstep + kstep, voffB);
        PG8_WAIT_V(6); PG8_BAR;
    } else {
        PG8_STAGE(PG8_SB(0, 0), cB, voffB); PG8_STAGE(PG8_SA(0, 0), cA, voffA); PG8_STAGE(PG8_SB(0, 1), cB + hstep, voffB); PG8_STAGE(PG8_SA(0, 1), cA + hstep, voffA);
        if (wr == 1) PG8_BAR;
        PG8_WAIT_V(4); PG8_BAR;
        PG8_STAGE(PG8_SB(1, 0), cB + kstep, voffB); PG8_STAGE(PG8_SA(1, 0), cA + kstep, voffA); PG8_STAGE(PG8_SB(1, 1), cB + hstep + kstep, voffB);
        PG8_WAIT_V(6); PG8_BAR;
    }
    for (;;) {
        const bool has_next = S.next(ui + 1, nxt);
        const char* nA = has_next ? (const char*)g.A + (size_t)nxt.pm * tstep : cA; const char* nB = has_next ? (const char*)g.Bt + (size_t)nxt.pn * tstep : cB;
        for (int t = 0; t < nt; t += 2) {
            const bool last = (t == nt - 2);
            const char* a1 = cA + (size_t)(t + 1) * kstep;
            const char* a2 = last ? nA : cA + (size_t)(t + 2) * kstep; const char* b2 = last ? nB : cB + (size_t)(t + 2) * kstep;
            const char* a3 = a2 + kstep; const char* b3 = b2 + kstep;
            if (last && has_next) S.a_ready(nxt);
            if constexpr (SP2) {
            PG8_LDB(B0, 0, 0); PG8_LDB(B1, 0, 1); PG8_SCHED; PG8_LDA(At, 0, 0); PG8_STAGE(PG8_SA(1, 1), a1 + hstep, voffA);
            PG8_WAIT_V(8); PG8_WAIT_L(0); PG8_BAR; PG8_MMA(0, 0, At, B0); PG8_MMA(0, 1, At, B1); PG8_BAR; PG8_SCHED;
            PG8_LDA(At, 0, 1); PG8_STAGE(PG8_SB(0, 0), b2, voffB); PG8_STAGE(PG8_SB(0, 1), b2 + hstep, voffB); PG8_STAGE(PG8_SA(0, 0), a2, voffA);
            PG8_WAIT_V(8); PG8_WAIT_L(0); PG8_BAR; PG8_MMA(1, 0, At, B0); PG8_MMA(1, 1, At, B1); PG8_BAR; PG8_SCHED;
            PG8_LDB(B0, 1, 0); PG8_LDB(B1, 1, 1); PG8_SCHED; PG8_LDA(At, 1, 0); PG8_STAGE(PG8_SA(0, 1), a2 + hstep, voffA);
            PG8_WAIT_V(8); PG8_WAIT_L(0); PG8_BAR; PG8_MMA(0, 0, At, B0); PG8_MMA(0, 1, At, B1); PG8_BAR; PG8_SCHED;
            PG8_LDA(At, 1, 1); PG8_STAGE(PG8_SB(1, 0), b3, voffB); PG8_STAGE(PG8_SB(1, 1), b3 + hstep, voffB); PG8_STAGE(PG8_SA(1, 0), a3, voffA);
            PG8_WAIT_V(8); PG8_WAIT_L(0); PG8_BAR; PG8_MMA(1, 0, At, B0); PG8_MMA(1, 1, At, B1); PG8_BAR; PG8_SCHED;
            } else {
            PG8_LDB(B0, 0, 0); PG8_SCHED; PG8_LDA(At, 0, 0); PG8_STAGE(PG8_SA(1, 1), a1 + hstep, voffA);
            PG8_WAIT_L(8); PG8_BAR; PG8_WAIT_L(0); PG8_MMA(0, 0, At, B0); PG8_BAR; PG8_SCHED;
            PG8_LDB(B1, 0, 1); PG8_STAGE(PG8_SB(0, 0), b2, voffB);
            PG8_BAR; PG8_WAIT_L(0); PG8_MMA(0, 1, At, B1); PG8_BAR;
            PG8_LDA(At, 0, 1); PG8_STAGE(PG8_SA(0, 0), a2, voffA);
            PG8_BAR; PG8_WAIT_L(0); PG8_MMA(1, 0, At, B0); PG8_BAR; PG8_SCHED;
            PG8_STAGE(PG8_SB(0, 1), b2 + hstep, voffB);
            PG8_WAIT_V(6); PG8_BAR; PG8_MMA(1, 1, At, B1); PG8_BAR;
            PG8_LDB(B0, 1, 0); PG8_SCHED; PG8_LDA(At, 1, 0); PG8_STAGE(PG8_SA(0, 1), a2 + hstep, voffA);
            PG8_WAIT_L(8); PG8_BAR; PG8_WAIT_L(0); PG8_MMA(0, 0, At, B0); PG8_BAR; PG8_SCHED;
            PG8_LDB(B1, 1, 1); PG8_STAGE(PG8_SB(1, 0), b3, voffB);
            PG8_BAR; PG8_WAIT_L(0); PG8_MMA(0, 1, At, B1); PG8_BAR;
            PG8_LDA(At, 1, 1); PG8_STAGE(PG8_SA(1, 0), a3, voffA);
            PG8_BAR; PG8_WAIT_L(0); PG8_MMA(1, 0, At, B0); PG8_BAR; PG8_SCHED;
            PG8_STAGE(PG8_SB(1, 1), b3 + hstep, voffB);
            PG8_WAIT_V(6); PG8_BAR; PG8_MMA(1, 1, At, B1); PG8_BAR;
            }
        }
        if constexpr (ALIGN_EPI) { if (wr == 0) PG8_BAR; }
        if constexpr (!Epi::AFTER_DRAIN) { E(acc, cur, wr, wc, fr, fq); S.done(cur); }
        if (!has_next) break;
#pragma unroll
        for (int a = 0; a < 2; ++a)
#pragma unroll
            for (int b = 0; b < 2; ++b)
#pragma unroll
                for (int m = 0; m < 4; ++m)
#pragma unroll
                    for (int n = 0; n < 2; ++n) acc[a][b][m][n] = (f32x4){0.f, 0.f, 0.f, 0.f};
        cur = nxt; cA = nA; cB = nB; ++ui;
        if constexpr (ALIGN_EPI) { if (wr == 1) PG8_BAR; }
    }
    PG8_WAIT_V(0);
    if constexpr (!ALIGN_EPI) { if (wr == 0) PG8_BAR; }
    PG8_BAR;
    if constexpr (Epi::AFTER_DRAIN) { E.fused(acc, cur, wr, wc, fr, fq, lds, wid, lane); S.done(cur); }
#undef PG8_SA
#undef PG8_SB
#undef PG8_STAGE
#undef PG8_LDA
#undef PG8_LDB
#undef PG8_MMA
#undef PG8_WAIT_V
#undef PG8_WAIT_L
#undef PG8_BAR
#undef PG8_SCHED
}
}
namespace attn_body {
using bf16=__hip_bfloat16;
using bf16x8=__attribute__((ext_vector_type(8)))short;
using s16x4=__attribute__((ext_vector_type(4)))short;
using f32x16=__attribute__((ext_vector_type(16)))float;
using u32x4=__attribute__((ext_vector_type(4)))unsigned;
constexpr int BATCH=16,NHEAD=8,SEQ=2048,D=64,DM=NHEAD*D;
constexpr int OPITCH=1024,OCOL=512;
constexpr int NW=8,QBLK=32,QB=QBLK*NW,KVBLK=64,NQB=SEQ/QB;
constexpr int ATTN_PITCH=DM, ATTN_UNIT_ROWS=QB;
__device__ __forceinline__ int crow(int r,int hi){return (r&3)+8*(r>>2)+4*hi;}
#define SBAR() __builtin_amdgcn_sched_barrier(0)
__device__ __forceinline__ void cmask(f32x16&p0,f32x16&p1,int jb,int qrel,int hi){
  const float NEG=-INFINITY; int kb=64*jb+4*hi; asm volatile("":"+v"(kb));
  #pragma unroll
  for(int r=0;r<16;++r){int kv=kb+(r&3)+8*(r>>2); if(kv>qrel)p0[r]=NEG; if(kv+32>qrel)p1[r]=NEG;}
}

constexpr int NSLOT=3, SLOTB=8192;
constexpr int LDS_K=0, LDS_V=NSLOT*SLOTB, LDS_WS=2*NSLOT*SLOTB, LDS_OST=LDS_WS+NW*64*4, LDS_KB=LDS_OST+NW*4096, LDS_BYTES=LDS_KB+SEQ*4;
constexpr float FLOOR=-2048.f, LOG2E_=1.4426950408889634f, ACP_T=24.f;
constexpr float C2=0.125f*1.4426950408889634f;
__device__ __forceinline__ void glds16(const void*gsrc,unsigned lds_dst){unsigned keep;
  asm volatile("s_mov_b32 %0, m0\n\ts_mov_b32 m0, %2\n\ts_nop 0\n\tglobal_load_lds_dwordx4 %1, off\n\ts_mov_b32 m0, %0":"=&s"(keep):"v"(gsrc),"s"(lds_dst):"memory");}
__device__ __forceinline__ void glds16s(const void*sbase,unsigned voff,unsigned lds_dst){unsigned keep;
  asm volatile("s_mov_b32 %0, m0\n\ts_mov_b32 m0, %3\n\ts_nop 0\n\tglobal_load_lds_dwordx4 %1, %2\n\ts_mov_b32 m0, %0":"=&s"(keep):"v"(voff),"s"(sbase),"s"(lds_dst):"memory");}
__device__ __forceinline__ float max3f(float a,float b,float c){float r;asm("v_max3_f32 %0, %1, %2, %3":"=v"(r):"v"(a),"v"(b),"v"(c));return r;}
__device__ __forceinline__ float max2f(float a,float b){float r;asm("v_max_f32_e32 %0, %1, %2":"=v"(r):"v"(a),"v"(b));return r;}
__device__ __forceinline__ float fadd_s(float a,float b){float r;asm("v_add_f32_e32 %0, %1, %2":"=v"(r):"v"(a),"v"(b));return r;}
__device__ __forceinline__ float fsub_s(float a,float b){float r;asm("v_sub_f32_e32 %0, %1, %2":"=v"(r):"v"(a),"v"(b));return r;}
typedef float f32x2_t __attribute__((ext_vector_type(2))); typedef float f32x4_t __attribute__((ext_vector_type(4))); typedef __bf16 bf16x2_t __attribute__((ext_vector_type(2)));
__device__ __forceinline__ unsigned cvtpk_s(float lo,float hi){f32x2_t v={lo,hi};bf16x2_t b=__builtin_convertvector(v,bf16x2_t);return __builtin_bit_cast(unsigned,b);}
#define WAIT_BAR(N) asm volatile("s_waitcnt vmcnt(" #N ") lgkmcnt(0)\n\ts_barrier":::"memory")

__device__ __forceinline__ void qkt(f32x16&p0,f32x16&p1,const char*Kslot,const bf16x8*qr,int r32,int hi){
  const char*kb=Kslot+hi*1024+r32*16;
  #pragma unroll
  for(int d0=0;d0<4;++d0){
    const bf16x8 b0=*reinterpret_cast<const bf16x8*>(kb+d0*2048);
    const bf16x8 b1=*reinterpret_cast<const bf16x8*>(kb+d0*2048+512);
    {p0=__builtin_amdgcn_mfma_f32_32x32x16_bf16(b0,qr[d0],p0,0,0,0);p1=__builtin_amdgcn_mfma_f32_32x32x16_bf16(b1,qr[d0],p1,0,0,0);}}
}
typedef __attribute__((address_space(3))) const char* lds_cptr;
typedef short v4i16_t __attribute__((ext_vector_type(4)));
__device__ __forceinline__ void kload8(bf16x8*kf,lds_cptr kp){
  kf[0]=*(const __attribute__((address_space(3))) bf16x8*)(kp);      kf[1]=*(const __attribute__((address_space(3))) bf16x8*)(kp+512);
  kf[2]=*(const __attribute__((address_space(3))) bf16x8*)(kp+2048); kf[3]=*(const __attribute__((address_space(3))) bf16x8*)(kp+2560);
  kf[4]=*(const __attribute__((address_space(3))) bf16x8*)(kp+4096); kf[5]=*(const __attribute__((address_space(3))) bf16x8*)(kp+4608);
  kf[6]=*(const __attribute__((address_space(3))) bf16x8*)(kp+6144); kf[7]=*(const __attribute__((address_space(3))) bf16x8*)(kp+6656);
}
__device__ __forceinline__ void kload2(bf16x8*kf,lds_cptr kp,int j){ kf[2*j]=*(const __attribute__((address_space(3))) bf16x8*)(kp+j*2048); kf[2*j+1]=*(const __attribute__((address_space(3))) bf16x8*)(kp+j*2048+512); }
__device__ __forceinline__ s16x4 vtr(lds_cptr p){ return __builtin_bit_cast(s16x4,__builtin_amdgcn_ds_read_tr16_b64_v4i16((__attribute__((address_space(3))) v4i16_t*)p)); }
__device__ __forceinline__ float rowmax(const f32x16&p0,const f32x16&p1){
  float a=max3f(p0[0],p0[1],p1[0]),b=max3f(p0[2],p0[3],p1[1]);a=max3f(a,p1[2],p1[3]);
  #pragma unroll
  for(int r=4;r<16;r+=4){a=max3f(a,p0[r],p0[r+1]);b=max3f(b,p0[r+2],p0[r+3]);a=max3f(a,p1[r],p1[r+1]);b=max3f(b,p1[r+2],p1[r+3]);}
  const float m=max2f(a,b);
  auto rr=__builtin_amdgcn_permlane32_swap(__float_as_uint(m),__float_as_uint(m),false,false);
  return max2f(__uint_as_float(rr[0]),__uint_as_float(rr[1]));
}
__device__ __forceinline__ void pv(f32x16*o,int vb,bf16x8 pa0,bf16x8 pa1,bf16x8 pa2,bf16x8 pa3){
  #pragma unroll
  for(int d0=0;d0<2;++d0){s16x4 lo[4],hi[4];
    #pragma unroll
    for(int ks=0;ks<4;++ks){
      asm volatile("ds_read_b64_tr_b16 %0,%1 offset:%c2":"=&v"(lo[ks]):"v"(vb),"i"(d0*4096+ks*1024):"memory");
      asm volatile("ds_read_b64_tr_b16 %0,%1 offset:%c2":"=&v"(hi[ks]):"v"(vb),"i"(d0*4096+ks*1024+512):"memory");}
    asm volatile("s_waitcnt lgkmcnt(0)":::"memory");SBAR();
    #define PK(k) (bf16x8){lo[k][0],lo[k][1],lo[k][2],lo[k][3],hi[k][0],hi[k][1],hi[k][2],hi[k][3]}
    o[d0]=__builtin_amdgcn_mfma_f32_32x32x16_bf16(pa0,PK(0),o[d0],0,0,0);
    o[d0]=__builtin_amdgcn_mfma_f32_32x32x16_bf16(pa1,PK(1),o[d0],0,0,0);
    o[d0]=__builtin_amdgcn_mfma_f32_32x32x16_bf16(pa2,PK(2),o[d0],0,0,0);
    o[d0]=__builtin_amdgcn_mfma_f32_32x32x16_bf16(pa3,PK(3),o[d0],0,0,0);
    #undef PK
  }
}

#ifndef ATTN_STORE16
#define ATTN_STORE16(p,v) (*(u32x4*)(p)=(v))
#endif
template<int THRL> __device__ __forceinline__ void attn_unit(int b,int h,int qb,const bf16*Q,const bf16*__restrict__ K,const bf16*__restrict__ V,const bf16*__restrict__ G,const float*__restrict__ CC,const float qm2,const float km2,bf16*O,char*shm,gu32*qctr,volatile LAS unsigned*qslot){
  int tid_=threadIdx.x; asm volatile("":"+v"(tid_));
  const int tid=tid_,lane=tid&63,r32=lane&31,hi=lane>>5; const int wid=__builtin_amdgcn_readfirstlane(tid>>6);
  const long rowbase=(long)b*SEQ; const int q0=qb*QB;
  const bf16*Qw=Q+(rowbase+q0+wid*QBLK)*DM+h*D;
  const bf16*Kh=K+rowbase*DM+h*D,*Vh=V+rowbase*DM+h*D;
  const unsigned lds0=(unsigned)(uintptr_t)shm;
  float*wsf=(float*)(shm+LDS_WS)+wid*64;
  const unsigned kvoff=(unsigned)(lane*DM+wid*8)*2u, vvoff=(unsigned)((16*(wid&3)+(lane>>2))*DM+(wid>>2)*32+(lane&3)*8)*2u;
  const char*Khb=(const char*)Kh,*Vhb=(const char*)Vh;
  const unsigned kdst=lds0+LDS_K+wid*1024, vdst=lds0+LDS_V+wid*1024;
  #define DMA_K(t,slot) glds16s(Khb+(long)(NT-1-(t))*(KVBLK*DM*2),kvoff,(unsigned)__builtin_amdgcn_readfirstlane(kdst+(slot)))
  #define DMA_V(t,slot) glds16s(Vhb+(long)(NT-1-(t))*(KVBLK*DM*2),vvoff,(unsigned)__builtin_amdgcn_readfirstlane(vdst+(slot)))
  const char*Kbase=shm+LDS_K; bf16x8 kf[8];
  const lds_cptr shm3=(lds_cptr)shm; const lds_cptr kp0=shm3+LDS_K+hi*1024+r32*16; const lds_cptr vp0=shm3+LDS_V+((lane>>4)&1)*32+(lane&3)*8+(4*hi+((lane&15)>>2))*64;
  const int NT=(q0+QB)/KVBLK;
  DMA_K(0,0);DMA_V(0,0);DMA_K(1,SLOTB);
  int NTE=NT;
  { const float*cc=CC+(long)(b*NHEAD+h)*SEQ; const float cref=cc[q0]; float*kbw=(float*)(shm+LDS_KB);
    const float clast=cc[64*(lane<NT?lane:0)+63];
    float cv[4];
    #pragma unroll
    for(int i=0;i<4;++i){const int k=tid+i*NW*64; cv[i]=(k<q0+QB)?cc[k]:0.f;}
    const float QK=2.04f*sqrtf(qm2*km2); const float bound=-(ACP_T+2.f*QK);
    const bool sk=(lane<NT)&&((cref-clast)*LOG2E_<bound);
    const unsigned long long bal=__ballot(sk); const int j0=__builtin_ctzll(~bal);
    NTE=NT-j0; NTE+=NTE&1; if(NTE<4)NTE=4; NTE=__builtin_amdgcn_readfirstlane(NTE);
    #pragma unroll
    for(int i=0;i<4;++i){const int k=tid+i*NW*64; if(k<q0+QB)kbw[k]=(cref-cv[i])*LOG2E_;} }
  const lds_cptr kbp=(lds_cptr)shm+LDS_KB+hi*16;
  #define CINIT(C0,C1,tt) do{ const lds_cptr kq_=kbp+(NT-1-(tt))*256; const float nm_=-mhat; \
    _Pragma("unroll") for(int g_=0;g_<4;++g_){ const f32x4_t a_=*(const __attribute__((address_space(3))) f32x4_t*)(kq_+g_*32); const f32x4_t b_=*(const __attribute__((address_space(3))) f32x4_t*)(kq_+128+g_*32); \
      C0[4*g_]=a_[0]+nm_;C0[4*g_+1]=a_[1]+nm_;C0[4*g_+2]=a_[2]+nm_;C0[4*g_+3]=a_[3]+nm_; C1[4*g_]=b_[0]+nm_;C1[4*g_+1]=b_[1]+nm_;C1[4*g_+2]=b_[2]+nm_;C1[4*g_+3]=b_[3]+nm_; } }while(0)
  bf16x8 qr[4];
  #pragma unroll
  for(int d0=0;d0<4;++d0)qr[d0]=*reinterpret_cast<const bf16x8*>(&Qw[(long)r32*DM+d0*16+hi*8]);
  float mhat=0.f,l_reg=0.f;f32x16 o[2];o[0]=f32x16{};o[1]=f32x16{};
  float qkrow; { float n2=0.f;
    #pragma unroll
    for(int d0=0;d0<4;++d0){
      #pragma unroll
      for(int e=0;e<8;++e){const float x=__uint_as_float((unsigned)(unsigned short)qr[d0][e]<<16); n2+=x*x;} }
    auto rr=__builtin_amdgcn_permlane32_swap(__float_as_uint(n2),__float_as_uint(n2),false,false); n2=__uint_as_float(rr[0])+__uint_as_float(rr[1]);
    qkrow=1.02f*sqrtf(n2)*sqrtf(2.f*km2); }
  const int qrel=wid*QBLK+r32;
  #define CMASK(P0,P1,t) do{int jb_=3-(t); if(jb_>=0)cmask(P0,P1,jb_,qrel,hi);}while(0)
  bool resc=false;
  #define START(P0,P1) do{ const float rm=rowmax(P0,P1); resc=false; \
    { const float dl=__builtin_fmaxf(rm,FLOOR); mhat=fadd_s(mhat,dl); \
      _Pragma("unroll") for(int r=0;r<16;++r){P0[r]=fsub_s(P0[r],dl);P1[r]=fsub_s(P1[r],dl);} } \
    _Pragma("unroll") for(int r=0;r<16;++r)P0[r]=__builtin_amdgcn_exp2f(P0[r]); }while(0)
  #define RESC() do{ if(resc){ asm volatile("s_waitcnt lgkmcnt(0)":::"memory"); \
      _Pragma("unroll") for(int d_=0;d_<2;++d_) _Pragma("unroll") for(int r=0;r<16;++r)o[d_][r]*=wsf[crow(r,hi)]; } }while(0)
  f32x16 pA0,pA1,pB0,pB1;
  int sl_prev=0,sl_cur=0,sl_next=SLOTB;
  #define ROT() do{sl_prev=sl_cur;sl_cur=sl_next;sl_next=(sl_next==(NSLOT-1)*SLOTB)?0:sl_next+SLOTB;}while(0)
  DMA_K(2,2*SLOTB);
  WAIT_BAR(3);
  CINIT(pA0,pA1,0); qkt(pA0,pA1,Kbase,qr,r32,hi);asm volatile("s_nop 15\n\ts_nop 7":"+v"(pA0),"+v"(pA1));CMASK(pA0,pA1,0);
  START(pA0,pA1);
  _Pragma("unroll") for(int r=0;r<16;++r)pA1[r]=__builtin_amdgcn_exp2f(pA1[r]);
  WAIT_BAR(0);
  DMA_K(3,0);DMA_V(1,SLOTB);
  ROT();
  kload8(kf,kp0+sl_cur);
  WAIT_BAR(2);
  s16x4 vlo[8],vhi[8]; u32x4 pw0,pw1,pw2,pw3;
  #define PKW(P,B) cvtpk_s(P[B],P[B+1])
  #define PAF(k) __builtin_bit_cast(bf16x8,pw##k)
  #define VFR(i) (bf16x8){vlo[i][0],vlo[i][1],vlo[i][2],vlo[i][3],vhi[i][0],vhi[i][1],vhi[i][2],vhi[i][3]}
  #define PIN(x) asm volatile("":"+v"(x))
  #define MX3(a,b,c) __builtin_fmaxf(__builtin_fmaxf((a),(b)),(c))
  #define GAPA(MF,A0,A1,A2,A3,W0,W1,PW) do{ MF; sacc+=A0; sacc+=A1; sacc+=A2; sacc+=A3; PIN(sacc); W0; W1; PIN(PW); SBAR(); }while(0)
  #define EX(v) __builtin_amdgcn_exp2f(v)
  #define GAPB(MF,X,B) do{ MF; X[B]=EX(X[B]); X[B+1]=EX(X[B+1]); X[B+2]=EX(X[B+2]); X[B+3]=EX(X[B+3]); PIN(X); SBAR(); }while(0)
  #define VRD(i) do{ vlo[i]=vtr(vp_+(((i)>>2)*4096+((i)&3)*1024)); vhi[i]=vtr(vp_+(((i)>>2)*4096+((i)&3)*1024+512)); }while(0)
  #define KRD(G,j) do{ if(G){ kload2(kf,kp0+sl_next,j); SBAR(); } }while(0)
  #define STEP(C0,C1,P0,P1,t,GK,GV,GL) do{ SBAR(); \
    CINIT(C0,C1,t); SBAR(); \
    const lds_cptr vp_=vp0+sl_prev; \
    VRD(0); SBAR(); float sacc=(P0[0]+P0[1]); \
    GAPA(C0=__builtin_amdgcn_mfma_f32_32x32x16_bf16(kf[0],qr[0],C0,0,0,0), P0[2],P0[3],P0[4],P0[5],     pw0[0]=PKW(P0,0), pw0[1]=PKW(P0,2), pw0); \
    VRD(4); SBAR(); GAPA(C1=__builtin_amdgcn_mfma_f32_32x32x16_bf16(kf[1],qr[0],C1,0,0,0), P0[6],P0[7],P0[8],P0[9],     pw0[2]=PKW(P0,4), pw0[3]=PKW(P0,6), pw0); \
    VRD(1); SBAR(); GAPA(C0=__builtin_amdgcn_mfma_f32_32x32x16_bf16(kf[2],qr[1],C0,0,0,0),   P0[10],P0[11],P0[12],P0[13], pw1[0]=PKW(P0,8), pw1[1]=PKW(P0,10), pw1); \
    VRD(5); SBAR(); GAPA(C1=__builtin_amdgcn_mfma_f32_32x32x16_bf16(kf[3],qr[1],C1,0,0,0),   P0[14],P0[15],P1[0],P1[1],   pw1[2]=PKW(P0,12),pw1[3]=PKW(P0,14), pw1); \
    VRD(2); SBAR(); GAPA(C0=__builtin_amdgcn_mfma_f32_32x32x16_bf16(kf[4],qr[2],C0,0,0,0),   P1[2],P1[3],P1[4],P1[5],     pw2[0]=PKW(P1,0), pw2[1]=PKW(P1,2), pw2); \
    VRD(6); SBAR(); GAPA(C1=__builtin_amdgcn_mfma_f32_32x32x16_bf16(kf[5],qr[2],C1,0,0,0),   P1[6],P1[7],P1[8],P1[9],     pw2[2]=PKW(P1,4), pw2[3]=PKW(P1,6), pw2); \
    VRD(3); SBAR(); GAPA(C0=__builtin_amdgcn_mfma_f32_32x32x16_bf16(kf[6],qr[3],C0,0,0,0),   P1[10],P1[11],P1[12],P1[13], pw3[0]=PKW(P1,8), pw3[1]=PKW(P1,10), pw3); \
    VRD(7); SBAR(); GAPA(C1=__builtin_amdgcn_mfma_f32_32x32x16_bf16(kf[7],qr[3],C1,0,0,0),   P1[14],P1[15],0.f,0.f,       pw3[2]=PKW(P1,12),pw3[3]=PKW(P1,14), pw3); \
    l_reg+=sacc; \
    if(GK){DMA_K((t)+3,sl_cur);} if(GV){DMA_V((t)+1,sl_next);} \
    CMASK(C0,C1,t); \
    { float a=MX3(C0[0],C0[1],C1[0]),b=MX3(C0[2],C0[3],C1[1]); a=MX3(a,C1[2],C1[3]); \
      _Pragma("unroll") for(int r=4;r<16;r+=4){a=MX3(a,C0[r],C0[r+1]);b=MX3(b,C0[r+2],C0[r+3]);a=MX3(a,C1[r],C1[r+1]);b=MX3(b,C1[r+2],C1[r+3]);} \
      float rm=__builtin_fmaxf(a,b); { auto rr=__builtin_amdgcn_permlane32_swap(__float_as_uint(rm),__float_as_uint(rm),false,false); rm=__builtin_fmaxf(__uint_as_float(rr[0]),__uint_as_float(rr[1])); } \
      resc=false; \
      if(__builtin_expect(__any(rm>(float)THRL),0)){ const float dl=__builtin_fmaxf(rm,0.f); mhat+=dl; \
        _Pragma("unroll") for(int r=0;r<16;++r){C0[r]-=dl;C1[r]-=dl;} \
        const float f=__builtin_amdgcn_exp2f(-dl); l_reg*=f; if(hi==0)wsf[r32]=f; resc=true; } } \
    SBAR(); \
    GAPB(o[0]=__builtin_amdgcn_mfma_f32_32x32x16_bf16(PAF(0),VFR(0),o[0],0,0,0), C0,0); \
    GAPB(o[1]=__builtin_amdgcn_mfma_f32_32x32x16_bf16(PAF(0),VFR(4),o[1],0,0,0), C0,4); \
    KRD(GL,0); GAPB(o[0]=__builtin_amdgcn_mfma_f32_32x32x16_bf16(PAF(1),VFR(1),o[0],0,0,0), C0,8); \
    KRD(GL,1); GAPB(o[1]=__builtin_amdgcn_mfma_f32_32x32x16_bf16(PAF(1),VFR(5),o[1],0,0,0), C0,12); \
    KRD(GL,2); GAPB(o[0]=__builtin_amdgcn_mfma_f32_32x32x16_bf16(PAF(2),VFR(2),o[0],0,0,0), C1,0); \
    KRD(GL,3); GAPB(o[1]=__builtin_amdgcn_mfma_f32_32x32x16_bf16(PAF(2),VFR(6),o[1],0,0,0), C1,4); \
    GAPB(o[0]=__builtin_amdgcn_mfma_f32_32x32x16_bf16(PAF(3),VFR(3),o[0],0,0,0), C1,8); \
    GAPB(o[1]=__builtin_amdgcn_mfma_f32_32x32x16_bf16(PAF(3),VFR(7),o[1],0,0,0), C1,12); \
    }while(0)
  int t=1;
  #define ENDW(tt) do{ if((tt)+3<NTE){WAIT_BAR(2);} else if((tt)+2<NTE){WAIT_BAR(1);} else {WAIT_BAR(0);} }while(0)
  for(;t<5&&t+1<NTE;t+=2){
    STEP(pB0,pB1,pA0,pA1,t,(t+3<NTE),(t+1<NTE),(t+1<NTE));       ENDW(t);   RESC(); ROT();
    if(t==3&&NTE>6){
      float sl=mhat-qkrow;
      sl=fminf(sl,__uint_as_float(__builtin_amdgcn_update_dpp(__float_as_uint(sl),__float_as_uint(sl),0xB1,0xf,0xf,false)));
      sl=fminf(sl,__uint_as_float(__builtin_amdgcn_update_dpp(__float_as_uint(sl),__float_as_uint(sl),0x4E,0xf,0xf,false)));
      sl=fminf(sl,__uint_as_float(__builtin_amdgcn_update_dpp(__float_as_uint(sl),__float_as_uint(sl),0x124,0xf,0xf,false)));
      sl=fminf(sl,__uint_as_float(__builtin_amdgcn_update_dpp(__float_as_uint(sl),__float_as_uint(sl),0x128,0xf,0xf,false)));
      { auto r_=__builtin_amdgcn_permlane16_swap(__float_as_uint(sl),__float_as_uint(sl),false,false); sl=fminf(__uint_as_float(r_[0]),__uint_as_float(r_[1])); }
      { auto r_=__builtin_amdgcn_permlane32_swap(__float_as_uint(sl),__float_as_uint(sl),false,false); sl=fminf(__uint_as_float(r_[0]),__uint_as_float(r_[1])); }
      if(lane==0)wsf[32]=sl;
      asm volatile("s_waitcnt lgkmcnt(0)\n\ts_barrier":::"memory");
      float smin=((const float*)(shm+LDS_WS))[32];
      #pragma unroll
      for(int w_=1;w_<NW;++w_)smin=fminf(smin,((const float*)(shm+LDS_WS))[w_*64+32]);
      const float kl=((const float*)(shm+LDS_KB))[64*(lane<NT?lane:0)+63];
      const bool sk2=(lane<NT)&&(kl<smin-ACP_T);
      const unsigned long long bal2=__ballot(sk2); int n2_=NT-__builtin_ctzll(~bal2); n2_+=n2_&1; if(n2_<6)n2_=6;
      n2_=__builtin_amdgcn_readfirstlane(n2_); if(n2_<NTE)NTE=n2_;
    }
    STEP(pA0,pA1,pB0,pB1,t+1,(t+4<NTE),(t+2<NTE),(t+2<NTE));     ENDW(t+1); RESC(); ROT();
  }
  #undef CMASK
  #define CMASK(P0,P1,t) do{}while(0)
  for(;t+5<NTE;t+=2){
    STEP(pB0,pB1,pA0,pA1,t,true,true,true);     WAIT_BAR(2); RESC(); ROT();
    STEP(pA0,pA1,pB0,pB1,t+1,true,true,true);   WAIT_BAR(2); RESC(); ROT();
  }
  #undef CMASK
  #define CMASK(P0,P1,t) do{int jb_=3-(t); if(jb_>=0)cmask(P0,P1,jb_,qrel,hi);}while(0)
  for(;t+1<NTE;t+=2){
    STEP(pB0,pB1,pA0,pA1,t,(t+3<NTE),(t+1<NTE),(t+1<NTE));       ENDW(t);   RESC(); ROT();
    STEP(pA0,pA1,pB0,pB1,t+1,(t+4<NTE),(t+2<NTE),(t+2<NTE));     ENDW(t+1); RESC(); ROT();
  }
  const bf16*Gw=G+(rowbase+q0+wid*QBLK)*DM+h*D; u32x4 gpre[4];
  { int lane_g=lane; asm volatile("":"+v"(lane_g));
    #pragma unroll
    for(int i=0;i<4;++i)gpre[i]=*(const u32x4*)(Gw+(long)(i*8+(lane_g>>3))*DM+(lane_g&7)*8); }
  unsigned qnext=0u; if(tid==0)qnext=__hip_atomic_fetch_add(qctr,1u,__ATOMIC_RELAXED,__HIP_MEMORY_SCOPE_AGENT);
  STEP(pB0,pB1,pA0,pA1,NTE-1,false,false,false); RESC();
  { float sacc=pB0[0]+pB0[1]; _Pragma("unroll") for(int r=2;r<16;++r)sacc+=pB0[r]; _Pragma("unroll") for(int r=0;r<16;++r)sacc+=pB1[r]; l_reg+=sacc;
    pw0=(u32x4){PKW(pB0,0),PKW(pB0,2),PKW(pB0,4),PKW(pB0,6)};pw1=(u32x4){PKW(pB0,8),PKW(pB0,10),PKW(pB0,12),PKW(pB0,14)};pw2=(u32x4){PKW(pB1,0),PKW(pB1,2),PKW(pB1,4),PKW(pB1,6)};pw3=(u32x4){PKW(pB1,8),PKW(pB1,10),PKW(pB1,12),PKW(pB1,14)};
    SBAR(); pv(o,(int)(unsigned)(size_t)vp0+sl_cur,PAF(0),PAF(1),PAF(2),PAF(3)); }
  #undef PKW
  #undef PAF
  #undef VFR
  #undef PIN
  #undef MX3
  #undef GAPA
  #undef GAPB
  #undef EX
  #undef VRD
  #undef KRD
  #undef STEP
  #undef ENDW
  {auto rr=__builtin_amdgcn_permlane32_swap(__float_as_uint(l_reg),__float_as_uint(l_reg),false,false);l_reg=__uint_as_float(rr[0])+__uint_as_float(rr[1]);}
  if(hi==0)wsf[32+r32]=l_reg;asm volatile("s_waitcnt lgkmcnt(0)":::"memory");
  float rli[16];
  #pragma unroll
  for(int r=0;r<16;++r)rli[r]=__builtin_amdgcn_rcpf(wsf[32+crow(r,hi)]);
  bf16*Ow=O+(rowbase+q0+wid*QBLK)*OPITCH+OCOL+h*D;
  { bf16*stg=(bf16*)(shm+LDS_OST)+wid*2048;
    #pragma unroll
    for(int r=0;r<16;++r){const int orow=crow(r,hi);
      #pragma unroll
      for(int d0=0;d0<2;++d0)stg[orow*64+d0*32+r32]=__float2bfloat16(o[d0][r]*rli[r]);}
    asm volatile("s_waitcnt lgkmcnt(0)":::"memory");
    int lane_e=lane; asm volatile("":"+v"(lane_e));
    #pragma unroll
    for(int i=0;i<4;++i){const int row=i*8+(lane_e>>3),ch=lane_e&7; const u32x4 v=*(const u32x4*)(stg+row*64+ch*8); const u32x4 g=gpre[i]; u32x4 w;
      #pragma unroll
      for(int e=0;e<4;++e){ const float lo=__uint_as_float(v[e]<<16)*__uint_as_float(g[e]<<16), hi_=__uint_as_float(v[e]&0xffff0000u)*__uint_as_float(g[e]&0xffff0000u); w[e]=cvtpk_s(lo,hi_); }
      ATTN_STORE16(Ow+(long)row*OPITCH+ch*8,w);} }
  if(tid==0)qslot[0]=qnext;
  asm volatile("s_waitcnt lgkmcnt(0)\n\ts_barrier":::"memory");
  #undef DMA_K
  #undef DMA_V
  #undef CMASK
  #undef START
  #undef RESC
  #undef ROT
}
constexpr int ATTN_LDS_BYTES=LDS_BYTES;
struct AttnTensors { const bf16* Q; const bf16* K; const bf16* V; const bf16* G; const float* CC; bf16* O; };
struct AttnUnit { int bh; int qb; };
struct StaticOrder {
  int vcu,G;
  __device__ __forceinline__ explicit StaticOrder(int grid,int block):vcu((grid%8==0)?(block%8)*(grid/8)+block/8:block),G(grid){}
  __device__ __forceinline__ bool next(int i,AttnUnit&u)const{ const int v=vcu+(i>>2)*G; if(v>=256)return false; const int s=2*(v&1),j=i&3; u.bh=v>>1; u.qb=(j==0)?7-s:(j==1)?s:(j==2)?6-s:s+1; return true; }
  __device__ __forceinline__ void a_ready(const AttnUnit&)const{}
  __device__ __forceinline__ void done(const AttnUnit&)const{}
};
template<class Sched,int THRL=8> __device__ __forceinline__ void attn_phase(char*lds,const AttnTensors&T,const Sched&S){
  AttnUnit u;
  for(int i=0;S.next(i,u);++i){ S.a_ready(u);   S.done(u); }
}
#undef SBAR
#undef WAIT_BAR
}
namespace hg {
typedef __attribute__((address_space(3))) unsigned char* lptr;
typedef short bf16x8 __attribute__((ext_vector_type(8)));
typedef short s16x4 __attribute__((ext_vector_type(4)));
typedef float f32x16 __attribute__((ext_vector_type(16)));
typedef float f32x4 __attribute__((ext_vector_type(4)));
typedef unsigned u32x4 __attribute__((ext_vector_type(4)));
typedef unsigned u32x2 __attribute__((ext_vector_type(2)));
constexpr int P = 144;
constexpr int L_QD = 0, L_QH = 9216, L_KD = 18432, L_KO = 27648, L_KHT = 32256, L_VT = 41472, L_ST = 50688, L_TOT = 59904, L_EB = 61952, L_SS = 62208, L_END = 62720;
__device__ __forceinline__ int crow(int r, int hi) { return (r & 3) + 8 * (r >> 2) + 4 * hi; }
typedef float f32x2_t __attribute__((ext_vector_type(2))); typedef __bf16 bf16x2_t __attribute__((ext_vector_type(2)));
__device__ __forceinline__ unsigned cvtpk(float lo, float hi) { f32x2_t v = {lo, hi}; bf16x2_t b = __builtin_convertvector(v, bf16x2_t); return __builtin_bit_cast(unsigned, b); }
__device__ __forceinline__ unsigned short cvt1(float x) { return (unsigned short)(cvtpk(x, 0.f) & 0xffffu); }
#define HG_MFMA(a, b, c) __builtin_amdgcn_mfma_f32_32x32x16_bf16((a), (b), (c), 0, 0, 0)

__device__ __forceinline__ void hgrn_item(int b, int h, const unsigned short* QA, const float* LF, const unsigned short* IA, const unsigned short* GA, const float* gnorm, unsigned short* MIX, unsigned char* shm_) {
    int tid_ = threadIdx.x; asm volatile("" : "+v"(tid_));
    const int tid = tid_, lane = tid & 63, w = __builtin_amdgcn_readfirstlane(tid >> 6), r = lane & 31, hh = lane >> 5;
    const lptr shm = (lptr)shm_;
    const int colh = h * 64 + lane;
    for (int e = tid; e < 64 * P / 4; e += 512) ((__attribute__((address_space(3))) unsigned*)(shm + L_ST))[e] = 0u;
    f32x16 S = {};
    const bool outw = w < 4; const int I = (w >> 1) & 1, vt = w & 1, dt = (w >> 1) & 1;
    f32x4 gnv[4];
    { const float* gn = gnorm + h * 64 + 32 * vt + 4 * hh;
#pragma unroll
      for (int g = 0; g < 4; ++g) gnv[g] = *(const f32x4*)(gn + 8 * g); }
    float nlf[8]; unsigned short nq[8], nv[8];
    { const size_t m0 = (size_t)b * SEQ + 8 * w;
#pragma unroll
      for (int i = 0; i < 8; ++i) { nlf[i] = LF[(m0 + i) * 256 + colh]; nq[i] = QA[(m0 + i) * 256 + colh]; nv[i] = IA[(m0 + i) * 256 + colh]; } }
    for (int c = 0; c < SEQ / 64; ++c) {
        const size_t row0 = (size_t)b * SEQ + c * 64;
        float l2[8]; unsigned short qv[8], vv[8];
#pragma unroll
        for (int i = 0; i < 8; ++i) { l2[i] = nlf[i] * LOG2E; qv[i] = nq[i]; vv[i] = nv[i]; }
        float cs[8]; { float s = 0.f;
#pragma unroll
            for (int i = 0; i < 8; ++i) { s += l2[i]; cs[i] = s; } }
        ((__attribute__((address_space(3))) float*)(shm + L_TOT))[w * 64 + lane] = cs[7];
        __syncthreads();
        float pre = 0.f, r1 = 0.f, blast = 0.f;
#pragma unroll
        for (int j = 0; j < 8; ++j) { const float t = ((__attribute__((address_space(3))) const float*)(shm + L_TOT))[j * 64 + lane]; if (j < w) pre += t; if (j < 4) r1 += t; blast += t; }
        const float er1 = __builtin_amdgcn_exp2f(r1), rI = (w >= 4) ? r1 : 0.f, e1 = (w >= 4) ? er1 : 1.0f, e2 = __builtin_amdgcn_exp2f(blast - rI);
        unsigned khp[4];
#pragma unroll
        for (int i = 0; i < 8; i += 2) {
            float kh2[2];
#pragma unroll
            for (int ii = 0; ii < 2; ++ii) {
                const int t = i + ii; const float bt = pre + cs[t]; const float f = __builtin_amdgcn_exp2f(l2[t]); const float k = 1.0f - f; const float q = __uint_as_float((unsigned)qv[t] << 16);
                const float qd = q * __builtin_amdgcn_exp2f(bt - rI), qh = qd * e1, kd = k * __builtin_amdgcn_exp2f(rI - bt);
                kh2[ii] = kd * e2;
                const int ro = (8 * w + t) * P + lane * 2;
                *(__attribute__((address_space(3))) unsigned short*)(shm + L_QD + ro) = cvt1(qd);
                *(__attribute__((address_space(3))) unsigned short*)(shm + L_QH + ro) = cvt1(qh);
                *(__attribute__((address_space(3))) unsigned short*)(shm + L_KD + ro) = cvt1(kd);
                if (w < 4) *(__attribute__((address_space(3))) unsigned short*)(shm + L_KO + ro) = cvt1(kd * er1);
            }
            khp[i >> 1] = cvtpk(kh2[0], kh2[1]);
        }
        *(__attribute__((address_space(3))) u32x4*)(shm + L_KHT + lane * P + w * 16) = (u32x4){khp[0], khp[1], khp[2], khp[3]};
        *(__attribute__((address_space(3))) u32x4*)(shm + L_VT + lane * P + w * 16) = (u32x4){(unsigned)vv[0] | ((unsigned)vv[1] << 16), (unsigned)vv[2] | ((unsigned)vv[3] << 16), (unsigned)vv[4] | ((unsigned)vv[5] << 16), (unsigned)vv[6] | ((unsigned)vv[7] << 16)};
        if (w == 0) ((__attribute__((address_space(3))) float*)(shm + L_EB))[lane] = __builtin_amdgcn_exp2f(blast);
        if (c + 1 < SEQ / 64) { const size_t m0 = row0 + 64 + 8 * w;
#pragma unroll
            for (int i = 0; i < 8; ++i) { nlf[i] = LF[(m0 + i) * 256 + colh]; nq[i] = QA[(m0 + i) * 256 + colh]; nv[i] = IA[(m0 + i) * 256 + colh]; } }
        __syncthreads();
        f32x16 OT = {}; u32x2 gt[4];
        if (outw) {
            { const unsigned short* gp = GA + (row0 + 32 * I + r) * 256 + h * 64 + 32 * vt + 4 * hh;
#pragma unroll
              for (int g = 0; g < 4; ++g) gt[g] = *(const u32x2*)(gp + 8 * g); }
#pragma unroll
            for (int J = 0; J < 2; ++J) {
                if (J <= I) {
                    const bool diag = (J == I);
                    const lptr kb = diag ? (shm + L_KD + (32 * J + r) * P + hh * 16) : (shm + L_KO + r * P + hh * 16);
                    const lptr qb = shm + L_QD + (32 * I + r) * P + hh * 16;
                    f32x16 XT = {};
#pragma unroll
                    for (int kk = 0; kk < 4; ++kk) XT = HG_MFMA(*(__attribute__((address_space(3))) const bf16x8*)(kb + kk * 32), *(__attribute__((address_space(3))) const bf16x8*)(qb + kk * 32), XT);
                    if (diag) {
#pragma unroll
                        for (int g = 0; g < 16; ++g) if (crow(g, hh) > r) XT[g] = 0.f;
                    }
                    const lptr vb = shm + L_VT + (32 * vt + r) * P + (32 * J + 4 * hh) * 2;
#pragma unroll
                    for (int sp = 0; sp < 2; ++sp) {
                        const u32x4 xb = {cvtpk(XT[8 * sp], XT[8 * sp + 1]), cvtpk(XT[8 * sp + 2], XT[8 * sp + 3]), cvtpk(XT[8 * sp + 4], XT[8 * sp + 5]), cvtpk(XT[8 * sp + 6], XT[8 * sp + 7])};
                        const u32x2 a0 = *(__attribute__((address_space(3))) const u32x2*)(vb + sp * 32), a1 = *(__attribute__((address_space(3))) const u32x2*)(vb + sp * 32 + 16);
                        const u32x4 av = {a0[0], a0[1], a1[0], a1[1]};
                        OT = HG_MFMA(__builtin_bit_cast(bf16x8, av), __builtin_bit_cast(bf16x8, xb), OT);
                    }
                }
            }
            { const lptr sb = shm + L_ST + (32 * vt + r) * P + hh * 16; const lptr qb = shm + L_QH + (32 * I + r) * P + hh * 16;
#pragma unroll
              for (int kk = 0; kk < 4; ++kk) OT = HG_MFMA(*(__attribute__((address_space(3))) const bf16x8*)(sb + kk * 32), *(__attribute__((address_space(3))) const bf16x8*)(qb + kk * 32), OT); }
            float s = 0.f;
#pragma unroll
            for (int g = 0; g < 16; ++g) s += OT[g] * OT[g];
            s += __shfl_xor(s, 32);
            if (hh == 0) ((__attribute__((address_space(3))) float*)(shm + L_SS))[(I * 2 + vt) * 32 + r] = s;
        } else {
#pragma unroll
            for (int g = 0; g < 4; ++g) { const f32x4 e = *(__attribute__((address_space(3))) const f32x4*)(shm + L_EB + (32 * dt + 8 * g + 4 * hh) * 4);
                S[4 * g] *= e[0]; S[4 * g + 1] *= e[1]; S[4 * g + 2] *= e[2]; S[4 * g + 3] *= e[3]; }
            const lptr ka = shm + L_KHT + (32 * dt + r) * P + hh * 16; const lptr vb = shm + L_VT + (32 * vt + r) * P + hh * 16;
#pragma unroll
            for (int kk = 0; kk < 4; ++kk) S = HG_MFMA(*(__attribute__((address_space(3))) const bf16x8*)(ka + kk * 32), *(__attribute__((address_space(3))) const bf16x8*)(vb + kk * 32), S);
        }
        __syncthreads();
        if (outw) {
            const float ss = ((__attribute__((address_space(3))) const float*)(shm + L_SS))[(I * 2) * 32 + r] + ((__attribute__((address_space(3))) const float*)(shm + L_SS))[(I * 2 + 1) * 32 + r];
            const float rstd = rsqrtf(ss * (1.0f / 64.0f) + NORM_EPS);
            unsigned short* op = MIX + (row0 + 32 * I + r) * DM + h * 64 + 32 * vt + 4 * hh;
#pragma unroll
            for (int g = 0; g < 4; ++g) { const f32x4 gv = gnv[g];
                const float y0 = OT[4 * g] * rstd * gv[0], y1 = OT[4 * g + 1] * rstd * gv[1], y2 = OT[4 * g + 2] * rstd * gv[2], y3 = OT[4 * g + 3] * rstd * gv[3];
                const unsigned p0 = cvtpk(y0, y1), p1 = cvtpk(y2, y3);
                const float z0 = __uint_as_float(p0 << 16) * __uint_as_float(gt[g][0] << 16), z1 = __uint_as_float(p0 & 0xffff0000u) * __uint_as_float(gt[g][0] & 0xffff0000u);
                const float z2 = __uint_as_float(p1 << 16) * __uint_as_float(gt[g][1] << 16), z3 = __uint_as_float(p1 & 0xffff0000u) * __uint_as_float(gt[g][1] & 0xffff0000u);
                *(u32x2*)(op + 8 * g) = (u32x2){cvtpk(z0, z1), cvtpk(z2, z3)}; }
        } else {
            const lptr sp = shm + L_ST + (32 * vt + r) * P + (32 * dt + 4 * hh) * 2;
#pragma unroll
            for (int g = 0; g < 4; ++g) *(__attribute__((address_space(3))) u32x2*)(sp + 16 * g) = (u32x2){cvtpk(S[4 * g], S[4 * g + 1]), cvtpk(S[4 * g + 2], S[4 * g + 3])};
        }
    }
    __syncthreads();
}
#undef HG_MFMA
}
namespace pl {
typedef __attribute__((address_space(3))) unsigned char* lptr;
typedef short bf16x8 __attribute__((ext_vector_type(8)));
typedef float f32x16 __attribute__((ext_vector_type(16)));
typedef float f32x4 __attribute__((ext_vector_type(4)));
typedef unsigned u32x4 __attribute__((ext_vector_type(4)));
typedef unsigned u32x2 __attribute__((ext_vector_type(2)));
constexpr int UP = 528, L_U = 0, L_P = 80 * UP, PP = 144, L_END = L_P + 4 * 64 * PP;
__device__ __forceinline__ float lo16(unsigned x) { return __uint_as_float(x << 16); }
__device__ __forceinline__ float hi16(unsigned x) { return __uint_as_float(x & 0xffff0000u); }
__device__ __forceinline__ void pool_item(int b, int tbeg, int ntile, const unsigned short* UB, const unsigned short* GB, const unsigned short* PWT, const float* pscale, unsigned short* MIX, unsigned char* shm_) {
    int tid_ = threadIdx.x; asm volatile("" : "+v"(tid_));
    const int tid = tid_, lane = tid & 63, w = __builtin_amdgcn_readfirstlane(tid >> 6), r = lane & 31, hh = lane >> 5;
    const lptr shm = (lptr)shm_;
    const int g = w >> 1, tt = w & 1;
    u32x4 uv[5]; u32x2 gtn[2][4];
#define PL_LOAD(T0) do { _Pragma("unroll") for (int i = 0; i < 5; ++i) { const int e = tid + 512 * i, j = e >> 5, ch = e & 31; const int t = (T0) - 16 + j; \
        uv[i] = (u32x4){0u, 0u, 0u, 0u}; if (t >= 0) uv[i] = *(const u32x4*)(UB + ((size_t)b * SEQ + t) * 256 + ch * 8); } \
      const unsigned short* gp_ = GB + ((size_t)b * SEQ + (T0) + 32 * tt + r) * 256 + g * 64 + 4 * hh; \
      _Pragma("unroll") for (int dt = 0; dt < 2; ++dt) _Pragma("unroll") for (int q = 0; q < 4; ++q) gtn[dt][q] = *(const u32x2*)(gp_ + 32 * dt + 8 * q); } while (0)
    PL_LOAD(tbeg);
    bf16x8 wa[2][4];
#pragma unroll
    for (int dt = 0; dt < 2; ++dt)
#pragma unroll
        for (int kk = 0; kk < 4; ++kk) wa[dt][kk] = *(const bf16x8*)(PWT + ((size_t)g * 64 + 32 * dt + r) * 64 + kk * 16 + hh * 8);
    for (int ti = 0; ti < ntile; ++ti) {
    const int t0 = tbeg + 64 * ti; const size_t row0 = (size_t)b * SEQ + t0;
    u32x2 gt[2][4];
#pragma unroll
    for (int dt = 0; dt < 2; ++dt)
#pragma unroll
        for (int q = 0; q < 4; ++q) gt[dt][q] = gtn[dt][q];
#pragma unroll
    for (int i = 0; i < 5; ++i) { const int e = tid + 512 * i, j = e >> 5, ch = e & 31; *(__attribute__((address_space(3))) u32x4*)(shm + L_U + j * UP + ch * 16) = uv[i]; }
    __syncthreads();
    if (ti + 1 < ntile) PL_LOAD(t0 + 64);
    { const int cp = tid & 127, qtr = tid >> 7, gg = cp >> 5, win = 2 << gg, tl0 = 16 * qtr;
      const lptr up = shm + L_U + cp * 4; const lptr pp = shm + L_P + gg * 64 * PP + (cp & 31) * 4;
      float s0 = 0.f, s1 = 0.f;
      for (int j = 0; j < win; ++j) { const unsigned x = *(__attribute__((address_space(3))) const unsigned*)(up + (16 + tl0 - j) * UP); s0 += lo16(x); s1 += hi16(x); }
      const float rw = 1.0f / (float)win;
#pragma unroll 4
      for (int i = 0; i < 16; ++i) { const int tl = tl0 + i; const unsigned x = *(__attribute__((address_space(3))) const unsigned*)(up + (16 + tl) * UP);
          const int ta = t0 + tl + 1; const float rc = ta < win ? __builtin_amdgcn_rcpf((float)ta) : rw;
          *(__attribute__((address_space(3))) unsigned*)(pp + tl * PP) = hg::cvtpk(s0 * rc - lo16(x), s1 * rc - hi16(x));
          const unsigned xn = *(__attribute__((address_space(3))) const unsigned*)(up + (17 + tl) * UP), xo = *(__attribute__((address_space(3))) const unsigned*)(up + (17 + tl - win) * UP);
          s0 += lo16(xn) - lo16(xo); s1 += hi16(xn) - hi16(xo); } }
    __syncthreads();
    { const lptr pb = shm + L_P + g * 64 * PP + (32 * tt + r) * PP + hh * 16;
      bf16x8 pf[4];
#pragma unroll
      for (int kk = 0; kk < 4; ++kk) pf[kk] = *(__attribute__((address_space(3))) const bf16x8*)(pb + kk * 32);
#pragma unroll
      for (int dt = 0; dt < 2; ++dt) {
          f32x16 acc = {};
#pragma unroll
          for (int kk = 0; kk < 4; ++kk) acc = __builtin_amdgcn_mfma_f32_32x32x16_bf16(wa[dt][kk], pf[kk], acc, 0, 0, 0);
          const float* sp = pscale + g * 64 + 32 * dt + 4 * hh; unsigned short* op = MIX + (row0 + 32 * tt + r) * DM + 256 + g * 64 + 32 * dt + 4 * hh;
#pragma unroll
          for (int q = 0; q < 4; ++q) { const f32x4 sc = *(const f32x4*)(sp + 8 * q);
              const unsigned p0 = hg::cvtpk(acc[4 * q] * sc[0], acc[4 * q + 1] * sc[1]), p1 = hg::cvtpk(acc[4 * q + 2] * sc[2], acc[4 * q + 3] * sc[3]);
              *(u32x2*)(op + 8 * q) = (u32x2){hg::cvtpk(lo16(p0) * lo16(gt[dt][q][0]), hi16(p0) * hi16(gt[dt][q][0])), hg::cvtpk(lo16(p1) * lo16(gt[dt][q][1]), hi16(p1) * hi16(gt[dt][q][1]))}; }
      } }
    __syncthreads();
    }
#undef PL_LOAD
}
}
#define XB_TMO      128
#define XB_XCNT(j)  (256  + 64 * (j))
#define XB_XSUB(j)  (1280 + 64 * (j))
#define XB_XGEN(j)  (2304 + 64 * (j))
#define XB_TOP      3328
#define XB_TOPGEN   3392
#define XCD_BAR_WORDS 3456
#define XB_SPIN_CAP (1u << 18)

__device__ __forceinline__ unsigned xb_ld(unsigned* p)              { return __hip_atomic_load(p, __ATOMIC_RELAXED, __HIP_MEMORY_SCOPE_AGENT); }
__device__ __forceinline__ unsigned xb_add(unsigned* p, unsigned v) { return __hip_atomic_fetch_add(p, v, __ATOMIC_RELAXED, __HIP_MEMORY_SCOPE_AGENT); }
__device__ __forceinline__ unsigned xb_xcc_id() { return (unsigned)__builtin_amdgcn_s_getreg((3 << 11) | 20) & 0xFu; }
#define XB_SPIN(cond, bar) do { unsigned _sp = 0; while (cond) { __builtin_amdgcn_s_sleep(1); \
    if ((++_sp & 255u) == 0u) { if (xb_ld(&(bar)[XB_TMO])) break; if (_sp > XB_SPIN_CAP) { atomicAdd(&(bar)[XB_TMO], 1u); break; } } } } while (0)

struct XcdBarrier {
    unsigned* bar; unsigned x;
    volatile LAS unsigned* st;
};

__device__ __forceinline__ XcdBarrier xcd_barrier_post(unsigned* bar, volatile LAS unsigned* st) {
    XcdBarrier b; b.bar = bar; b.x = xb_xcc_id(); b.st = st;
    if (threadIdx.x == 0) (void)xb_add(&bar[XB_XCNT(b.x)], 1u);
    return b;
}
__device__ __forceinline__ void xcd_barrier_complete(unsigned* bar, unsigned x, unsigned& nloc, unsigned& nx) {
    const unsigned G = gridDim.x * gridDim.y * gridDim.z;
    unsigned sum, cnt, mine, sp = 0u;
    for (;;) {
        sum = 0u; cnt = 0u; mine = 0u;
#pragma unroll
        for (unsigned j = 0; j < 16; ++j) { const unsigned c = xb_ld(&bar[XB_XCNT(j)]); sum += c; cnt += (c > 0u) ? 1u : 0u; mine = (j == x) ? c : mine; }
        if (sum == G) break;
        __builtin_amdgcn_s_sleep(1);
        if ((++sp & 255u) == 0u) { if (xb_ld(&bar[XB_TMO])) break; if (sp > XB_SPIN_CAP) { atomicAdd(&bar[XB_TMO], 1u); break; } }
    }
    nloc = mine > 0u ? mine : 1u; nx = cnt > 0u ? cnt : 1u;
}

__device__ __forceinline__ void xcd_barrier(const XcdBarrier& b) {
    asm volatile("s_waitcnt vmcnt(0)" ::: "memory");
    __syncthreads();
    if (threadIdx.x == 0) {
        unsigned* bar = b.bar;
        __builtin_amdgcn_s_waitcnt(0);
        unsigned nloc = b.st[0], nx = b.st[1];
        if (nloc == 0u) { xcd_barrier_complete(bar, b.x, nloc, nx); b.st[0] = nloc; b.st[1] = nx; }
        const unsigned old = xb_add(&bar[XB_XSUB(b.x)], 1u);
        const unsigned gen = old / nloc;
        if (old + 1u == (gen + 1u) * nloc) {
            __builtin_amdgcn_fence(__ATOMIC_RELEASE, "agent");
            asm volatile("s_waitcnt vmcnt(0)" ::: "memory");
            const unsigned og = xb_add(&bar[XB_TOP], 1u);
            const unsigned tg = og / nx;
            if (og + 1u == (tg + 1u) * nx) xb_add(&bar[XB_TOPGEN], 1u);
            else XB_SPIN(xb_ld(&bar[XB_TOPGEN]) == tg, bar);
            __builtin_amdgcn_fence(__ATOMIC_ACQUIRE, "agent");
            xb_add(&bar[XB_XGEN(b.x)], 1u);
            asm volatile("s_waitcnt vmcnt(0)" ::: "memory");
        } else {
            XB_SPIN(xb_ld(&bar[XB_XGEN(b.x)]) == gen, bar);
            __builtin_amdgcn_fence(__ATOMIC_ACQUIRE, "agent");
            asm volatile("s_waitcnt vmcnt(0)" ::: "memory");
        }
    }
    __syncthreads();
}
#ifndef PROBE_REP_IN
#define PROBE_REP_IN 1
#endif
#ifndef PROBE_REP_OUT
#define PROBE_REP_OUT 1
#endif
#ifndef PROBE_REP_MIX
#define PROBE_REP_MIX 1
#endif
constexpr int NWAVES = 8;
constexpr int RING_OFF = 0, RING_BYTES = 131072;
constexpr int LDSCTL_OFF = RING_BYTES, MISC_OFF = LDSCTL_OFF + 320;
constexpr int LDS_BYTES = 147456;
constexpr int CW_TMO = 0, CW_CODE = 1, CW_Q = 2048, CW_BAR = 4096, CW_QM = 8192, CW_KM = 8192 + 2048;
constexpr size_t CTL_ZERO_BYTES = 65536;
constexpr int N_PHASES = 9;

struct Frame {
    LAS unsigned char* lds; volatile LAS unsigned* MISC; gu32* ctl;
    int wave, vcu, G;
};

__device__ __forceinline__ void p0_transpose_item(const float* W, int K, int ldw, int nblk, bf16* WT, LAS float* scr, int item, int lane) {
    const int kb = item / nblk, nb = item % nblk, k0 = 64 * kb, n0 = 32 * nb;
#pragma unroll 8
    for (int i = 0; i < 32; ++i) { const int kk = 2 * i + (lane >> 5); scr[kk * 33 + (lane & 31)] = W[(size_t)(k0 + kk) * ldw + n0 + (lane & 31)]; }
    LDS_WAIT(); asm volatile("" ::: "memory");
    const int c = lane & 7;
#pragma unroll
    for (int j = 0; j < 4; ++j) { const int n = (lane >> 3) + 8 * j; const LAS float* s = scr + (8 * c) * 33 + n;
        v4u o; o.x = pk2(s[0 * 33], s[1 * 33]); o.y = pk2(s[2 * 33], s[3 * 33]); o.z = pk2(s[4 * 33], s[5 * 33]); o.w = pk2(s[6 * 33], s[7 * 33]);
        *(GAS v4u*)(WT + (size_t)(n0 + n) * K + k0 + 8 * c) = o; }
    LDS_WAIT(); asm volatile("" ::: "memory");
}
constexpr int WFC_LDS = 98304;
template <class T> __device__ __forceinline__ T* opq(T* p) { GAS T* g = (GAS T*)p; asm volatile("" : "+s"(g)); return (T*)g; }
__device__ __forceinline__ int opaque_tid() { int t = threadIdx.x; asm volatile("" : "+v"(t)); return t; }
__device__ __forceinline__ void stage_wfc(Frame& F, const float* w_in_l, int tid) {
    LAS float* wf = (LAS float*)(F.lds + WFC_LDS);
    for (int e = tid; e < 8192; e += NWAVES * 64) { const int k = e >> 3, h = e & 7; wf[h * 1024 + k] = w_in_l[(size_t)k * NIN + 3584 + h]; }
}
__device__ __forceinline__ void fc_row(Frame& F, const f32x4 (&v)[4], const float* fbias, float* lfc_row, int lane) {
    const LAS float* wf = (const LAS float*)(F.lds + WFC_LDS);
    float s[8];
#pragma unroll
    for (int h = 0; h < 8; ++h) { float a = 0.f;
#pragma unroll
        for (int j = 0; j < 4; ++j) { const f32x4 w = *(const LAS f32x4*)(wf + h * 1024 + 256 * j + 4 * lane); a += (v[j].x * w.x + v[j].y * w.y) + (v[j].z * w.z + v[j].w * w.w); }
        s[h] = a; }
    float t[4], u[2];
#pragma unroll
    for (int j = 0; j < 4; ++j) { auto r = __builtin_amdgcn_permlane32_swap(__float_as_uint(s[j]), __float_as_uint(s[j + 4]), false, false); t[j] = __uint_as_float(r[0]) + __uint_as_float(r[1]); }
#pragma unroll
    for (int j = 0; j < 2; ++j) { auto r = __builtin_amdgcn_permlane16_swap(__float_as_uint(t[j]), __float_as_uint(t[j + 2]), false, false); u[j] = __uint_as_float(r[0]) + __uint_as_float(r[1]); }
    const bool b3 = (lane & 8) != 0;
    const float keep = b3 ? u[1] : u[0], send = b3 ? u[0] : u[1];
    float tot = keep + __uint_as_float(__builtin_amdgcn_update_dpp(0u, __float_as_uint(send), 0x128, 0xf, 0xf, false));
    tot = dpp_add<0xB1>(tot); tot = dpp_add<0x4E>(tot); tot = dpp_add<0x141>(tot);
    if ((lane & 7) == 0) { const int h = lane >> 3; lfc_row[h] = logsigmoidf_(tot + fbias[h]); }
}
__device__ __forceinline__ float bfround(float f) { return __uint_as_float(f2bf(f) << 16); }
__device__ __forceinline__ void emit_xn_row(Frame& F, f32x4 (&v)[4], bf16* xn_row, const float* fbias, float* lfc_row, int lane) {
    GAS unsigned long long* o8 = (GAS unsigned long long*)xn_row + lane;
#pragma unroll
    for (int j = 0; j < 4; ++j) { const unsigned lo = pk2(v[j].x, v[j].y), hi = pk2(v[j].z, v[j].w); o8[64 * j] = (unsigned long long)lo | ((unsigned long long)hi << 32);
        v[j].x = __uint_as_float(lo << 16); v[j].y = __uint_as_float(lo & 0xffff0000u); v[j].z = __uint_as_float(hi << 16); v[j].w = __uint_as_float(hi & 0xffff0000u); }
    fc_row(F, v, fbias, lfc_row, lane);
}

__device__ __forceinline__ void cumsum_wave(const float* LFC, float* CC, int bh, int lane) {
    const int b = bh >> 3, h = bh & 7;
    float loc[32]; float s = 0.f;
#pragma unroll
    for (int i = 0; i < 32; ++i) { s += LFC[((size_t)b * SEQ + lane * 32 + i) * 8 + h]; loc[i] = s; }
    float incl = s;
#pragma unroll
    for (int o = 1; o < 64; o <<= 1) { const float t = __shfl_up(incl, o); if (lane >= o) incl += t; }
    const float excl = incl - s;
#pragma unroll
    for (int i = 0; i < 32; i += 4) *(f32x4*)(CC + (size_t)bh * SEQ + lane * 32 + i) = (f32x4){excl + loc[i], excl + loc[i + 1], excl + loc[i + 2], excl + loc[i + 3]};
}
struct Args { const float* in[10]; float* out; unsigned char* ws; int ph_lo, ph_hi, li, pad; };

#define GRID_BAR() do { XcdBarrier b_ = bar; asm volatile("" : "+s"(b_.bar), "+s"(b_.x)); xcd_barrier(b_); } while (0)
#define IN(k) (lo <= (k) && (k) < hi)
#define BOTH(k) (IN(k) && IN((k) + 1))
template <int l> __device__ __forceinline__ void layer_phases(const Args& args, Frame& F, const XcdBarrier& bar, unsigned char* lds, int lo, int hi, int gw, int NGW) {
        const int pb = 1 + 4 * l;
        if (IN(pb)) {
            unsigned char* ws = opq(args.ws); bf16* XN = (bf16*)(ws + WS_XN);
            if (gw < BATCH * 8) cumsum_wave((const float*)(ws + WS_LFC), (float*)(ws + WS_CC), gw, opaque_tid() & 63);
            pg8::Gemm g{XN, (const bf16*)(ws + WS_WIN + l * 8 * MiB), M, 3584, DM}; pg8::StaticOrder S; S.init(M, 3584, F.G, (int)blockIdx.x);
            pg8::EpiIn E{ws, (const float*)(ws + WS_LBS) + l * 256, (unsigned*)(F.ctl + CW_QM + l * 1024), (unsigned*)(F.ctl + CW_KM + l * 128)};
            for (int rep_ = 0; rep_ < PROBE_REP_IN; ++rep_) pg8::gemm_phase<pg8::EpiIn, pg8::StaticOrder, true, true>(F.lds + RING_OFF, g, S, E);
            if (BOTH(pb)) GRID_BAR();
        }
        if (IN(pb + 1)) {
            unsigned char* ws = opq(args.ws); bf16* MIX = (bf16*)(ws + WS_MIX);
            for (int rep_ = 0; rep_ < PROBE_REP_MIX; ++rep_) {
            gu32* qctr = F.ctl + CW_Q + 64 * (l + 2 * rep_); volatile LAS unsigned* slot = F.MISC + 16;
#define POP_SYNC() do { __syncthreads(); if (threadIdx.x == 0) slot[0] = __hip_atomic_fetch_add(qctr, 1u, RLX_AGENT); __syncthreads(); } while (0)
            POP_SYNC();
            for (;;) {
                const int idx = __builtin_amdgcn_readfirstlane((int)slot[0]);
                if (idx >= 64 + 128 + 1024) break;
                if (idx < 64) { hg::hgrn_item(idx >> 2, idx & 3, (const bf16*)(ws + WS_QA), (const float*)(ws + WS_LF), (const bf16*)(ws + WS_IA), (const bf16*)(ws + WS_GA), args.in[4] + l * 256, MIX, lds + RING_OFF); POP_SYNC(); }
                else if (idx < 64 + 128) { const int p = idx - 64;
                    pl::pool_item(p >> 3, (p & 7) * 256, 4, (const bf16*)(ws + WS_UB), (const bf16*)(ws + WS_GB), (const bf16*)(ws + WS_PWT) + l * 4 * 64 * 64, args.in[7] + l * 256, MIX, lds + RING_OFF); POP_SYNC(); }
                else { const int j = idx - 64 - 128, qb = 7 - (j >> 7), bh = j & 127;
                    attn_body::attn_unit<8>(bh >> 3, bh & 7, qb, (const attn_body::bf16*)(ws + WS_QC), (const attn_body::bf16*)(ws + WS_KC), (const attn_body::bf16*)(ws + WS_VC), (const attn_body::bf16*)(ws + WS_GC), (const float*)(ws + WS_CC), __uint_as_float(F.ctl[CW_QM + l * 1024 + bh * 8 + qb]), __uint_as_float(F.ctl[CW_KM + l * 128 + bh]), (attn_body::bf16*)MIX, (char*)lds + RING_OFF, qctr, slot); }
            }
#undef POP_SYNC
            if (rep_ + 1 < PROBE_REP_MIX) GRID_BAR();
            }
            if (BOTH(pb + 1)) GRID_BAR();
        }
        if (IN(pb + 2)) {
            unsigned char* ws = opq(args.ws); bf16* MIX = (bf16*)(ws + WS_MIX); bf16* Y = (bf16*)(ws + WS_Y);
            pg8::Gemm g{MIX, (const bf16*)(ws + WS_WOUT + l * 2 * MiB), M, DM, DM}; pg8::StaticOrder S; S.init(M, DM, F.G, (int)blockIdx.x);
            pg8::EpiY E{Y, DM};
            for (int rep_ = 0; rep_ < PROBE_REP_OUT; ++rep_) pg8::gemm_phase<pg8::EpiY, pg8::StaticOrder, true, true>(F.lds + RING_OFF, g, S, E);
            if (BOTH(pb + 2)) GRID_BAR();
        }
        if (IN(pb + 3)) {
            const int tid = opaque_tid(), lane = tid & 63;
            unsigned char* ws = opq(args.ws); const float* x = args.in[0]; const float* pre_g = args.in[2]; const float* w_in = args.in[3]; const float* fbias = args.in[5]; const float* post_g = args.in[9]; float* out = args.out;
            bf16* XN = (bf16*)(ws + WS_XN); const bf16* Y = (const bf16*)(ws + WS_Y); float* LFC = (float*)(ws + WS_LFC);
            const bool more = l + 1 < DEPTH;
            if (more) { stage_wfc(F, w_in + (size_t)(l + 1) * DM * NIN, tid); __syncthreads(); }
            bf16* X1 = (bf16*)(ws + WS_X1);
            for (int m0 = gw; m0 < M; m0 += 2 * NGW) {
                unsigned long long yy[2][4]; f32x4 xv[2][4];
#pragma unroll
                for (int rr = 0; rr < 2; ++rr) { const int m = m0 + rr * NGW;
                    const GAS unsigned long long* yr = (const GAS unsigned long long*)(Y + (size_t)m * DM) + lane;
                    if (l == 0) { const GAS f32x4* xr = (const GAS f32x4*)(x + (size_t)m * DM) + lane;
#pragma unroll
                        for (int j = 0; j < 4; ++j) { yy[rr][j] = __builtin_nontemporal_load(yr + 64 * j); xv[rr][j] = __builtin_nontemporal_load(xr + 64 * j); } }
                    else { const GAS unsigned long long* xr = (const GAS unsigned long long*)(X1 + (size_t)m * DM) + lane;
#pragma unroll
                        for (int j = 0; j < 4; ++j) { yy[rr][j] = __builtin_nontemporal_load(yr + 64 * j); const unsigned long long xx = __builtin_nontemporal_load(xr + 64 * j); const unsigned xlo = (unsigned)xx, xhi = (unsigned)(xx >> 32);
                            xv[rr][j] = (f32x4){__uint_as_float(xlo << 16), __uint_as_float(xlo & 0xffff0000u), __uint_as_float(xhi << 16), __uint_as_float(xhi & 0xffff0000u)}; } } }
                f32x4 gp[4];
#pragma unroll
                for (int j = 0; j < 4; ++j) gp[j] = *((const f32x4*)(post_g + l * DM) + 64 * j + lane);
#pragma unroll
                for (int rr = 0; rr < 2; ++rr) { const int m = m0 + rr * NGW;
                    f32x4 v[4]; float ss = 0.f;
#pragma unroll
                    for (int j = 0; j < 4; ++j) { const unsigned ylo = (unsigned)yy[rr][j], yhi = (unsigned)(yy[rr][j] >> 32);
                        v[j] = (f32x4){__uint_as_float(ylo << 16), __uint_as_float(ylo & 0xffff0000u), __uint_as_float(yhi << 16), __uint_as_float(yhi & 0xffff0000u)}; ss += (v[j].x * v[j].x + v[j].y * v[j].y) + (v[j].z * v[j].z + v[j].w * v[j].w); }
                    const float rstd = rsqrtf(wave_sum(ss) * (1.f / DM) + NORM_EPS);
                    float s2 = 0.f;
#pragma unroll
                    for (int j = 0; j < 4; ++j) { v[j] = xv[rr][j] + v[j] * rstd * gp[j];
                        s2 += (v[j].x * v[j].x + v[j].y * v[j].y) + (v[j].z * v[j].z + v[j].w * v[j].w);
                        if (more) __builtin_nontemporal_store((unsigned long long)pk2(v[j].x, v[j].y) | ((unsigned long long)pk2(v[j].z, v[j].w) << 32), (GAS unsigned long long*)(X1 + (size_t)m * DM) + 64 * j + lane);
                        else __builtin_nontemporal_store(v[j], (GAS f32x4*)(out + (size_t)m * DM) + 64 * j + lane); }
                    if (more) { const float r2 = rsqrtf(wave_sum(s2) * (1.f / DM) + NORM_EPS);
#pragma unroll
                        for (int j = 0; j < 4; ++j) v[j] = v[j] * r2 * *((const f32x4*)(pre_g + (l + 1) * DM) + 64 * j + lane);
                        emit_xn_row(F, v, XN + (size_t)m * DM, fbias + (l + 1) * 8, LFC + (size_t)m * 8, lane); } }
            }
            if (BOTH(pb + 3)) GRID_BAR();
        }
}
__global__ void __launch_bounds__(NWAVES * 64, 2) fwd(Args args) {
    extern __shared__ __attribute__((aligned(16))) unsigned char lds[];
    Frame F;
    F.lds = (LAS unsigned char*)lds; F.MISC = (volatile LAS unsigned*)(F.lds + MISC_OFF);
    F.wave = __builtin_amdgcn_readfirstlane(threadIdx.x >> 6);
    F.G = gridDim.x; { const int bx = blockIdx.x; F.vcu = (F.G % 8 == 0) ? (bx % 8) * (F.G / 8) + bx / 8 : bx; }
    F.ctl = (gu32*)(args.ws + WS_CTL);
    for (int u = threadIdx.x; u < (LDS_BYTES - LDSCTL_OFF) / 4; u += NWAVES * 64) ((LAS unsigned*)(F.lds + LDSCTL_OFF))[u] = 0u;
    __syncthreads();
    XcdBarrier bar = xcd_barrier_post((unsigned*)(F.ctl + CW_BAR) + args.li * XCD_BAR_WORDS, F.MISC + 8);
    const int lo = args.ph_lo, hi = args.ph_hi;
    const int gw = F.vcu * NWAVES + F.wave, NGW = F.G * NWAVES;

    if (IN(0)) {
        const int tid = opaque_tid(), lane = tid & 63;
        unsigned char* ws = opq(args.ws); const float* x = args.in[0]; const float* lower = args.in[1]; const float* pre_g = args.in[2]; const float* w_in = args.in[3]; const float* fbias = args.in[5]; const float* pool_w = args.in[6]; const float* w_out = args.in[8];
        bf16* XN = (bf16*)(ws + WS_XN); float* LFC = (float*)(ws + WS_LFC);
        stage_wfc(F, w_in, tid);
        __syncthreads();
        LAS float* scr = (LAS float*)(F.lds + RING_OFF + F.wave * 8448);
        constexpr int I_IN = 16 * 112, I_OUT = 16 * 32, NITEMS = 2 * (I_IN + I_OUT);
        for (int it = gw; it < NITEMS; it += NGW) {
            int r = it; const int l = r / (I_IN + I_OUT); r -= l * (I_IN + I_OUT);
            if (r < I_IN) p0_transpose_item(w_in + (size_t)l * DM * NIN, DM, NIN, 112, (bf16*)(ws + WS_WIN + l * 8 * MiB), scr, r, lane);
            else p0_transpose_item(w_out + (size_t)l * DM * DM, DM, DM, 32, (bf16*)(ws + WS_WOUT + l * 2 * MiB), scr, r - I_IN, lane);
        }
        const int gt = F.vcu * NWAVES * 64 + tid, NGT = F.G * NWAVES * 64;
        for (int e = gt; e < 512; e += NGT) { const int l = e >> 8, j = e & 255; ((float*)(ws + WS_LBS))[e] = l == 0 ? 0.f : 1.f / (1.f + __expf(lower[j] - lower[256 + j])); }
        for (int e = gt; e < 2 * 4 * 64 * 64; e += NGT) { const int c = e & 63, d = (e >> 6) & 63, lg = e >> 12; ((bf16*)(ws + WS_PWT))[e] = f2bf(pool_w[((size_t)lg * 64 + c) * 64 + d]); }
        for (int m0 = gw; m0 < M; m0 += 2 * NGW) {
            f32x4 xv[2][4];
#pragma unroll
            for (int rr = 0; rr < 2; ++rr) { const GAS f32x4* xr = (const GAS f32x4*)(x + (size_t)(m0 + rr * NGW) * DM) + lane;
#pragma unroll
                for (int j = 0; j < 4; ++j) xv[rr][j] = __builtin_nontemporal_load(xr + 64 * j); }
#pragma unroll
            for (int rr = 0; rr < 2; ++rr) { const int m = m0 + rr * NGW;
                f32x4 v[4]; float ss = 0.f;
#pragma unroll
                for (int j = 0; j < 4; ++j) { v[j] = xv[rr][j]; ss += (v[j].x * v[j].x + v[j].y * v[j].y) + (v[j].z * v[j].z + v[j].w * v[j].w); }
                const float rstd = rsqrtf(wave_sum(ss) * (1.f / DM) + NORM_EPS);
#pragma unroll
                for (int j = 0; j < 4; ++j) v[j] = v[j] * rstd * *((const f32x4*)pre_g + 64 * j + lane);
                emit_xn_row(F, v, XN + (size_t)m * DM, fbias, LFC + (size_t)m * 8, lane); }
        }
        if (BOTH(0)) GRID_BAR();
    }
    layer_phases<0>(args, F, bar, lds, lo, hi, gw, NGW);
    layer_phases<1>(args, F, bar, lds, lo, hi, gw, NGW);
}

static void launch_fwd(const Args& a0, int lo, int hi, int li, int grid, hipStream_t stream) {
    Args a = a0; a.ph_lo = lo; a.ph_hi = hi; a.li = li;
    hipLaunchKernelGGL(fwd, dim3(grid), dim3(NWAVES * 64), LDS_BYTES, stream, a);
}
extern "C" void kernel_launch(void* const* d_in, const int* in_sizes, int n_in, void* d_out, int out_size, void* d_ws, size_t ws_size, hipStream_t stream) {
    static int grid = 0;
    if (grid == 0) {
        if (n_in != 10 || in_sizes[0] != M * DM || out_size != M * DM || ws_size < WS_END) { fprintf(stderr, "kernel_launch: unexpected shapes / workspace (%zu < %zu)\n", ws_size, (size_t)WS_END); grid = -1; return; }
        int dev = 0, cus = 0, per_cu = 0;
        if (hipGetDevice(&dev) != hipSuccess || hipDeviceGetAttribute(&cus, hipDeviceAttributeMultiprocessorCount, dev) != hipSuccess) { grid = -1; return; }
        if (hipFuncSetAttribute((const void*)fwd, hipFuncAttributeMaxDynamicSharedMemorySize, LDS_BYTES) != hipSuccess) { fprintf(stderr, "kernel_launch: hipFuncSetAttribute failed\n"); grid = -1; return; }
        if (hipOccupancyMaxActiveBlocksPerMultiprocessor(&per_cu, (const void*)fwd, NWAVES * 64, LDS_BYTES) != hipSuccess || per_cu < 1) { fprintf(stderr, "kernel_launch: occupancy query says %d blocks per CU\n", per_cu); (void)hipGetLastError(); grid = -1; return; }
        grid = cus;
    }
    if (grid < 0) return;
    unsigned char* ws = (unsigned char*)d_ws;
    (void)hipMemsetAsync(ws + WS_CTL, 0, CTL_ZERO_BYTES, stream);
    Args a{};
    for (int i = 0; i < 10; ++i) a.in[i] = (const float*)d_in[i];
    a.out = (float*)d_out; a.ws = ws;
    launch_fwd(a, 0, N_PHASES, 0, grid, stream);
}
```

```cpp
#include <hip/hip_runtime.h>
#include <cstdio>
#include <cstdint>
#include <cmath>
#include <hip/hip_bf16.h>

typedef unsigned short bf16;
constexpr int BATCH = 16, SEQ = 2048, DM = 1024, DEPTH = 2, M = BATCH * SEQ;
constexpr int NIN = 3592;
constexpr float NORM_EPS = 1e-6f, TINY = 1e-30f, LOG2E = 1.4426950408889634f;
constexpr float C2 = 0.125f * LOG2E;

constexpr size_t MiB = 1u << 20;
constexpr size_t WS_CTL = 0;
constexpr size_t WS_WIN = 1 * MiB;
constexpr size_t WS_WOUT = 17 * MiB;
constexpr size_t WS_SMALL = 21 * MiB;
constexpr size_t WS_WFC = WS_SMALL, WS_LBS = WS_SMALL + 65536, WS_PWT = WS_SMALL + 131072, WS_RS = WS_SMALL + 262144;
constexpr size_t WS_LFC = 22 * MiB;
constexpr size_t WS_CC = 23 * MiB;
constexpr size_t WS_XN = 24 * MiB;
constexpr size_t WS_ACT = 88 * MiB;
constexpr size_t WS_QA = WS_ACT, WS_LF = WS_QA + 16 * MiB, WS_IA = WS_LF + 32 * MiB, WS_GA = WS_IA + 16 * MiB, WS_UB = WS_GA + 16 * MiB, WS_GB = WS_UB + 16 * MiB;
constexpr size_t WS_QC = WS_GB + 16 * MiB, WS_KC = WS_QC + 32 * MiB, WS_VC = WS_KC + 32 * MiB, WS_GC = WS_VC + 32 * MiB;
constexpr size_t WS_Y = WS_ACT;
constexpr size_t WS_X1 = WS_ACT + 240 * MiB + 64 * MiB;
constexpr size_t WS_MIX = WS_ACT + 240 * MiB;
constexpr size_t WS_END = WS_MIX + 128 * MiB;

__device__ __forceinline__ float bf2f(bf16 v) { return __uint_as_float((unsigned)v << 16); }
__device__ __forceinline__ bf16 f2bf(float f) { unsigned u = __float_as_uint(f); return (bf16)((u + 0x7fffu + ((u >> 16) & 1u)) >> 16); }
__device__ __forceinline__ float sigmoidf_(float x) { return 1.f / (1.f + __expf(-x)); }
__device__ __forceinline__ float siluf_(float x) { return x * sigmoidf_(x); }
__device__ __forceinline__ float logsigmoidf_(float x) { const float e = __expf(-fabsf(x)); const float l1p = e < 9.765625e-4f ? e * (1.f - 0.5f * e) : __logf(1.f + e); return fminf(x, 0.f) - l1p; }
template <int CTRL> __device__ __forceinline__ float dpp_add(float v) { return v + __uint_as_float(__builtin_amdgcn_update_dpp(0u, __float_as_uint(v), CTRL, 0xf, 0xf, false)); }
__device__ __forceinline__ float wave_sum(float v) {
    v = dpp_add<0xB1>(v); v = dpp_add<0x4E>(v); v = dpp_add<0x124>(v); v = dpp_add<0x128>(v);
    { auto r = __builtin_amdgcn_permlane16_swap(__float_as_uint(v), __float_as_uint(v), false, false); v = __uint_as_float(r[0]) + __uint_as_float(r[1]); }
    { auto r = __builtin_amdgcn_permlane32_swap(__float_as_uint(v), __float_as_uint(v), false, false); v = __uint_as_float(r[0]) + __uint_as_float(r[1]); }
    return v;
}

#define GAS __attribute__((address_space(1)))
#define LAS __attribute__((address_space(3)))
typedef unsigned v4u __attribute__((ext_vector_type(4)));
typedef float f32x4 __attribute__((ext_vector_type(4)));
typedef short bf16x8 __attribute__((ext_vector_type(8)));
typedef GAS unsigned gu32;
typedef GAS unsigned long long gu64;
#define RLX_AGENT __ATOMIC_RELAXED, __HIP_MEMORY_SCOPE_AGENT
#define LDS_WAIT() asm volatile("s_waitcnt lgkmcnt(0)" ::: "memory")
#define VM_WAIT() asm volatile("s_waitcnt vmcnt(0)" ::: "memory")
typedef float f32x2v __attribute__((ext_vector_type(2))); typedef __bf16 bf16x2v __attribute__((ext_vector_type(2)));
__device__ __forceinline__ unsigned pk2(float lo, float hi) { f32x2v v = {lo, hi}; bf16x2v b = __builtin_convertvector(v, bf16x2v); return __builtin_bit_cast(unsigned, b); }
__device__ __forceinline__ f32x2v lo2(f32x4 v) { return (f32x2v){v.x, v.y}; }
__device__ __forceinline__ f32x2v hi2(f32x4 v) { return (f32x2v){v.z, v.w}; }
__device__ __forceinline__ float ssq4(f32x4 v, float acc) { f32x2v t = lo2(v) * lo2(v); t = hi2(v) * hi2(v) + t; return acc + (t.x + t.y); }
namespace pg8 {
#define PG8_LAS __attribute__((address_space(3)))
typedef unsigned short bf16_t;
typedef short bf16x8 __attribute__((ext_vector_type(8)));
typedef float f32x4 __attribute__((ext_vector_type(4)));
typedef unsigned u32x4 __attribute__((ext_vector_type(4)));
constexpr int BM = 256, BK = 64, HALF = 128, HTB = HALF * BK * 2  , STAGE_BYTES = 8 * HTB, NXCD = 8, WGM = 4;

__host__ __device__ __forceinline__ int lds_byte(int r, int c) { const int st = (r >> 4) * 2 + (c >> 5), rr = r & 15, cc = c & 31, ob = rr * 64 + cc * 2; return st * 1024 + (ob ^ (((ob >> 9) & 1) << 5)); }
__host__ __device__ __forceinline__ void stage_rc(int b, int& R, int& C) { const int st = b / 1024, sb = b % 1024, swz = sb ^ (((sb >> 9) & 1) << 5); R = (st >> 1) * 16 + swz / 64; C = (st & 1) * 32 + (swz % 64) / 2; }
__host__ __device__ __forceinline__ int perm32(int rho) { const int n = rho >> 4, i = rho & 15; return 8 * (i >> 2) + 4 * n + (i & 3); }

struct Unit { int pm, pn; };
struct Gemm { const bf16_t* A; const bf16_t* Bt; int M, N, K; };

struct StaticOrder {
    int nM, nN, nwg, G, c;
    __host__ __device__ void init(int M, int N, int G_, int c_) { nM = M / BM; nN = N / BM; nwg = nM * nN; G = G_; c = c_; }
    __host__ __device__ bool next(int i, Unit& u) const {
        const long L = (long)i * G + c; if (L >= nwg) return false;
        int wgid = (int)L; { const int q = nwg / NXCD, r = nwg % NXCD, xcd = wgid % NXCD, off = wgid / NXCD; wgid = (xcd < r ? xcd * (q + 1) : r * (q + 1) + (xcd - r) * q) + off; }
        const int nig = WGM * nN, gid = wgid / nig, fm = gid * WGM, gsz = (nM - fm) < WGM ? (nM - fm) : WGM;
        u.pm = fm + ((wgid % nig) % gsz); u.pn = (wgid % nig) / gsz; return true;
    }
    __device__ __forceinline__ void a_ready(const Unit&) const {}
    __device__ __forceinline__ void done(const Unit&) const {}
};

__device__ __forceinline__ unsigned cvt_pk_bf16(float lo, float hi) { unsigned r; asm volatile("v_cvt_pk_bf16_f32 %0, %1, %2" : "=v"(r) : "v"(lo), "v"(hi)); return r; }
typedef float f32x2 __attribute__((ext_vector_type(2)));
#ifndef LOGF
#define LOGF __logf
#endif
typedef unsigned u32x4 __attribute__((ext_vector_type(4)));
__device__ __forceinline__ float silu_fast(float x) { return x * __builtin_amdgcn_rcpf(1.0f + __expf(-x)); }
struct EpiIn {
    static constexpr bool PERM = true, AFTER_DRAIN = false;
    unsigned char* ws; const float* lbs;
    PG8_LAS float* lbl;
    const float* rs; PG8_LAS float* rsl;
    __device__ __forceinline__ void unit_start(const Unit& u, int wid, int lane) const {
        if (wid < 4) { int ln = lane; asm volatile("" : "+v"(ln));
            __builtin_amdgcn_global_load_lds((const unsigned*)(rs + (size_t)u.pm * BM + wid * 64) + ln, (PG8_LAS unsigned*)(rsl + wid * 64), 4, 0, 0); }
        else if (u.pn == 1) { int ln = lane; asm volatile("" : "+v"(ln));
            __builtin_amdgcn_global_load_lds((const unsigned*)(lbs + (wid - 4) * 64) + ln, (PG8_LAS unsigned*)(lbl + (wid - 4) * 64), 4, 0, 0); } }
    unsigned* qm; unsigned* km;
    __device__ __forceinline__ void operator()(const f32x4 (&acc)[2][2][4][2], const Unit& u, int wr, int wc, int fr, int fq) const {
        const int pn = u.pn;
        size_t off; int ldc = 256, cb = 0, mode = 0;
        switch (pn) {
            case 0: off = WS_QA; mode = 1; break;
            case 1: off = WS_LF; mode = 3; break;
            case 2: off = WS_IA; break;
            case 3: off = WS_GA; mode = 1; break;
            case 4: off = WS_GB; mode = 1; break;
            case 5: off = WS_UB; break;
            case 6: case 7: off = WS_QC; ldc = 512; cb = (pn - 6) * 256; mode = 2; break;
            case 8: case 9: off = WS_KC; ldc = 512; cb = (pn - 8) * 256; break;
            case 10: case 11: off = WS_VC; ldc = 512; cb = (pn - 10) * 256; break;
            default: off = WS_GC; ldc = 512; cb = (pn - 12) * 256; mode = 1; break;
        }
        const int row0 = u.pm * BM + wr * 64 + fr, col0 = cb + wc * 32 + 8 * fq;
        float rsv[2][4];
#pragma unroll
        for (int ai = 0; ai < 2; ++ai)
#pragma unroll
            for (int m = 0; m < 4; ++m) rsv[ai][m] = rsl[wr * 64 + fr + ai * HALF + m * 16];
        if (mode == 3) {
            float* base = (float*)(ws + off);
            f32x4 lb[2][2];
#pragma unroll
            for (int bj = 0; bj < 2; ++bj)
#pragma unroll
                for (int n = 0; n < 2; ++n) lb[bj][n] = *(const PG8_LAS f32x4*)(lbl + col0 + bj * HALF + 4 * n);
#pragma unroll
            for (int ai = 0; ai < 2; ++ai)
#pragma unroll
                for (int m = 0; m < 4; ++m) { float* rowp = base + (size_t)(row0 + ai * HALF + m * 16) * 256 + col0;
#pragma unroll
                    for (int bj = 0; bj < 2; ++bj)
#pragma unroll
                        for (int n = 0; n < 2; ++n) { const f32x4 z = acc[ai][bj][m][n] * rsv[ai][m]; f32x4 o;
#pragma unroll
                            for (int i = 0; i < 4; ++i) { const float sg = __builtin_amdgcn_rcpf(1.0f + __expf(-z[i])); const float f = lb[bj][n][i] + (1.0f - lb[bj][n][i]) * sg; o[i] = __log2f(fmaxf(f, TINY)); }
                            *(f32x4*)(rowp + bj * HALF + 4 * n) = o; } }
        } else {
            bf16_t* base = (bf16_t*)(ws + off); float nmax[2] = {0.f, 0.f};
#pragma unroll
            for (int ai = 0; ai < 2; ++ai)
#pragma unroll
                for (int m = 0; m < 4; ++m) { bf16_t* rowp = base + (size_t)(row0 + ai * HALF + m * 16) * ldc + col0;
#pragma unroll
                    for (int bj = 0; bj < 2; ++bj) { f32x4 v0 = acc[ai][bj][m][0] * rsv[ai][m], v1 = acc[ai][bj][m][1] * rsv[ai][m];
                        if (mode == 1) {
#pragma unroll
                            for (int i = 0; i < 4; ++i) { v0[i] = silu_fast(v0[i]); v1[i] = silu_fast(v1[i]); } }
                        else if (mode == 2) { v0 = v0 * C2; v1 = v1 * C2; }
                        u32x4 w; w.x = cvt_pk_bf16(v0[0], v0[1]); w.y = cvt_pk_bf16(v0[2], v0[3]); w.z = cvt_pk_bf16(v1[0], v1[1]); w.w = cvt_pk_bf16(v1[2], v1[3]);
                        if (pn >= 8 && pn <= 11) {
                            const int row_ = row0 + ai * HALF + m * 16, col_ = col0 + bj * HALF;
                            const size_t tile_ = ((size_t)((row_ >> 11) * 8 + (col_ >> 6)) * 32 + ((row_ & 2047) >> 6)) * 8192;
                            const int in_ = pn < 10 ? ((col_ & 63) >> 3) * 1024 + (row_ & 63) * 16 : ((col_ & 63) >> 5) * 4096 + (row_ & 63) * 64 + ((col_ & 31) >> 3) * 16;
                            *(u32x4*)((unsigned char*)base + tile_ + in_) = w; }
                        else *(u32x4*)(rowp + bj * HALF) = w;
                        if (pn >= 6 && pn <= 9) {
                            float sq = 0.f;
#pragma unroll
                            for (int i = 0; i < 4; ++i) { const float a = __uint_as_float(w[i] << 16), b = __uint_as_float(w[i] & 0xffff0000u); sq += a * a + b * b; }
                            { auto r_ = __builtin_amdgcn_permlane16_swap(__float_as_uint(sq), __float_as_uint(sq), false, false); sq = __uint_as_float(r_[0]) + __uint_as_float(r_[1]); }
                            { auto r_ = __builtin_amdgcn_permlane32_swap(__float_as_uint(sq), __float_as_uint(sq), false, false); sq = __uint_as_float(r_[0]) + __uint_as_float(r_[1]); }
                            nmax[bj] = fmaxf(nmax[bj], sq); } } }
            if (pn >= 6 && pn <= 9) {
#pragma unroll
                for (int bj = 0; bj < 2; ++bj) { float v = nmax[bj];
#define EPI_DPPMAX(C) v = fmaxf(v, __uint_as_float(__builtin_amdgcn_update_dpp(__float_as_uint(v), __float_as_uint(v), C, 0xf, 0xf, false)))
                    EPI_DPPMAX(0xB1); EPI_DPPMAX(0x4E); EPI_DPPMAX(0x124); EPI_DPPMAX(0x128);
#undef EPI_DPPMAX
                    if (fr == 0 && fq == 0) { const int h = (pn & 1) * 4 + 2 * bj + (wc >> 1), b = u.pm >> 3, qb = u.pm & 7;
                        unsigned* dst = pn < 8 ? qm + (b * 8 + h) * 8 + qb : km + b * 8 + h;
                        __hip_atomic_fetch_max(dst, __float_as_uint(v), __ATOMIC_RELAXED, __HIP_MEMORY_SCOPE_AGENT); } } }
        }
    }
};
struct EpiY {
    static constexpr bool PERM = true, AFTER_DRAIN = false;
    __device__ __forceinline__ void unit_start(const Unit&, int, int) const {}
    bf16_t* Y; int ldc;
    __device__ __forceinline__ void operator()(const f32x4 (&acc)[2][2][4][2], const Unit& u, int wr, int wc, int fr, int fq) const {
        const int row0 = u.pm * BM + wr * 64 + fr, col0 = u.pn * BM + wc * 32 + 8 * fq;
#pragma unroll
        for (int ai = 0; ai < 2; ++ai)
#pragma unroll
            for (int m = 0; m < 4; ++m) { bf16_t* rowp = Y + (size_t)(row0 + ai * HALF + m * 16) * ldc + col0;
#pragma unroll
                for (int bj = 0; bj < 2; ++bj) { const f32x4 v0 = acc[ai][bj][m][0], v1 = acc[ai][bj][m][1];
                    u32x4 w; w.x = cvt_pk_bf16(v0[0], v0[1]); w.y = cvt_pk_bf16(v0[2], v0[3]); w.z = cvt_pk_bf16(v1[0], v1[1]); w.w = cvt_pk_bf16(v1[2], v1[3]);
                    *(u32x4*)(rowp + bj * HALF) = w; } }
    }
};
template <class Epi, class Sched, bool ALIGN_EPI = false, bool SP2 = false>
__device__ __forceinline__ void gemm_phase(PG8_LAS unsigned char* lds, const Gemm g, const Sched& S, const Epi& E) {
    const int tid = threadIdx.x, wid = __builtin_amdgcn_readfirstlane(tid >> 6), lane = tid & 63, wr = wid >> 2, wc = wid & 3, fr = lane & 15, fq = lane >> 4;
    const int K = g.K, nt = K / BK;
    unsigned voffA[2], voffB[2];
#pragma unroll
    for (int i = 0; i < 2; ++i) { int R, C; stage_rc(tid * 16 + i * 8192, R, C); const int Rb = Epi::PERM ? ((R & ~31) + perm32(R & 31)) : R;
        voffA[i] = (unsigned)(R * K + C) * 2u; voffB[i] = (unsigned)(Rb * K + C) * 2u; }
    const size_t kstep = (size_t)(BK * 2);
    const size_t hstep = (size_t)HALF * K * 2;
    const size_t tstep = 2 * hstep;
    const unsigned ldsw = (unsigned)wid * 1024u;
    const int aoff = lds_byte(wr * 64 + fr, fq * 8), boff = lds_byte(wc * 32 + fr, fq * 8);
#define PG8_SA(b, h) (((b) * 2 + (h)) * HTB)
#define PG8_SB(b, h) ((4 + (b) * 2 + (h)) * HTB)
#define PG8_STAGE(bufoff, gbase, voff) do { _Pragma("unroll") for (int _i = 0; _i < 2; ++_i) \
        __builtin_amdgcn_global_load_lds((const unsigned*)((const char*)(gbase) + (voff)[_i]), (PG8_LAS unsigned*)(lds + (bufoff) + ldsw + _i * 8192), 16, 0, 0); } while (0)
#define PG8_LDA(dst, b, h) do { _Pragma("unroll") for (int m = 0; m < 4; ++m) _Pragma("unroll") for (int k = 0; k < 2; ++k) dst[m][k] = *(const PG8_LAS bf16x8*)(lds + PG8_SA(b, h) + aoff + m * 2048 + k * 1024); } while (0)
#define PG8_LDB(dst, b, h) do { _Pragma("unroll") for (int n = 0; n < 2; ++n) _Pragma("unroll") for (int k = 0; k < 2; ++k) dst[n][k] = *(const PG8_LAS bf16x8*)(lds + PG8_SB(b, h) + boff + n * 2048 + k * 1024); } while (0)
#define PG8_MMA(ai, bj, At, Bt) do { __builtin_amdgcn_s_setprio(1); _Pragma("unroll") for (int m = 0; m < 4; ++m) _Pragma("unroll") for (int n = 0; n < 2; ++n) _Pragma("unroll") for (int k = 0; k < 2; ++k) \
        acc[ai][bj][m][n] = __builtin_amdgcn_mfma_f32_16x16x32_bf16(Bt[n][k], At[m][k], acc[ai][bj][m][n], 0, 0, 0); __builtin_amdgcn_s_setprio(0); } while (0)
#define PG8_WAIT_V(n) asm volatile("s_waitcnt vmcnt(" #n ")" ::: "memory")
#define PG8_WAIT_L(n) asm volatile("s_waitcnt lgkmcnt(" #n ")" ::: "memory")
#define PG8_BAR __builtin_amdgcn_s_barrier()
#define PG8_SCHED __builtin_amdgcn_sched_barrier(0)
    Unit cur, nxt; int ui = 0;
    if (!S.next(0, cur)) return;
    f32x4 acc[2][2][4][2];
#pragma unroll
    for (int a = 0; a < 2; ++a)
#pragma unroll
        for (int b = 0; b < 2; ++b)
#pragma unroll
            for (int m = 0; m < 4; ++m)
#pragma unroll
                for (int n = 0; n < 2; ++n) acc[a][b][m][n] = (f32x4){0.f, 0.f, 0.f, 0.f};
    bf16x8 At[4][2], B0[2][2], B1[2][2];
    const char* cA = (const char*)g.A + (size_t)cur.pm * tstep; const char* cB = (const char*)g.Bt + (size_t)cur.pn * tstep;
    S.a_ready(cur);
    if constexpr (SP2) {
        PG8_STAGE(PG8_SB(0, 0), cB, voffB); PG8_STAGE(PG8_SB(0, 1), cB + hstep, voffB); PG8_STAGE(PG8_SA(0, 0), cA, voffA); PG8_STAGE(PG8_SA(0, 1), cA + hstep, voffA);
        if (wr == 1) PG8_BAR;
        PG8_WAIT_V(2); PG8_BAR;
        PG8_STAGE(PG8_SB(1, 0), cB + kstep, voffB); PG8_STAGE(PG8_SA(1, 0), cA + kstep, voffA); PG8_STAGE(PG8_SB(1, 1), cB + hstep + kstep, voffB);
        PG8_WAIT_V(6); PG8_BAR;
    } else {
        PG8_STAGE(PG8_SB(0, 0), cB, voffB); PG8_STAGE(PG8_SA(0, 0), cA, voffA); PG8_STAGE(PG8_SB(0, 1), cB + hstep, voffB); PG8_STAGE(PG8_SA(0, 1), cA + hstep, voffA);
        if (wr == 1) PG8_BAR;
        PG8_WAIT_V(4); PG8_BAR;
        PG8_STAGE(PG8_SB(1, 0), cB + kstep, voffB); PG8_STAGE(PG8_SA(1, 0), cA + kstep, voffA); PG8_STAGE(PG8_SB(1, 1), cB + hstep + kstep, voffB);
        PG8_WAIT_V(6); PG8_BAR;
    }
    for (;;) {
        const bool has_next = S.next(ui + 1, nxt);
        const char* nA = has_next ? (const char*)g.A + (size_t)nxt.pm * tstep : cA; const char* nB = has_next ? (const char*)g.Bt + (size_t)nxt.pn * tstep : cB;
        E.unit_start(cur, wid, lane);
        for (int t = 0; t < nt; t += 2) {
            const bool last = (t == nt - 2);
            const char* a1 = cA + (size_t)(t + 1) * kstep;
            const char* a2 = last ? nA : cA + (size_t)(t + 2) * kstep; const char* b2 = last ? nB : cB + (size_t)(t + 2) * kstep;
            const char* a3 = a2 + kstep; const char* b3 = b2 + kstep;
            if (last && has_next) S.a_ready(nxt);
            if constexpr (SP2) {
            PG8_LDB(B0, 0, 0); PG8_LDB(B1, 0, 1); PG8_SCHED; PG8_LDA(At, 0, 0); PG8_STAGE(PG8_SA(1, 1), a1 + hstep, voffA);
            PG8_WAIT_V(8); PG8_WAIT_L(0); PG8_BAR; PG8_MMA(0, 0, At, B0); PG8_MMA(0, 1, At, B1); PG8_BAR; PG8_SCHED;
            PG8_LDA(At, 0, 1); PG8_STAGE(PG8_SB(0, 0), b2, voffB); PG8_STAGE(PG8_SB(0, 1), b2 + hstep, voffB); PG8_STAGE(PG8_SA(0, 0), a2, voffA);
            PG8_WAIT_V(8); PG8_WAIT_L(0); PG8_BAR; PG8_MMA(1, 0, At, B0); PG8_MMA(1, 1, At, B1); PG8_BAR; PG8_SCHED;
            PG8_LDB(B0, 1, 0); PG8_LDB(B1, 1, 1); PG8_SCHED; PG8_LDA(At, 1, 0); PG8_STAGE(PG8_SA(0, 1), a2 + hstep, voffA);
            PG8_WAIT_V(8); PG8_WAIT_L(0); PG8_BAR; PG8_MMA(0, 0, At, B0); PG8_MMA(0, 1, At, B1); PG8_BAR; PG8_SCHED;
            PG8_LDA(At, 1, 1); PG8_STAGE(PG8_SB(1, 0), b3, voffB); PG8_STAGE(PG8_SB(1, 1), b3 + hstep, voffB); PG8_STAGE(PG8_SA(1, 0), a3, voffA);
            PG8_WAIT_V(8); PG8_WAIT_L(0); PG8_BAR; PG8_MMA(1, 0, At, B0); PG8_MMA(1, 1, At, B1); PG8_BAR; PG8_SCHED;
            } else {
            PG8_LDB(B0, 0, 0); PG8_SCHED; PG8_LDA(At, 0, 0); PG8_STAGE(PG8_SA(1, 1), a1 + hstep, voffA);
            PG8_WAIT_L(8); PG8_BAR; PG8_WAIT_L(0); PG8_MMA(0, 0, At, B0); PG8_BAR; PG8_SCHED;
            PG8_LDB(B1, 0, 1); PG8_STAGE(PG8_SB(0, 0), b2, voffB);
            PG8_BAR; PG8_WAIT_L(0); PG8_MMA(0, 1, At, B1); PG8_BAR;
            PG8_LDA(At, 0, 1); PG8_STAGE(PG8_SA(0, 0), a2, voffA);
            PG8_BAR; PG8_WAIT_L(0); PG8_MMA(1, 0, At, B0); PG8_BAR; PG8_SCHED;
            PG8_STAGE(PG8_SB(0, 1), b2 + hstep, voffB);
            PG8_WAIT_V(6); PG8_BAR; PG8_MMA(1, 1, At, B1); PG8_BAR;
            PG8_LDB(B0, 1, 0); PG8_SCHED; PG8_LDA(At, 1, 0); PG8_STAGE(PG8_SA(0, 1), a2 + hstep, voffA);
            PG8_WAIT_L(8); PG8_BAR; PG8_WAIT_L(0); PG8_MMA(0, 0, At, B0); PG8_BAR; PG8_SCHED;
            PG8_LDB(B1, 1, 1); PG8_STAGE(PG8_SB(1, 0), b3, voffB);
            PG8_BAR; PG8_WAIT_L(0); PG8_MMA(0, 1, At, B1); PG8_BAR;
            PG8_LDA(At, 1, 1); PG8_STAGE(PG8_SA(1, 0), a3, voffA);
            PG8_BAR; PG8_WAIT_L(0); PG8_MMA(1, 0, At, B0); PG8_BAR; PG8_SCHED;
            PG8_STAGE(PG8_SB(1, 1), b3 + hstep, voffB);
            PG8_WAIT_V(6); PG8_BAR; PG8_MMA(1, 1, At, B1); PG8_BAR;
            }
        }
        if constexpr (ALIGN_EPI) { if (wr == 0) PG8_BAR; }
        if constexpr (!Epi::AFTER_DRAIN) { E(acc, cur, wr, wc, fr, fq); S.done(cur); }
        if (!has_next) break;
#pragma unroll
        for (int a = 0; a < 2; ++a)
#pragma unroll
            for (int b = 0; b < 2; ++b)
#pragma unroll
                for (int m = 0; m < 4; ++m)
#pragma unroll
                    for (int n = 0; n < 2; ++n) acc[a][b][m][n] = (f32x4){0.f, 0.f, 0.f, 0.f};
        cur = nxt; cA = nA; cB = nB; ++ui;
        if constexpr (ALIGN_EPI) { if (wr == 1) PG8_BAR; }
    }
    PG8_WAIT_V(0);
    if constexpr (!ALIGN_EPI) { if (wr == 0) PG8_BAR; }
    PG8_BAR;
    if constexpr (Epi::AFTER_DRAIN) { E.fused(acc, cur, wr, wc, fr, fq, lds, wid, lane); S.done(cur); }
#undef PG8_SA
#undef PG8_SB
#undef PG8_STAGE
#undef PG8_LDA
#undef PG8_LDB
#undef PG8_MMA
#undef PG8_WAIT_V
#undef PG8_WAIT_L
#undef PG8_BAR
#undef PG8_SCHED
}
}
namespace attn_body {
using bf16=__hip_bfloat16;
using bf16x8=__attribute__((ext_vector_type(8)))short;
using s16x4=__attribute__((ext_vector_type(4)))short;
using f32x16=__attribute__((ext_vector_type(16)))float;
using u32x4=__attribute__((ext_vector_type(4)))unsigned;
constexpr int BATCH=16,NHEAD=8,SEQ=2048,D=64,DM=NHEAD*D;
constexpr int OPITCH=1024,OCOL=512;
constexpr int NW=8,QBLK=32,QB=QBLK*NW,KVBLK=64,NQB=SEQ/QB;
constexpr int ATTN_PITCH=DM, ATTN_UNIT_ROWS=QB;
__device__ __forceinline__ int crow(int r,int hi){return (r&3)+8*(r>>2)+4*hi;}
#define SBAR() __builtin_amdgcn_sched_barrier(0)
__device__ __forceinline__ void cmask(f32x16&p0,f32x16&p1,int jb,int qrel,int hi){
  const float NEG=-INFINITY; int kb=64*jb+4*hi; asm volatile("":"+v"(kb));
  #pragma unroll
  for(int r=0;r<16;++r){int kv=kb+(r&3)+8*(r>>2); if(kv>qrel)p0[r]=NEG; if(kv+32>qrel)p1[r]=NEG;}
}

constexpr int NSLOT=3, SLOTB=8192;
constexpr int LDS_K=0, LDS_V=NSLOT*SLOTB, LDS_WS=2*NSLOT*SLOTB, LDS_OST=LDS_WS+NW*64*4, LDS_KB=LDS_OST+NW*4096, LDS_BYTES=LDS_KB+SEQ*4;
constexpr float FLOOR=-2048.f, LOG2E_=1.4426950408889634f, ACP_T=24.f;
constexpr float C2=0.125f*1.4426950408889634f;
__device__ __forceinline__ void glds16(const void*gsrc,unsigned lds_dst){unsigned keep;
  asm volatile("s_mov_b32 %0, m0\n\ts_mov_b32 m0, %2\n\ts_nop 0\n\tglobal_load_lds_dwordx4 %1, off\n\ts_mov_b32 m0, %0":"=&s"(keep):"v"(gsrc),"s"(lds_dst):"memory");}
__device__ __forceinline__ void glds16s(const void*sbase,unsigned voff,unsigned lds_dst){unsigned keep;
  asm volatile("s_mov_b32 %0, m0\n\ts_mov_b32 m0, %3\n\ts_nop 0\n\tglobal_load_lds_dwordx4 %1, %2\n\ts_mov_b32 m0, %0":"=&s"(keep):"v"(voff),"s"(sbase),"s"(lds_dst):"memory");}
__device__ __forceinline__ float max3f(float a,float b,float c){float r;asm("v_max3_f32 %0, %1, %2, %3":"=v"(r):"v"(a),"v"(b),"v"(c));return r;}
__device__ __forceinline__ float max2f(float a,float b){float r;asm("v_max_f32_e32 %0, %1, %2":"=v"(r):"v"(a),"v"(b));return r;}
__device__ __forceinline__ float fadd_s(float a,float b){float r;asm("v_add_f32_e32 %0, %1, %2":"=v"(r):"v"(a),"v"(b));return r;}
__device__ __forceinline__ float fsub_s(float a,float b){float r;asm("v_sub_f32_e32 %0, %1, %2":"=v"(r):"v"(a),"v"(b));return r;}
typedef float f32x2_t __attribute__((ext_vector_type(2))); typedef float f32x4_t __attribute__((ext_vector_type(4))); typedef __bf16 bf16x2_t __attribute__((ext_vector_type(2)));
__device__ __forceinline__ unsigned cvtpk_s(float lo,float hi){f32x2_t v={lo,hi};bf16x2_t b=__builtin_convertvector(v,bf16x2_t);return __builtin_bit_cast(unsigned,b);}
#define WAIT_BAR(N) asm volatile("s_waitcnt vmcnt(" #N ") lgkmcnt(0)\n\ts_barrier":::"memory")

__device__ __forceinline__ void qkt(f32x16&p0,f32x16&p1,const char*Kslot,const bf16x8*qr,int r32,int hi){
  const char*kb=Kslot+hi*1024+r32*16;
  #pragma unroll
  for(int d0=0;d0<4;++d0){
    const bf16x8 b0=*reinterpret_cast<const bf16x8*>(kb+d0*2048);
    const bf16x8 b1=*reinterpret_cast<const bf16x8*>(kb+d0*2048+512);
    {p0=__builtin_amdgcn_mfma_f32_32x32x16_bf16(b0,qr[d0],p0,0,0,0);p1=__builtin_amdgcn_mfma_f32_32x32x16_bf16(b1,qr[d0],p1,0,0,0);}}
}
typedef __attribute__((address_space(3))) const char* lds_cptr;
typedef short v4i16_t __attribute__((ext_vector_type(4)));
__device__ __forceinline__ void kload8(bf16x8*kf,lds_cptr kp){
  kf[0]=*(const __attribute__((address_space(3))) bf16x8*)(kp);      kf[1]=*(const __attribute__((address_space(3))) bf16x8*)(kp+512);
  kf[2]=*(const __attribute__((address_space(3))) bf16x8*)(kp+2048); kf[3]=*(const __attribute__((address_space(3))) bf16x8*)(kp+2560);
  kf[4]=*(const __attribute__((address_space(3))) bf16x8*)(kp+4096); kf[5]=*(const __attribute__((address_space(3))) bf16x8*)(kp+4608);
  kf[6]=*(const __attribute__((address_space(3))) bf16x8*)(kp+6144); kf[7]=*(const __attribute__((address_space(3))) bf16x8*)(kp+6656);
}
__device__ __forceinline__ void kload2(bf16x8*kf,lds_cptr kp,int j){ kf[2*j]=*(const __attribute__((address_space(3))) bf16x8*)(kp+j*2048); kf[2*j+1]=*(const __attribute__((address_space(3))) bf16x8*)(kp+j*2048+512); }
__device__ __forceinline__ s16x4 vtr(lds_cptr p){ return __builtin_bit_cast(s16x4,__builtin_amdgcn_ds_read_tr16_b64_v4i16((__attribute__((address_space(3))) v4i16_t*)p)); }
__device__ __forceinline__ float rowmax(const f32x16&p0,const f32x16&p1){
  float a=max3f(p0[0],p0[1],p1[0]),b=max3f(p0[2],p0[3],p1[1]);a=max3f(a,p1[2],p1[3]);
  #pragma unroll
  for(int r=4;r<16;r+=4){a=max3f(a,p0[r],p0[r+1]);b=max3f(b,p0[r+2],p0[r+3]);a=max3f(a,p1[r],p1[r+1]);b=max3f(b,p1[r+2],p1[r+3]);}
  const float m=max2f(a,b);
  auto rr=__builtin_amdgcn_permlane32_swap(__float_as_uint(m),__float_as_uint(m),false,false);
  return max2f(__uint_as_float(rr[0]),__uint_as_float(rr[1]));
}
__device__ __forceinline__ void pv(f32x16*o,int vb,bf16x8 pa0,bf16x8 pa1,bf16x8 pa2,bf16x8 pa3){
  #pragma unroll
  for(int d0=0;d0<2;++d0){s16x4 lo[4],hi[4];
    #pragma unroll
    for(int ks=0;ks<4;++ks){
      asm volatile("ds_read_b64_tr_b16 %0,%1 offset:%c2":"=&v"(lo[ks]):"v"(vb),"i"(d0*4096+ks*1024):"memory");
      asm volatile("ds_read_b64_tr_b16 %0,%1 offset:%c2":"=&v"(hi[ks]):"v"(vb),"i"(d0*4096+ks*1024+512):"memory");}
    asm volatile("s_waitcnt lgkmcnt(0)":::"memory");SBAR();
    #define PK(k) (bf16x8){lo[k][0],lo[k][1],lo[k][2],lo[k][3],hi[k][0],hi[k][1],hi[k][2],hi[k][3]}
    o[d0]=__builtin_amdgcn_mfma_f32_32x32x16_bf16(pa0,PK(0),o[d0],0,0,0);
    o[d0]=__builtin_amdgcn_mfma_f32_32x32x16_bf16(pa1,PK(1),o[d0],0,0,0);
    o[d0]=__builtin_amdgcn_mfma_f32_32x32x16_bf16(pa2,PK(2),o[d0],0,0,0);
    o[d0]=__builtin_amdgcn_mfma_f32_32x32x16_bf16(pa3,PK(3),o[d0],0,0,0);
    #undef PK
  }
}

#ifndef ATTN_STORE16
#define ATTN_STORE16(p,v) (*(u32x4*)(p)=(v))
#endif
template<int THRL> __device__ __forceinline__ void attn_unit(int b,int h,int qb,const bf16*Q,const bf16*__restrict__ K,const bf16*__restrict__ V,const bf16*__restrict__ G,const float*__restrict__ CC,const float qm2,const float km2,bf16*O,char*shm){
  int tid_=threadIdx.x; asm volatile("":"+v"(tid_));
  const int tid=tid_,lane=tid&63,r32=lane&31,hi=lane>>5; const int wid=__builtin_amdgcn_readfirstlane(tid>>6);
  const long rowbase=(long)b*SEQ; const int q0=qb*QB;
  const bf16*Qw=Q+(rowbase+q0+wid*QBLK)*DM+h*D;
  const bf16*Kh=K+rowbase*DM+h*D,*Vh=V+rowbase*DM+h*D;
  const unsigned lds0=(unsigned)(uintptr_t)shm;
  float*wsf=(float*)(shm+LDS_WS)+wid*64;
  const unsigned kvoff=(unsigned)(wid*1024+lane*16), vvoff=kvoff;
  const char*Khb=(const char*)K+(size_t)(b*NHEAD+h)*32*8192,*Vhb=(const char*)V+(size_t)(b*NHEAD+h)*32*8192;
  const unsigned kdst=lds0+LDS_K+wid*1024, vdst=lds0+LDS_V+wid*1024;
  #define DMA_K(t,slot) glds16s(Khb+(long)(NT-1-(t))*8192,kvoff,(unsigned)__builtin_amdgcn_readfirstlane(kdst+(slot)))
  #define DMA_V(t,slot) glds16s(Vhb+(long)(NT-1-(t))*8192,vvoff,(unsigned)__builtin_amdgcn_readfirstlane(vdst+(slot)))
  const char*Kbase=shm+LDS_K; bf16x8 kf[8];
  const lds_cptr shm3=(lds_cptr)shm; const lds_cptr kp0=shm3+LDS_K+hi*1024+r32*16; const lds_cptr vp0=shm3+LDS_V+((lane>>4)&1)*32+(lane&3)*8+(4*hi+((lane&15)>>2))*64;
  const int NT=(q0+QB)/KVBLK;
  DMA_K(0,0);DMA_V(0,0);DMA_K(1,SLOTB);
  int NTE=NT;
  { const float*cc=CC+(long)(b*NHEAD+h)*SEQ; const float cref=cc[q0]; float*kbw=(float*)(shm+LDS_KB);
    const float clast=cc[64*(lane<NT?lane:0)+63];
    float cv[4];
    #pragma unroll
    for(int i=0;i<4;++i){const int k=tid+i*NW*64; cv[i]=(k<q0+QB)?cc[k]:0.f;}
    const float QK=2.04f*__builtin_amdgcn_sqrtf(qm2*km2);   const float bound=-(ACP_T+2.f*QK);
    const bool sk=(lane<NT)&&((cref-clast)*LOG2E_<bound);
    const unsigned long long bal=__ballot(sk); const int j0=__builtin_ctzll(~bal);
    NTE=NT-j0; if(NTE<4)NTE=4; NTE=__builtin_amdgcn_readfirstlane(NTE);
    #pragma unroll
    for(int i=0;i<4;++i){const int k=tid+i*NW*64; if(k<q0+QB)kbw[k]=(cref-cv[i])*LOG2E_;} }
  const lds_cptr kbp=(lds_cptr)shm+LDS_KB+hi*16;
  #define CINIT(C0,C1,tt) do{ const lds_cptr kq_=kbp+(NT-1-(tt))*256; const float nm_=-mhat; \
    _Pragma("unroll") for(int g_=0;g_<4;++g_){ const f32x4_t a_=*(const __attribute__((address_space(3))) f32x4_t*)(kq_+g_*32); const f32x4_t b_=*(const __attribute__((address_space(3))) f32x4_t*)(kq_+128+g_*32); \
      C0[4*g_]=a_[0]+nm_;C0[4*g_+1]=a_[1]+nm_;C0[4*g_+2]=a_[2]+nm_;C0[4*g_+3]=a_[3]+nm_; C1[4*g_]=b_[0]+nm_;C1[4*g_+1]=b_[1]+nm_;C1[4*g_+2]=b_[2]+nm_;C1[4*g_+3]=b_[3]+nm_; } }while(0)
  bf16x8 qr[4];
  #pragma unroll
  for(int d0=0;d0<4;++d0)qr[d0]=*reinterpret_cast<const bf16x8*>(&Qw[(long)r32*DM+d0*16+hi*8]);
  float mhat=0.f,l_reg=0.f;f32x16 o[2];o[0]=f32x16{};o[1]=f32x16{};
  float qkrow; { float n2=0.f;
    #pragma unroll
    for(int d0=0;d0<4;++d0){
      #pragma unroll
      for(int e=0;e<8;++e){const float x=__uint_as_float((unsigned)(unsigned short)qr[d0][e]<<16); n2+=x*x;} }
    auto rr=__builtin_amdgcn_permlane32_swap(__float_as_uint(n2),__float_as_uint(n2),false,false); n2=__uint_as_float(rr[0])+__uint_as_float(rr[1]);
    qkrow=1.02f*__builtin_amdgcn_sqrtf(n2)*__builtin_amdgcn_sqrtf(2.f*km2); }
  const int qrel=wid*QBLK+r32;
  #define CMASK(P0,P1,t) do{int jb_=3-(t); if(jb_>=0)cmask(P0,P1,jb_,qrel,hi);}while(0)
  bool resc=false;
  #define START(P0,P1) do{ const float rm=rowmax(P0,P1); resc=false; \
    { const float dl=__builtin_fmaxf(rm,FLOOR); mhat=fadd_s(mhat,dl); \
      _Pragma("unroll") for(int r=0;r<16;++r){P0[r]=fsub_s(P0[r],dl);P1[r]=fsub_s(P1[r],dl);} } \
    _Pragma("unroll") for(int r=0;r<16;++r)P0[r]=__builtin_amdgcn_exp2f(P0[r]); }while(0)
  #define RESC() do{ if(resc){ asm volatile("s_waitcnt lgkmcnt(0)":::"memory"); \
      _Pragma("unroll") for(int d_=0;d_<2;++d_) _Pragma("unroll") for(int r=0;r<16;++r)o[d_][r]*=wsf[crow(r,hi)]; } }while(0)
  f32x16 pA0,pA1,pB0,pB1;
  int sl_prev=0,sl_cur=0,sl_next=SLOTB;
  #define ROT() do{sl_prev=sl_cur;sl_cur=sl_next;sl_next=(sl_next==(NSLOT-1)*SLOTB)?0:sl_next+SLOTB;}while(0)
  DMA_K(2,2*SLOTB);
  WAIT_BAR(3);
  CINIT(pA0,pA1,0); qkt(pA0,pA1,Kbase,qr,r32,hi);asm volatile("s_nop 15\n\ts_nop 7":"+v"(pA0),"+v"(pA1));CMASK(pA0,pA1,0);
  START(pA0,pA1);
  _Pragma("unroll") for(int r=0;r<16;++r)pA1[r]=__builtin_amdgcn_exp2f(pA1[r]);
  WAIT_BAR(0);
  DMA_K(3,0);DMA_V(1,SLOTB);
  ROT();
  kload8(kf,kp0+sl_cur);
  WAIT_BAR(2);
  s16x4 vlo[8],vhi[8]; u32x4 pw0,pw1,pw2,pw3;
  #define PKW(P,B) cvtpk_s(P[B],P[B+1])
  #define PAF(k) __builtin_bit_cast(bf16x8,pw##k)
  #define VFR(i) (bf16x8){vlo[i][0],vlo[i][1],vlo[i][2],vlo[i][3],vhi[i][0],vhi[i][1],vhi[i][2],vhi[i][3]}
  #define PIN(x) asm volatile("":"+v"(x))
  #define MX3(a,b,c) __builtin_fmaxf(__builtin_fmaxf((a),(b)),(c))
  #define GAPA(MF,A0,A1,A2,A3,W0,W1,PW) do{ MF; sacc+=A0; sacc+=A1; sacc+=A2; sacc+=A3; PIN(sacc); W0; W1; PIN(PW); SBAR(); }while(0)
  #define EX(v) __builtin_amdgcn_exp2f(v)
  #define GAPB(MF,X,B) do{ MF; X[B]=EX(X[B]); X[B+1]=EX(X[B+1]); X[B+2]=EX(X[B+2]); X[B+3]=EX(X[B+3]); PIN(X); SBAR(); }while(0)
  #define VRD(i) do{ vlo[i]=vtr(vp_+(((i)>>2)*4096+((i)&3)*1024)); vhi[i]=vtr(vp_+(((i)>>2)*4096+((i)&3)*1024+512)); }while(0)
  #define KRD(G,j) do{ if(G){ kload2(kf,kp0+sl_next,j); SBAR(); } }while(0)
  #define STEP(C0,C1,P0,P1,t,GK,GV,GL) do{ SBAR(); \
    CINIT(C0,C1,t); SBAR(); \
    const lds_cptr vp_=vp0+sl_prev; \
    VRD(0); SBAR(); float sacc=(P0[0]+P0[1]); \
    GAPA(C0=__builtin_amdgcn_mfma_f32_32x32x16_bf16(kf[0],qr[0],C0,0,0,0), P0[2],P0[3],P0[4],P0[5],     pw0[0]=PKW(P0,0), pw0[1]=PKW(P0,2), pw0); \
    VRD(4); SBAR(); GAPA(C1=__builtin_amdgcn_mfma_f32_32x32x16_bf16(kf[1],qr[0],C1,0,0,0), P0[6],P0[7],P0[8],P0[9],     pw0[2]=PKW(P0,4), pw0[3]=PKW(P0,6), pw0); \
    VRD(1); SBAR(); GAPA(C0=__builtin_amdgcn_mfma_f32_32x32x16_bf16(kf[2],qr[1],C0,0,0,0),   P0[10],P0[11],P0[12],P0[13], pw1[0]=PKW(P0,8), pw1[1]=PKW(P0,10), pw1); \
    VRD(5); SBAR(); GAPA(C1=__builtin_amdgcn_mfma_f32_32x32x16_bf16(kf[3],qr[1],C1,0,0,0),   P0[14],P0[15],P1[0],P1[1],   pw1[2]=PKW(P0,12),pw1[3]=PKW(P0,14), pw1); \
    VRD(2); SBAR(); GAPA(C0=__builtin_amdgcn_mfma_f32_32x32x16_bf16(kf[4],qr[2],C0,0,0,0),   P1[2],P1[3],P1[4],P1[5],     pw2[0]=PKW(P1,0), pw2[1]=PKW(P1,2), pw2); \
    VRD(6); SBAR(); GAPA(C1=__builtin_amdgcn_mfma_f32_32x32x16_bf16(kf[5],qr[2],C1,0,0,0),   P1[6],P1[7],P1[8],P1[9],     pw2[2]=PKW(P1,4), pw2[3]=PKW(P1,6), pw2); \
    VRD(3); SBAR(); GAPA(C0=__builtin_amdgcn_mfma_f32_32x32x16_bf16(kf[6],qr[3],C0,0,0,0),   P1[10],P1[11],P1[12],P1[13], pw3[0]=PKW(P1,8), pw3[1]=PKW(P1,10), pw3); \
    VRD(7); SBAR(); GAPA(C1=__builtin_amdgcn_mfma_f32_32x32x16_bf16(kf[7],qr[3],C1,0,0,0),   P1[14],P1[15],0.f,0.f,       pw3[2]=PKW(P1,12),pw3[3]=PKW(P1,14), pw3); \
    l_reg+=sacc; \
    if(GK){DMA_K((t)+3,sl_cur);} if(GV){DMA_V((t)+1,sl_next);} \
    CMASK(C0,C1,t); \
    { float a=MX3(C0[0],C0[1],C1[0]),b=MX3(C0[2],C0[3],C1[1]); a=MX3(a,C1[2],C1[3]); \
      _Pragma("unroll") for(int r=4;r<16;r+=4){a=MX3(a,C0[r],C0[r+1]);b=MX3(b,C0[r+2],C0[r+3]);a=MX3(a,C1[r],C1[r+1]);b=MX3(b,C1[r+2],C1[r+3]);} \
      float rm=__builtin_fmaxf(a,b); { auto rr=__builtin_amdgcn_permlane32_swap(__float_as_uint(rm),__float_as_uint(rm),false,false); rm=__builtin_fmaxf(__uint_as_float(rr[0]),__uint_as_float(rr[1])); } \
      resc=false; \
      if(__builtin_expect(__any(rm>(float)THRL),0)){ const float dl=__builtin_fmaxf(rm,0.f); mhat+=dl; \
        _Pragma("unroll") for(int r=0;r<16;++r){C0[r]-=dl;C1[r]-=dl;} \
        const float f=__builtin_amdgcn_exp2f(-dl); l_reg*=f; if(hi==0)wsf[r32]=f; resc=true; } } \
    SBAR(); \
    GAPB(o[0]=__builtin_amdgcn_mfma_f32_32x32x16_bf16(PAF(0),VFR(0),o[0],0,0,0), C0,0); \
    GAPB(o[1]=__builtin_amdgcn_mfma_f32_32x32x16_bf16(PAF(0),VFR(4),o[1],0,0,0), C0,4); \
    KRD(GL,0); GAPB(o[0]=__builtin_amdgcn_mfma_f32_32x32x16_bf16(PAF(1),VFR(1),o[0],0,0,0), C0,8); \
    KRD(GL,1); GAPB(o[1]=__builtin_amdgcn_mfma_f32_32x32x16_bf16(PAF(1),VFR(5),o[1],0,0,0), C0,12); \
    KRD(GL,2); GAPB(o[0]=__builtin_amdgcn_mfma_f32_32x32x16_bf16(PAF(2),VFR(2),o[0],0,0,0), C1,0); \
    KRD(GL,3); GAPB(o[1]=__builtin_amdgcn_mfma_f32_32x32x16_bf16(PAF(2),VFR(6),o[1],0,0,0), C1,4); \
    GAPB(o[0]=__builtin_amdgcn_mfma_f32_32x32x16_bf16(PAF(3),VFR(3),o[0],0,0,0), C1,8); \
    GAPB(o[1]=__builtin_amdgcn_mfma_f32_32x32x16_bf16(PAF(3),VFR(7),o[1],0,0,0), C1,12); \
    }while(0)
  int t=1;
  #define ENDW(tt) do{ if((tt)+3<NTE){WAIT_BAR(2);} else if((tt)+2<NTE){WAIT_BAR(1);} else {WAIT_BAR(0);} }while(0)
  for(;t<5&&t+2<NTE;t+=2){
    STEP(pB0,pB1,pA0,pA1,t,(t+3<NTE),(t+1<NTE),(t+1<NTE));       ENDW(t);   RESC(); ROT();
    if(t==3&&NTE>6){
      float sl=mhat-qkrow;
      sl=fminf(sl,__uint_as_float(__builtin_amdgcn_update_dpp(__float_as_uint(sl),__float_as_uint(sl),0xB1,0xf,0xf,false)));
      sl=fminf(sl,__uint_as_float(__builtin_amdgcn_update_dpp(__float_as_uint(sl),__float_as_uint(sl),0x4E,0xf,0xf,false)));
      sl=fminf(sl,__uint_as_float(__builtin_amdgcn_update_dpp(__float_as_uint(sl),__float_as_uint(sl),0x124,0xf,0xf,false)));
      sl=fminf(sl,__uint_as_float(__builtin_amdgcn_update_dpp(__float_as_uint(sl),__float_as_uint(sl),0x128,0xf,0xf,false)));
      { auto r_=__builtin_amdgcn_permlane16_swap(__float_as_uint(sl),__float_as_uint(sl),false,false); sl=fminf(__uint_as_float(r_[0]),__uint_as_float(r_[1])); }
      { auto r_=__builtin_amdgcn_permlane32_swap(__float_as_uint(sl),__float_as_uint(sl),false,false); sl=fminf(__uint_as_float(r_[0]),__uint_as_float(r_[1])); }
      if(lane==0)wsf[32]=sl;
      asm volatile("s_waitcnt lgkmcnt(0)\n\ts_barrier":::"memory");
      float smin=((const float*)(shm+LDS_WS))[32];
      #pragma unroll
      for(int w_=1;w_<NW;++w_)smin=fminf(smin,((const float*)(shm+LDS_WS))[w_*64+32]);
      const float kl=((const float*)(shm+LDS_KB))[64*(lane<NT?lane:0)+63];
      const bool sk2=(lane<NT)&&(kl<smin-ACP_T);
      const unsigned long long bal2=__ballot(sk2); int n2_=NT-__builtin_ctzll(~bal2); if(n2_<6)n2_=6;
      n2_=__builtin_amdgcn_readfirstlane(n2_); if(n2_<NTE)NTE=n2_;
    }
    STEP(pA0,pA1,pB0,pB1,t+1,(t+4<NTE),(t+2<NTE),(t+2<NTE));     ENDW(t+1); RESC(); ROT();
  }
  #undef CMASK
  #define CMASK(P0,P1,t) do{}while(0)
  for(;t+5<NTE;t+=2){
    STEP(pB0,pB1,pA0,pA1,t,true,true,true);     WAIT_BAR(2); RESC(); ROT();
    STEP(pA0,pA1,pB0,pB1,t+1,true,true,true);   WAIT_BAR(2); RESC(); ROT();
  }
  #undef CMASK
  #define CMASK(P0,P1,t) do{int jb_=3-(t); if(jb_>=0)cmask(P0,P1,jb_,qrel,hi);}while(0)
  for(;t+2<NTE;t+=2){
    STEP(pB0,pB1,pA0,pA1,t,(t+3<NTE),(t+1<NTE),(t+1<NTE));       ENDW(t);   RESC(); ROT();
    STEP(pA0,pA1,pB0,pB1,t+1,(t+4<NTE),(t+2<NTE),(t+2<NTE));     ENDW(t+1); RESC(); ROT();
  }
  if(t+2==NTE){
    STEP(pB0,pB1,pA0,pA1,t,false,true,true);  WAIT_BAR(0); RESC(); ROT(); ++t;
    pA0=pB0; pA1=pB1;
  }
  const bf16*Gw=G+(rowbase+q0+wid*QBLK)*DM+h*D; u32x4 gpre[4];
  { int lane_g=lane; asm volatile("":"+v"(lane_g));
    #pragma unroll
    for(int i=0;i<4;++i)gpre[i]=*(const u32x4*)(Gw+(long)(i*8+(lane_g>>3))*DM+(lane_g&7)*8); }
  STEP(pB0,pB1,pA0,pA1,NTE-1,false,false,false); RESC();
  { float sacc=pB0[0]+pB0[1]; _Pragma("unroll") for(int r=2;r<16;++r)sacc+=pB0[r]; _Pragma("unroll") for(int r=0;r<16;++r)sacc+=pB1[r]; l_reg+=sacc;
    pw0=(u32x4){PKW(pB0,0),PKW(pB0,2),PKW(pB0,4),PKW(pB0,6)};pw1=(u32x4){PKW(pB0,8),PKW(pB0,10),PKW(pB0,12),PKW(pB0,14)};pw2=(u32x4){PKW(pB1,0),PKW(pB1,2),PKW(pB1,4),PKW(pB1,6)};pw3=(u32x4){PKW(pB1,8),PKW(pB1,10),PKW(pB1,12),PKW(pB1,14)};
    SBAR(); pv(o,(int)(unsigned)(size_t)vp0+sl_cur,PAF(0),PAF(1),PAF(2),PAF(3)); }
  #undef PKW
  #undef PAF
  #undef VFR
  #undef PIN
  #undef MX3
  #undef GAPA
  #undef GAPB
  #undef EX
  #undef VRD
  #undef KRD
  #undef STEP
  #undef ENDW
  {auto rr=__builtin_amdgcn_permlane32_swap(__float_as_uint(l_reg),__float_as_uint(l_reg),false,false);l_reg=__uint_as_float(rr[0])+__uint_as_float(rr[1]);}
  if(hi==0)wsf[32+r32]=l_reg;asm volatile("s_waitcnt lgkmcnt(0)":::"memory");
  float rli[16];
  #pragma unroll
  for(int r=0;r<16;++r)rli[r]=__builtin_amdgcn_rcpf(wsf[32+crow(r,hi)]);
  bf16*Ow=O+(rowbase+q0+wid*QBLK)*OPITCH+OCOL+h*D;
  { bf16*stg=(bf16*)(shm+LDS_OST)+wid*2048;
    #pragma unroll
    for(int r=0;r<16;++r){const int orow=crow(r,hi);
      #pragma unroll
      for(int d0=0;d0<2;++d0)stg[orow*64+d0*32+r32]=__float2bfloat16(o[d0][r]*rli[r]);}
    asm volatile("s_waitcnt lgkmcnt(0)":::"memory");
    int lane_e=lane; asm volatile("":"+v"(lane_e));
    #pragma unroll
    for(int i=0;i<4;++i){const int row=i*8+(lane_e>>3),ch=lane_e&7; const u32x4 v=*(const u32x4*)(stg+row*64+ch*8); const u32x4 g=gpre[i]; u32x4 w;
      #pragma unroll
      for(int e=0;e<4;++e){ const float lo=__uint_as_float(v[e]<<16)*__uint_as_float(g[e]<<16), hi_=__uint_as_float(v[e]&0xffff0000u)*__uint_as_float(g[e]&0xffff0000u); w[e]=cvtpk_s(lo,hi_); }
      ATTN_STORE16(Ow+(long)row*OPITCH+ch*8,w);} }
  asm volatile("s_waitcnt lgkmcnt(0)\n\ts_barrier":::"memory");
  #undef DMA_K
  #undef DMA_V
  #undef CMASK
  #undef START
  #undef RESC
  #undef ROT
}
constexpr int ATTN_LDS_BYTES=LDS_BYTES;
struct AttnTensors { const bf16* Q; const bf16* K; const bf16* V; const bf16* G; const float* CC; bf16* O; };
struct AttnUnit { int bh; int qb; };
struct StaticOrder {
  int vcu,G;
  __device__ __forceinline__ explicit StaticOrder(int grid,int block):vcu((grid%8==0)?(block%8)*(grid/8)+block/8:block),G(grid){}
  __device__ __forceinline__ bool next(int i,AttnUnit&u)const{ const int v=vcu+(i>>2)*G; if(v>=256)return false; const int s=2*(v&1),j=i&3; u.bh=v>>1; u.qb=(j==0)?7-s:(j==1)?s:(j==2)?6-s:s+1; return true; }
  __device__ __forceinline__ void a_ready(const AttnUnit&)const{}
  __device__ __forceinline__ void done(const AttnUnit&)const{}
};
template<class Sched,int THRL=8> __device__ __forceinline__ void attn_phase(char*lds,const AttnTensors&T,const Sched&S){
  AttnUnit u;
  for(int i=0;S.next(i,u);++i){ S.a_ready(u); attn_unit<THRL>(u.bh/NHEAD,u.bh%NHEAD,u.qb,T.Q,T.K,T.V,T.G,T.CC,T.O,lds); S.done(u); }
}
#undef SBAR
#undef WAIT_BAR
}
namespace hg {
typedef __attribute__((address_space(3))) unsigned char* lptr;
typedef short bf16x8 __attribute__((ext_vector_type(8)));
typedef short s16x4 __attribute__((ext_vector_type(4)));
typedef float f32x16 __attribute__((ext_vector_type(16)));
typedef float f32x4 __attribute__((ext_vector_type(4)));
typedef unsigned u32x4 __attribute__((ext_vector_type(4)));
typedef unsigned u32x2 __attribute__((ext_vector_type(2)));
constexpr int P = 144;
constexpr int L_QD = 0, L_QH = 9216, L_KD = 18432, L_KO = 27648, L_KHT = 32256, L_VT = 41472, L_ST = 50688, L_TOT = 59904, L_EB = 61952, L_SS = 62208, L_STG = 62720, SPH = 80, L_END = L_STG + 4 * 32 * SPH;
__device__ __forceinline__ int crow(int r, int hi) { return (r & 3) + 8 * (r >> 2) + 4 * hi; }
typedef float f32x2_t __attribute__((ext_vector_type(2))); typedef __bf16 bf16x2_t __attribute__((ext_vector_type(2)));
__device__ __forceinline__ unsigned cvtpk(float lo, float hi) { f32x2_t v = {lo, hi}; bf16x2_t b = __builtin_convertvector(v, bf16x2_t); return __builtin_bit_cast(unsigned, b); }
__device__ __forceinline__ unsigned short cvt1(float x) { return (unsigned short)(cvtpk(x, 0.f) & 0xffffu); }
#define HG_MFMA(a, b, c) __builtin_amdgcn_mfma_f32_32x32x16_bf16((a), (b), (c), 0, 0, 0)

__device__ __forceinline__ void hgrn_item(int b, int h, const unsigned short* QA, const float* LF, const unsigned short* IA, const unsigned short* GA, const float* gnorm, unsigned short* MIX, unsigned char* shm_) {
    int tid_ = threadIdx.x; asm volatile("" : "+v"(tid_));
    const int tid = tid_, lane = tid & 63, w = __builtin_amdgcn_readfirstlane(tid >> 6), r = lane & 31, hh = lane >> 5;
    const lptr shm = (lptr)shm_;
    const int colh = h * 64 + lane;
    for (int e = tid; e < 64 * P / 4; e += 512) ((__attribute__((address_space(3))) unsigned*)(shm + L_ST))[e] = 0u;
    f32x16 S = {};
    const bool outw = w < 4; const int I = (w >> 1) & 1, vt = w & 1, dt = (w >> 1) & 1;
    float nlf[8]; unsigned short nq[8], nv[8];
    { const size_t m0 = (size_t)b * SEQ + 8 * w;
#pragma unroll
      for (int i = 0; i < 8; ++i) { nlf[i] = LF[(m0 + i) * 256 + colh]; nq[i] = QA[(m0 + i) * 256 + colh]; nv[i] = IA[(m0 + i) * 256 + colh]; } }
    for (int c = 0; c < SEQ / 64; ++c) {
        const size_t row0 = (size_t)b * SEQ + c * 64;
        float l2[8]; unsigned short qv[8], vv[8];
#pragma unroll
        for (int i = 0; i < 8; ++i) { l2[i] = nlf[i]; qv[i] = nq[i]; vv[i] = nv[i]; }
        float cs[8]; { float s = 0.f;
#pragma unroll
            for (int i = 0; i < 8; ++i) { s += l2[i]; cs[i] = s; } }
        ((__attribute__((address_space(3))) float*)(shm + L_TOT))[w * 64 + lane] = cs[7];
        __syncthreads();
        float pre = 0.f, r1 = 0.f, blast = 0.f;
#pragma unroll
        for (int j = 0; j < 8; ++j) { const float t = ((__attribute__((address_space(3))) const float*)(shm + L_TOT))[j * 64 + lane]; if (j < w) pre += t; if (j < 4) r1 += t; blast += t; }
        const float er1 = __builtin_amdgcn_exp2f(r1), rI = (w >= 4) ? r1 : 0.f, e1 = (w >= 4) ? er1 : 1.0f, e2 = __builtin_amdgcn_exp2f(blast - rI);
        unsigned khp[4];
#pragma unroll
        for (int i = 0; i < 8; i += 2) {
            float kh2[2];
#pragma unroll
            for (int ii = 0; ii < 2; ++ii) {
                const int t = i + ii; const float bt = pre + cs[t]; const float f = __builtin_amdgcn_exp2f(l2[t]); const float k = 1.0f - f; const float q = __uint_as_float((unsigned)qv[t] << 16);
                const float qd = q * __builtin_amdgcn_exp2f(bt - rI), qh = qd * e1, kd = k * __builtin_amdgcn_exp2f(rI - bt);
                kh2[ii] = kd * e2;
                const int ro = (8 * w + t) * P + lane * 2;
                *(__attribute__((address_space(3))) unsigned short*)(shm + L_QD + ro) = cvt1(qd);
                *(__attribute__((address_space(3))) unsigned short*)(shm + L_QH + ro) = cvt1(qh);
                *(__attribute__((address_space(3))) unsigned short*)(shm + L_KD + ro) = cvt1(kd);
                if (w < 4) *(__attribute__((address_space(3))) unsigned short*)(shm + L_KO + ro) = cvt1(kd * er1);
            }
            khp[i >> 1] = cvtpk(kh2[0], kh2[1]);
        }
        *(__attribute__((address_space(3))) u32x4*)(shm + L_KHT + lane * P + w * 16) = (u32x4){khp[0], khp[1], khp[2], khp[3]};
        *(__attribute__((address_space(3))) u32x4*)(shm + L_VT + lane * P + w * 16) = (u32x4){(unsigned)vv[0] | ((unsigned)vv[1] << 16), (unsigned)vv[2] | ((unsigned)vv[3] << 16), (unsigned)vv[4] | ((unsigned)vv[5] << 16), (unsigned)vv[6] | ((unsigned)vv[7] << 16)};
        if (w == 0) ((__attribute__((address_space(3))) float*)(shm + L_EB))[lane] = __builtin_amdgcn_exp2f(blast);
        if (c + 1 < SEQ / 64) { const size_t m0 = row0 + 64 + 8 * w;
#pragma unroll
            for (int i = 0; i < 8; ++i) { nlf[i] = LF[(m0 + i) * 256 + colh]; nq[i] = QA[(m0 + i) * 256 + colh]; nv[i] = IA[(m0 + i) * 256 + colh]; } }
        __syncthreads();
        f32x16 OT = {}; u32x4 gt[2];
        if (outw) {
            { const unsigned short* gp = GA + (row0 + 32 * I + (lane >> 2)) * 256 + h * 64 + 32 * vt + (lane & 3) * 8;
              gt[0] = *(const u32x4*)gp; gt[1] = *(const u32x4*)(gp + 16 * 256); }
#pragma unroll
            for (int J = 0; J < 2; ++J) {
                if (J <= I) {
                    const bool diag = (J == I);
                    const lptr kb = diag ? (shm + L_KD + (32 * J + r) * P + hh * 16) : (shm + L_KO + r * P + hh * 16);
                    const lptr qb = shm + L_QD + (32 * I + r) * P + hh * 16;
                    f32x16 XT = {};
#pragma unroll
                    for (int kk = 0; kk < 4; ++kk) XT = HG_MFMA(*(__attribute__((address_space(3))) const bf16x8*)(kb + kk * 32), *(__attribute__((address_space(3))) const bf16x8*)(qb + kk * 32), XT);
                    if (diag) {
#pragma unroll
                        for (int g = 0; g < 16; ++g) if (crow(g, hh) > r) XT[g] = 0.f;
                    }
                    const lptr vb = shm + L_VT + (32 * vt + r) * P + (32 * J + 4 * hh) * 2;
#pragma unroll
                    for (int sp = 0; sp < 2; ++sp) {
                        const u32x4 xb = {cvtpk(XT[8 * sp], XT[8 * sp + 1]), cvtpk(XT[8 * sp + 2], XT[8 * sp + 3]), cvtpk(XT[8 * sp + 4], XT[8 * sp + 5]), cvtpk(XT[8 * sp + 6], XT[8 * sp + 7])};
                        const u32x2 a0 = *(__attribute__((address_space(3))) const u32x2*)(vb + sp * 32), a1 = *(__attribute__((address_space(3))) const u32x2*)(vb + sp * 32 + 16);
                        const u32x4 av = {a0[0], a0[1], a1[0], a1[1]};
                        OT = HG_MFMA(__builtin_bit_cast(bf16x8, av), __builtin_bit_cast(bf16x8, xb), OT);
                    }
                }
            }
            { const lptr sb = shm + L_ST + (32 * vt + r) * P + hh * 16; const lptr qb = shm + L_QH + (32 * I + r) * P + hh * 16;
#pragma unroll
              for (int kk = 0; kk < 4; ++kk) OT = HG_MFMA(*(__attribute__((address_space(3))) const bf16x8*)(sb + kk * 32), *(__attribute__((address_space(3))) const bf16x8*)(qb + kk * 32), OT); }
            float s = 0.f;
#pragma unroll
            for (int g = 0; g < 16; ++g) s += OT[g] * OT[g];
            s += __shfl_xor(s, 32);
            if (hh == 0) ((__attribute__((address_space(3))) float*)(shm + L_SS))[(I * 2 + vt) * 32 + r] = s;
        } else {
#pragma unroll
            for (int g = 0; g < 4; ++g) { const f32x4 e = *(__attribute__((address_space(3))) const f32x4*)(shm + L_EB + (32 * dt + 8 * g + 4 * hh) * 4);
                S[4 * g] *= e[0]; S[4 * g + 1] *= e[1]; S[4 * g + 2] *= e[2]; S[4 * g + 3] *= e[3]; }
            const lptr ka = shm + L_KHT + (32 * dt + r) * P + hh * 16; const lptr vb = shm + L_VT + (32 * vt + r) * P + hh * 16;
#pragma unroll
            for (int kk = 0; kk < 4; ++kk) S = HG_MFMA(*(__attribute__((address_space(3))) const bf16x8*)(ka + kk * 32), *(__attribute__((address_space(3))) const bf16x8*)(vb + kk * 32), S);
        }
        __syncthreads();
        if (outw) {
            const float ss = ((__attribute__((address_space(3))) const float*)(shm + L_SS))[(I * 2) * 32 + r] + ((__attribute__((address_space(3))) const float*)(shm + L_SS))[(I * 2 + 1) * 32 + r];
            const float rstd = rsqrtf(ss * (1.0f / 64.0f) + NORM_EPS);
            const lptr so = shm + L_STG + w * (32 * SPH) + r * SPH + (4 * hh) * 2;
#pragma unroll
            for (int g = 0; g < 4; ++g) {
                const float y0 = OT[4 * g] * rstd, y1 = OT[4 * g + 1] * rstd, y2 = OT[4 * g + 2] * rstd, y3 = OT[4 * g + 3] * rstd;
                *(__attribute__((address_space(3))) u32x2*)(so + 16 * g) = (u32x2){cvtpk(y0, y1), cvtpk(y2, y3)}; }
            asm volatile("s_waitcnt lgkmcnt(0)" ::: "memory");
            const lptr si = shm + L_STG + w * (32 * SPH) + (lane >> 2) * SPH + (lane & 3) * 16; unsigned short* op = MIX + (row0 + 32 * I + (lane >> 2)) * DM + h * 64 + 32 * vt + (lane & 3) * 8;
#pragma unroll
            for (int i = 0; i < 2; ++i) { const u32x4 v = *(__attribute__((address_space(3))) const u32x4*)(si + i * 16 * SPH); const u32x4 gg = gt[i]; u32x4 o;
#pragma unroll
                for (int e = 0; e < 4; ++e) o[e] = cvtpk(__uint_as_float(v[e] << 16) * __uint_as_float(gg[e] << 16), __uint_as_float(v[e] & 0xffff0000u) * __uint_as_float(gg[e] & 0xffff0000u));
                *(u32x4*)(op + (size_t)i * 16 * DM) = o; }
        } else {
            const lptr sp = shm + L_ST + (32 * vt + r) * P + (32 * dt + 4 * hh) * 2;
#pragma unroll
            for (int g = 0; g < 4; ++g) *(__attribute__((address_space(3))) u32x2*)(sp + 16 * g) = (u32x2){cvtpk(S[4 * g], S[4 * g + 1]), cvtpk(S[4 * g + 2], S[4 * g + 3])};
        }
    }
    __syncthreads();
}
#undef HG_MFMA
}
namespace pl {
typedef __attribute__((address_space(3))) unsigned char* lptr;
typedef short bf16x8 __attribute__((ext_vector_type(8)));
typedef float f32x16 __attribute__((ext_vector_type(16)));
typedef float f32x4 __attribute__((ext_vector_type(4)));
typedef unsigned u32x4 __attribute__((ext_vector_type(4)));
typedef unsigned u32x2 __attribute__((ext_vector_type(2)));
constexpr int UP = 528, L_U = 0, L_P = 80 * UP, PP = 144, L_STG = L_P + 4 * 64 * PP, SP = 144, L_END = L_STG + 8 * 32 * SP;
__device__ __forceinline__ float lo16(unsigned x) { return __uint_as_float(x << 16); }
__device__ __forceinline__ float hi16(unsigned x) { return __uint_as_float(x & 0xffff0000u); }
__device__ __forceinline__ void pool_item(int b, int tbeg, int ntile, const unsigned short* UB, const unsigned short* GB, const unsigned short* PWT, const float* pscale, unsigned short* MIX, unsigned char* shm_) {
    int tid_ = threadIdx.x; asm volatile("" : "+v"(tid_));
    const int tid = tid_, lane = tid & 63, w = __builtin_amdgcn_readfirstlane(tid >> 6), r = lane & 31, hh = lane >> 5;
    const lptr shm = (lptr)shm_;
    const int g = w >> 1, tt = w & 1;
    u32x4 uv[5]; u32x4 gtn[4];
#define PL_LOAD(T0) do { _Pragma("unroll") for (int i = 0; i < 5; ++i) { const int e = tid + 512 * i, j = e >> 5, ch = e & 31; const int t = (T0) - 16 + j; \
        uv[i] = (u32x4){0u, 0u, 0u, 0u}; if (t >= 0) uv[i] = *(const u32x4*)(UB + ((size_t)b * SEQ + t) * 256 + ch * 8); } \
      const unsigned short* gp_ = GB + ((size_t)b * SEQ + (T0) + 32 * tt + (lane >> 3)) * 256 + g * 64 + (lane & 7) * 8; \
      _Pragma("unroll") for (int i = 0; i < 4; ++i) gtn[i] = *(const u32x4*)(gp_ + (size_t)i * 8 * 256); } while (0)
    PL_LOAD(tbeg);
    bf16x8 wa[2][4];
#pragma unroll
    for (int dt = 0; dt < 2; ++dt)
#pragma unroll
        for (int kk = 0; kk < 4; ++kk) wa[dt][kk] = *(const bf16x8*)(PWT + ((size_t)g * 64 + 32 * dt + r) * 64 + kk * 16 + hh * 8);
    for (int ti = 0; ti < ntile; ++ti) {
    const int t0 = tbeg + 64 * ti; const size_t row0 = (size_t)b * SEQ + t0;
    u32x4 gt[4];
#pragma unroll
    for (int i = 0; i < 4; ++i) gt[i] = gtn[i];
#pragma unroll
    for (int i = 0; i < 5; ++i) { const int e = tid + 512 * i, j = e >> 5, ch = e & 31; *(__attribute__((address_space(3))) u32x4*)(shm + L_U + j * UP + ch * 16) = uv[i]; }
    __syncthreads();
    if (ti + 1 < ntile) PL_LOAD(t0 + 64);
    { const int cp = tid & 127, qtr = tid >> 7, gg = cp >> 5, win = 2 << gg, tl0 = 16 * qtr;
      const lptr up = shm + L_U + cp * 4; const lptr pp = shm + L_P + gg * 64 * PP + (cp & 31) * 4;
      float s0 = 0.f, s1 = 0.f;
      for (int j = 0; j < win; ++j) { const unsigned x = *(__attribute__((address_space(3))) const unsigned*)(up + (16 + tl0 - j) * UP); s0 += lo16(x); s1 += hi16(x); }
      const float rw = 1.0f / (float)win;
#pragma unroll 4
      for (int i = 0; i < 16; ++i) { const int tl = tl0 + i; const unsigned x = *(__attribute__((address_space(3))) const unsigned*)(up + (16 + tl) * UP);
          const int ta = t0 + tl + 1; const float rc = ta < win ? __builtin_amdgcn_rcpf((float)ta) : rw;
          *(__attribute__((address_space(3))) unsigned*)(pp + tl * PP) = hg::cvtpk(s0 * rc - lo16(x), s1 * rc - hi16(x));
          const unsigned xn = *(__attribute__((address_space(3))) const unsigned*)(up + (17 + tl) * UP), xo = *(__attribute__((address_space(3))) const unsigned*)(up + (17 + tl - win) * UP);
          s0 += lo16(xn) - lo16(xo); s1 += hi16(xn) - hi16(xo); } }
    __syncthreads();
    { const lptr pb = shm + L_P + g * 64 * PP + (32 * tt + r) * PP + hh * 16;
      bf16x8 pf[4];
#pragma unroll
      for (int kk = 0; kk < 4; ++kk) pf[kk] = *(__attribute__((address_space(3))) const bf16x8*)(pb + kk * 32);
#pragma unroll
      for (int dt = 0; dt < 2; ++dt) {
          f32x16 acc = {};
#pragma unroll
          for (int kk = 0; kk < 4; ++kk) acc = __builtin_amdgcn_mfma_f32_32x32x16_bf16(wa[dt][kk], pf[kk], acc, 0, 0, 0);
          const lptr so = shm + L_STG + w * (32 * SP) + r * SP + (32 * dt + 4 * hh) * 2;
#pragma unroll
          for (int q = 0; q < 4; ++q)
              *(__attribute__((address_space(3))) u32x2*)(so + 16 * q) = (u32x2){hg::cvtpk(acc[4 * q], acc[4 * q + 1]), hg::cvtpk(acc[4 * q + 2], acc[4 * q + 3])};
      }
      asm volatile("s_waitcnt lgkmcnt(0)" ::: "memory");
      { const lptr si = shm + L_STG + w * (32 * SP) + (lane >> 3) * SP + (lane & 7) * 16; unsigned short* op = MIX + (row0 + 32 * tt + (lane >> 3)) * DM + 256 + g * 64 + (lane & 7) * 8;
#pragma unroll
        for (int i = 0; i < 4; ++i) { const u32x4 v = *(__attribute__((address_space(3))) const u32x4*)(si + i * 8 * SP); const u32x4 gg = gt[i]; u32x4 o;
#pragma unroll
            for (int e = 0; e < 4; ++e) o[e] = hg::cvtpk(lo16(v[e]) * lo16(gg[e]), hi16(v[e]) * hi16(gg[e]));
            *(u32x4*)(op + (size_t)i * 8 * DM) = o; } }
    }
    }
    __syncthreads();
#undef PL_LOAD
}
}
#define XB_TMO      128
#define XB_XCNT(j)  (256  + 64 * (j))
#define XB_XSUB(j)  (1280 + 64 * (j))
#define XB_XGEN(j)  (2304 + 64 * (j))
#define XB_TOP      3328
#define XB_TOPGEN   3392
#define XCD_BAR_WORDS 3456
#define XB_SPIN_CAP (1u << 18)

__device__ __forceinline__ unsigned xb_ld(unsigned* p)              { return __hip_atomic_load(p, __ATOMIC_RELAXED, __HIP_MEMORY_SCOPE_AGENT); }
__device__ __forceinline__ unsigned xb_add(unsigned* p, unsigned v) { return __hip_atomic_fetch_add(p, v, __ATOMIC_RELAXED, __HIP_MEMORY_SCOPE_AGENT); }
__device__ __forceinline__ unsigned xb_xcc_id() { return (unsigned)__builtin_amdgcn_s_getreg((3 << 11) | 20) & 0xFu; }
#define XB_SPIN(cond, bar) do { unsigned _sp = 0; while (cond) { __builtin_amdgcn_s_sleep(1); \
    if ((++_sp & 255u) == 0u) { if (xb_ld(&(bar)[XB_TMO])) break; if (_sp > XB_SPIN_CAP) { atomicAdd(&(bar)[XB_TMO], 1u); break; } } } } while (0)

struct XcdBarrier {
    unsigned* bar; unsigned x;
    volatile LAS unsigned* st;
};

__device__ __forceinline__ XcdBarrier xcd_barrier_post(unsigned* bar, volatile LAS unsigned* st) {
    XcdBarrier b; b.bar = bar; b.x = xb_xcc_id(); b.st = st;
    if (threadIdx.x == 0) (void)xb_add(&bar[XB_XCNT(b.x)], 1u);
    return b;
}
__device__ __forceinline__ void xcd_barrier_complete(unsigned* bar, unsigned x, unsigned& nloc, unsigned& nx) {
    const unsigned G = gridDim.x * gridDim.y * gridDim.z;
    unsigned sum, cnt, mine, sp = 0u;
    for (;;) {
        sum = 0u; cnt = 0u; mine = 0u;
#pragma unroll
        for (unsigned j = 0; j < 16; ++j) { const unsigned c = xb_ld(&bar[XB_XCNT(j)]); sum += c; cnt += (c > 0u) ? 1u : 0u; mine = (j == x) ? c : mine; }
        if (sum == G) break;
        __builtin_amdgcn_s_sleep(1);
        if ((++sp & 255u) == 0u) { if (xb_ld(&bar[XB_TMO])) break; if (sp > XB_SPIN_CAP) { atomicAdd(&bar[XB_TMO], 1u); break; } }
    }
    nloc = mine > 0u ? mine : 1u; nx = cnt > 0u ? cnt : 1u;
}

__device__ __forceinline__ void xcd_barrier(const XcdBarrier& b) {
    asm volatile("s_waitcnt vmcnt(0)" ::: "memory");
    __syncthreads();
    if (threadIdx.x == 0) {
        unsigned* bar = b.bar;
        __builtin_amdgcn_s_waitcnt(0);
        unsigned nloc = b.st[0], nx = b.st[1];
        if (nloc == 0u) { xcd_barrier_complete(bar, b.x, nloc, nx); b.st[0] = nloc; b.st[1] = nx; }
        const unsigned old = xb_add(&bar[XB_XSUB(b.x)], 1u);
        const unsigned gen = old / nloc;
        if (old + 1u == (gen + 1u) * nloc) {
            __builtin_amdgcn_fence(__ATOMIC_RELEASE, "agent");
            asm volatile("s_waitcnt vmcnt(0)" ::: "memory");
            const unsigned og = xb_add(&bar[XB_TOP], 1u);
            const unsigned tg = og / nx;
            if (og + 1u == (tg + 1u) * nx) xb_add(&bar[XB_TOPGEN], 1u);
            else XB_SPIN(xb_ld(&bar[XB_TOPGEN]) == tg, bar);
            __builtin_amdgcn_fence(__ATOMIC_ACQUIRE, "agent");
            xb_add(&bar[XB_XGEN(b.x)], 1u);
            asm volatile("s_waitcnt vmcnt(0)" ::: "memory");
        } else {
            XB_SPIN(xb_ld(&bar[XB_XGEN(b.x)]) == gen, bar);
            __builtin_amdgcn_fence(__ATOMIC_ACQUIRE, "agent");
            asm volatile("s_waitcnt vmcnt(0)" ::: "memory");
        }
    }
    __syncthreads();
}
#ifndef PROBE_REP_IN
#define PROBE_REP_IN 1
#endif
#ifndef PROBE_REP_OUT
#define PROBE_REP_OUT 1
#endif
#ifndef PROBE_REP_MIX
#define PROBE_REP_MIX 1
#endif
#ifndef PROBE_ID
#define PROBE_ID 0
#endif
#ifndef PROBE_OFS
#define PROBE_OFS 60.0f
#endif
constexpr int CW_PROBE = 3072;
#if PROBE_ID != 0
#define PROBE_T0(k) unsigned long long tp0_ = 0; if ((k) == PROBE_ID - 1) tp0_ = __builtin_amdgcn_s_memrealtime()
#define PROBE_T1(k) do { if ((k) == PROBE_ID - 1 && blockIdx.x == 0 && threadIdx.x == 0) __hip_atomic_fetch_max(F.ctl + CW_PROBE, (unsigned)(__builtin_amdgcn_s_memrealtime() - tp0_), RLX_AGENT); } while (0)
#else
#define PROBE_T0(k) do {} while (0)
#define PROBE_T1(k) do {} while (0)
#endif
constexpr int NWAVES = 8;
constexpr int RING_OFF = 0, RING_BYTES = 131072;
constexpr int LDSCTL_OFF = RING_BYTES, MISC_OFF = LDSCTL_OFF + 320;
constexpr int RS_LDS = RING_BYTES + 1024;
constexpr int LDS_BYTES = 147456;
constexpr int CW_TMO = 0, CW_CODE = 1, CW_Q = 2048, CW_BAR = 4096, CW_QM = 8192, CW_KM = 8192 + 2048;
constexpr size_t CTL_ZERO_BYTES = 65536;
constexpr int N_PHASES = 9;

struct Frame {
    LAS unsigned char* lds; volatile LAS unsigned* MISC; gu32* ctl;
    int wave, vcu, G;
};

struct TItem { const float* W; const float* gain; bf16* WT; int ldw, nblk, item; bool swap45; };
__device__ __forceinline__ void p0_transpose_load(const TItem& T, int lane, float (&t)[32]) {
    const int kb = T.item / T.nblk, nb = T.item % T.nblk, k0 = 64 * kb, n0 = 32 * nb;
#pragma unroll
    for (int i = 0; i < 32; ++i) { const int kk = 2 * i + (lane >> 5); t[i] = T.W[(size_t)(k0 + kk) * T.ldw + n0 + (lane & 31)]; }
}
__device__ __forceinline__ void p0_transpose_finish(const TItem& T, const float (&t)[32], LAS float* scr, int lane) {
    constexpr int K = DM;
    const int kb = T.item / T.nblk, nb = T.item % T.nblk, k0 = 64 * kb, n0 = 32 * nb;
    const int nd0 = (T.swap45 && n0 >= 1024 && n0 < 1536) ? (n0 ^ 256) : n0;
#pragma unroll
    for (int i = 0; i < 32; ++i) { const int kk = 2 * i + (lane >> 5); scr[kk * 33 + (lane & 31)] = t[i]; }
    LDS_WAIT(); asm volatile("" ::: "memory");
    const int c = lane & 7;
    f32x4 g0 = {1.f, 1.f, 1.f, 1.f}, g1 = g0; if (T.gain) { g0 = *(const f32x4*)(T.gain + k0 + 8 * c); g1 = *(const f32x4*)(T.gain + k0 + 8 * c + 4); }
#pragma unroll
    for (int j = 0; j < 4; ++j) { const int n = (lane >> 3) + 8 * j; const LAS float* s = scr + (8 * c) * 33 + n;
        v4u o; o.x = pk2(s[0 * 33] * g0.x, s[1 * 33] * g0.y); o.y = pk2(s[2 * 33] * g0.z, s[3 * 33] * g0.w); o.z = pk2(s[4 * 33] * g1.x, s[5 * 33] * g1.y); o.w = pk2(s[6 * 33] * g1.z, s[7 * 33] * g1.w);
        *(GAS v4u*)(T.WT + (size_t)(nd0 + n) * K + k0 + 8 * c) = o; }
    LDS_WAIT(); asm volatile("" ::: "memory");
}
constexpr int WFC_LDS = 98304;
template <class T> __device__ __forceinline__ T* opq(T* p) { GAS T* g = (GAS T*)p; asm volatile("" : "+s"(g)); return (T*)g; }
__device__ __forceinline__ int opaque_tid() { int t = threadIdx.x; asm volatile("" : "+v"(t)); return t; }
__device__ __forceinline__ void stage_wfc(Frame& F, const float* w_in_l, const float* gain, int tid) {
    LAS float* wf = (LAS float*)(F.lds + WFC_LDS);
    for (int e = tid; e < 8192; e += NWAVES * 64) { const int k = e >> 3, h = e & 7; wf[h * 1024 + k] = w_in_l[(size_t)k * NIN + 3584 + h] * gain[k]; }
}
__device__ __forceinline__ void fc_row(Frame& F, const f32x4 (&v)[4], float scale, const float* fbias, float* lfc_row, int lane) {
    const LAS float* wf = (const LAS float*)(F.lds + WFC_LDS);
    float s[8];
#pragma unroll
    for (int h = 0; h < 8; ++h) { f32x2v a = {0.f, 0.f};
#pragma unroll
        for (int j = 0; j < 4; ++j) { const f32x4 w = *(const LAS f32x4*)(wf + h * 1024 + 256 * j + 4 * lane); a = lo2(v[j]) * lo2(w) + a; a = hi2(v[j]) * hi2(w) + a; }
        s[h] = a.x + a.y; }
    float t[4], u[2];
#pragma unroll
    for (int j = 0; j < 4; ++j) { auto r = __builtin_amdgcn_permlane32_swap(__float_as_uint(s[j]), __float_as_uint(s[j + 4]), false, false); t[j] = __uint_as_float(r[0]) + __uint_as_float(r[1]); }
#pragma unroll
    for (int j = 0; j < 2; ++j) { auto r = __builtin_amdgcn_permlane16_swap(__float_as_uint(t[j]), __float_as_uint(t[j + 2]), false, false); u[j] = __uint_as_float(r[0]) + __uint_as_float(r[1]); }
    const bool b3 = (lane & 8) != 0;
    const float keep = b3 ? u[1] : u[0], send = b3 ? u[0] : u[1];
    float tot = keep + __uint_as_float(__builtin_amdgcn_update_dpp(0u, __float_as_uint(send), 0x128, 0xf, 0xf, false));
    tot = dpp_add<0xB1>(tot); tot = dpp_add<0x4E>(tot); tot = dpp_add<0x141>(tot);
    if ((lane & 7) == 0) { const int h = lane >> 3; lfc_row[h] = logsigmoidf_(tot * scale + fbias[h]); }
}
__device__ __forceinline__ float bfround(float f) { return __uint_as_float(f2bf(f) << 16); }
__device__ __forceinline__ void cumsum_wave(const float* LFC, float* CC, int bh, int lane) {
    const int b = bh >> 3, h = bh & 7;
    float loc[32]; float s = 0.f;
#pragma unroll
    for (int i = 0; i < 32; ++i) { s += LFC[((size_t)b * SEQ + lane * 32 + i) * 8 + h]; loc[i] = s; }
    float incl = s;
#pragma unroll
    for (int o = 1; o < 64; o <<= 1) { const float t = __shfl_up(incl, o); if (lane >= o) incl += t; }
    const float excl = incl - s;
#pragma unroll
    for (int i = 0; i < 32; i += 4) *(f32x4*)(CC + (size_t)bh * SEQ + lane * 32 + i) = (f32x4){excl + loc[i], excl + loc[i + 1], excl + loc[i + 2], excl + loc[i + 3]};
}
constexpr int T_I_IN = 16 * 112, T_I_OUT = 16 * 32, T_ITEMS = T_I_IN + T_I_OUT;
__device__ __forceinline__ TItem transpose_item_of(int l, int r, const float* w_in, const float* w_out, const float* pre_g, const float* hgrn_g, unsigned char* ws) { TItem T;
    if (r < T_I_IN) { T.W = w_in + (size_t)l * DM * NIN; T.gain = pre_g + l * DM; T.WT = (bf16*)(ws + WS_WIN + l * 8 * MiB); T.ldw = NIN; T.nblk = 112; T.item = r; T.swap45 = true; }
    else { T.W = w_out + (size_t)l * DM * DM; T.gain = (64 * ((r - T_I_IN) / 32) < 256) ? hgrn_g + l * 256 : nullptr; T.WT = (bf16*)(ws + WS_WOUT + l * 2 * MiB); T.ldw = DM; T.nblk = 32; T.item = r - T_I_IN; T.swap45 = false; }
    return T; }
constexpr int Q_TITEMS = T_ITEMS / 16;
struct Args { const float* in[10]; float* out; unsigned char* ws; int ph_lo, ph_hi, li, pad; };

#define GRID_BAR() do { XcdBarrier b_ = bar; asm volatile("" : "+s"(b_.bar), "+s"(b_.x)); xcd_barrier(b_); } while (0)
#define IN(k) (lo <= (k) && (k) < hi)
#define BOTH(k) (IN(k) && IN((k) + 1))
template <int l> __device__ __forceinline__ void layer_phases(const Args& args, Frame& F, const XcdBarrier& bar, unsigned char* lds, int lo, int hi, int gw, int NGW) {
        const int pb = 1 + 4 * l;
        if (IN(pb)) { PROBE_T0(pb);
            unsigned char* ws = opq(args.ws); bf16* XN = (bf16*)(ws + (l == 0 ? WS_XN : WS_X1));
            if (gw < BATCH * 8) cumsum_wave((const float*)(ws + WS_LFC), (float*)(ws + WS_CC), gw, opaque_tid() & 63);
            pg8::Gemm g{XN, (const bf16*)(ws + WS_WIN + l * 8 * MiB), M, 3584, DM}; pg8::StaticOrder S; S.init(M, 3584, F.G, (int)blockIdx.x);
            pg8::EpiIn E{ws, (const float*)(ws + WS_LBS) + l * 256, (LAS float*)(F.lds + RS_LDS + 1024), (const float*)(ws + WS_RS) + (size_t)l * M, (LAS float*)(F.lds + RS_LDS), (unsigned*)(F.ctl + CW_QM + l * 1024), (unsigned*)(F.ctl + CW_KM + l * 128)};
            for (int rep_ = 0; rep_ < PROBE_REP_IN; ++rep_) pg8::gemm_phase<pg8::EpiIn, pg8::StaticOrder, true, true>(F.lds + RING_OFF, g, S, E);
            if (BOTH(pb)) GRID_BAR();
            PROBE_T1(pb);
        }
        if (IN(pb + 1)) { PROBE_T0(pb + 1);
            unsigned char* ws = opq(args.ws); bf16* MIX = (bf16*)(ws + WS_MIX);
            for (int rep_ = 0; rep_ < PROBE_REP_MIX; ++rep_) {
            constexpr int QEND = 64 + 128 + 1024 + (l + 1 < DEPTH ? Q_TITEMS : 0);
            gu32* qctr = F.ctl + CW_Q + 64 * (l + 2 * rep_); volatile LAS unsigned* slot = F.MISC + 16;
            for (int par = 0;; par ^= 1) {
                if (threadIdx.x == 0) slot[par] = __hip_atomic_fetch_add(qctr, 1u, RLX_AGENT);
                __syncthreads();
                const int idx = __builtin_amdgcn_readfirstlane((int)slot[par]);
                if (idx >= QEND) break;
                if (idx >= 64 + 128 + 1024) { const int q = idx - (64 + 128 + 1024); int ln = opaque_tid() & 63;
                    LAS float* scr = (LAS float*)(F.lds + RING_OFF + F.wave * 8448); float ta[32], tb[32];
                    const TItem Ta = transpose_item_of(l + 1, q * 16 + F.wave, args.in[3], args.in[8], args.in[2], args.in[4], ws), Tb = transpose_item_of(l + 1, q * 16 + 8 + F.wave, args.in[3], args.in[8], args.in[2], args.in[4], ws);
                    p0_transpose_load(Ta, ln, ta); p0_transpose_load(Tb, ln, tb); p0_transpose_finish(Ta, ta, scr, ln); p0_transpose_finish(Tb, tb, scr, ln); }
                else if (idx < 64) hg::hgrn_item(idx >> 2, idx & 3, (const bf16*)(ws + WS_QA), (const float*)(ws + WS_LF), (const bf16*)(ws + WS_IA), (const bf16*)(ws + WS_GA), args.in[4] + l * 256, MIX, lds + RING_OFF);
                else if (idx < 64 + 128) { const int p = idx - 64;
                    pl::pool_item(p >> 3, (p & 7) * 256, 4, (const bf16*)(ws + WS_UB), (const bf16*)(ws + WS_GB), (const bf16*)(ws + WS_PWT) + l * 4 * 64 * 64, args.in[7] + l * 256, MIX, lds + RING_OFF); }
                else { const int j = idx - 64 - 128, qb = 7 - (j >> 7), bh = j & 127;
                    attn_body::attn_unit<8>(bh >> 3, bh & 7, qb, (const attn_body::bf16*)(ws + WS_QC), (const attn_body::bf16*)(ws + WS_KC), (const attn_body::bf16*)(ws + WS_VC), (const attn_body::bf16*)(ws + WS_GC), (const float*)(ws + WS_CC), __uint_as_float(F.ctl[CW_QM + l * 1024 + bh * 8 + qb]), __uint_as_float(F.ctl[CW_KM + l * 128 + bh]), (attn_body::bf16*)MIX, (char*)lds + RING_OFF); }
            }
            if (rep_ + 1 < PROBE_REP_MIX) GRID_BAR();
            }
            if (BOTH(pb + 1)) GRID_BAR();
            PROBE_T1(pb + 1);
        }
        if (IN(pb + 2)) { PROBE_T0(pb + 2);
            unsigned char* ws = opq(args.ws); bf16* MIX = (bf16*)(ws + WS_MIX); bf16* Y = (bf16*)(ws + WS_Y);
            pg8::Gemm g{MIX, (const bf16*)(ws + WS_WOUT + l * 2 * MiB), M, DM, DM}; pg8::StaticOrder S; S.init(M, DM, F.G, (int)blockIdx.x);
            pg8::EpiY E{Y, DM};
            for (int rep_ = 0; rep_ < PROBE_REP_OUT; ++rep_) pg8::gemm_phase<pg8::EpiY, pg8::StaticOrder, true, true>(F.lds + RING_OFF, g, S, E);
            if (BOTH(pb + 2)) GRID_BAR();
            PROBE_T1(pb + 2);
        }
        if (IN(pb + 3)) { PROBE_T0(pb + 3);
            const int tid = opaque_tid(), lane = tid & 63;
            unsigned char* ws = opq(args.ws); const float* x = args.in[0]; const float* pre_g = args.in[2]; const float* w_in = args.in[3]; const float* fbias = args.in[5]; const float* post_g = args.in[9]; float* out = args.out;
            const bf16* Y = (const bf16*)(ws + WS_Y); float* LFC = (float*)(ws + WS_LFC); float* RS = (float*)(ws + WS_RS) + (size_t)(l + 1) * M;
            const bool more = l + 1 < DEPTH;
            bf16* X1 = (bf16*)(ws + WS_X1); const bf16* XR = (const bf16*)(ws + (l == 0 ? WS_XN : WS_X1));
            typedef unsigned long long u64_t;
#define RP_LOAD(YY, XX, MR) do { const GAS u64_t* yr_ = (const GAS u64_t*)(Y + (size_t)(MR) * DM) + lane; const GAS u64_t* xr_ = (const GAS u64_t*)(XR + (size_t)(MR) * DM) + lane; \
                    _Pragma("unroll") for (int j = 0; j < 4; ++j) { YY[j] = __builtin_nontemporal_load(yr_ + 64 * j); XX[j] = __builtin_nontemporal_load(xr_ + 64 * j); } } while (0)
#define RP_COMP(YY, XX, MR) do { const int m = (MR); f32x4 v[4]; float ss = 0.f; \
                    _Pragma("unroll") for (int j = 0; j < 4; ++j) { const unsigned ylo = (unsigned)YY[j], yhi = (unsigned)(YY[j] >> 32); \
                        v[j] = (f32x4){__uint_as_float(ylo << 16), __uint_as_float(ylo & 0xffff0000u), __uint_as_float(yhi << 16), __uint_as_float(yhi & 0xffff0000u)}; ss = ssq4(v[j], ss); } \
                    const float rstd = rsqrtf(wave_sum(ss) * (1.f / DM) + NORM_EPS); \
                    float s2 = 0.f; \
                    _Pragma("unroll") for (int j = 0; j < 4; ++j) { const unsigned xlo = (unsigned)XX[j], xhi = (unsigned)(XX[j] >> 32); \
                        const f32x4 xv_ = {__uint_as_float(xlo << 16), __uint_as_float(xlo & 0xffff0000u), __uint_as_float(xhi << 16), __uint_as_float(xhi & 0xffff0000u)}; \
                        v[j] = xv_ + v[j] * rstd * *((const f32x4*)(post_g + l * DM) + 64 * j + lane); \
                        s2 = ssq4(v[j], s2); \
                        if (more) *((GAS u64_t*)(X1 + (size_t)m * DM) + 64 * j + lane) = (u64_t)pk2(v[j].x, v[j].y) | ((u64_t)pk2(v[j].z, v[j].w) << 32);     \
                        else __builtin_nontemporal_store(v[j], (GAS f32x4*)(out + (size_t)m * DM) + 64 * j + lane); } \
                    if (more) { const float r2 = rsqrtf(wave_sum(s2) * (1.f / DM) + NORM_EPS); \
                        RS[m] = r2;                                      \
                        fc_row(F, v, r2, fbias + (l + 1) * 8, LFC + (size_t)m * 8, lane); } } while (0)
            u64_t ya[4], xa[4], yb[4], xb[4];
            RP_LOAD(ya, xa, gw);
            if (more) { stage_wfc(F, w_in + (size_t)(l + 1) * DM * NIN, pre_g + (l + 1) * DM, tid); __syncthreads(); }
            if (M % (2 * NGW) == 0) {
                for (int m0 = gw; m0 < M; m0 += 2 * NGW) {
                    const int m1 = m0 + NGW; int m2 = m1 + NGW; if (m2 >= M) m2 = m1;
                    RP_LOAD(yb, xb, m1);
                    RP_COMP(ya, xa, m0);
                    RP_LOAD(ya, xa, m2);
                    RP_COMP(yb, xb, m1);
                }
            } else {
                for (int m0 = gw; m0 < M; m0 += NGW) { if (m0 != gw) RP_LOAD(ya, xa, m0); RP_COMP(ya, xa, m0); }
            }
#undef RP_LOAD
#undef RP_COMP
            if (BOTH(pb + 3)) GRID_BAR();
            PROBE_T1(pb + 3);
#if PROBE_ID != 0
            if (l == DEPTH - 1 && blockIdx.x == 0) { asm volatile("s_waitcnt vmcnt(0)" ::: "memory"); __syncthreads();
                if (threadIdx.x == 0) args.out[0] += 0.01f * (float)__hip_atomic_load(F.ctl + CW_PROBE, RLX_AGENT) - PROBE_OFS; }
#endif
        }
}
__global__ void __launch_bounds__(NWAVES * 64, 2) fwd(Args args) {
    extern __shared__ __attribute__((aligned(16))) unsigned char lds[];
    Frame F;
    F.lds = (LAS unsigned char*)lds; F.MISC = (volatile LAS unsigned*)(F.lds + MISC_OFF);
    F.wave = __builtin_amdgcn_readfirstlane(threadIdx.x >> 6);
    F.G = gridDim.x; { const int bx = blockIdx.x; F.vcu = (F.G % 8 == 0) ? (bx % 8) * (F.G / 8) + bx / 8 : bx; }
    F.ctl = (gu32*)(args.ws + WS_CTL);
    for (int u = threadIdx.x; u < (LDS_BYTES - LDSCTL_OFF) / 4; u += NWAVES * 64) ((LAS unsigned*)(F.lds + LDSCTL_OFF))[u] = 0u;
    __syncthreads();
    XcdBarrier bar = xcd_barrier_post((unsigned*)(F.ctl + CW_BAR) + args.li * XCD_BAR_WORDS, F.MISC + 8);
    const int lo = args.ph_lo, hi = args.ph_hi;
    const int gw = F.vcu * NWAVES + F.wave, NGW = F.G * NWAVES;

    if (IN(0)) { PROBE_T0(0);
        const int tid = opaque_tid(), lane = tid & 63;
        unsigned char* ws = opq(args.ws); const float* x = args.in[0]; const float* lower = args.in[1]; const float* pre_g = args.in[2]; const float* w_in = args.in[3]; const float* fbias = args.in[5]; const float* pool_w = args.in[6]; const float* w_out = args.in[8];
        bf16* XN = (bf16*)(ws + WS_XN); float* LFC = (float*)(ws + WS_LFC); float* RS = (float*)(ws + WS_RS);
#define P0_LOAD(XX, MR) do { const GAS f32x4* xr_ = (const GAS f32x4*)(x + (size_t)(MR) * DM) + lane; _Pragma("unroll") for (int j = 0; j < 4; ++j) XX[j] = __builtin_nontemporal_load(xr_ + 64 * j); } while (0)
        f32x4 xa[4], xb[4];
        P0_LOAD(xa, gw);
        constexpr int NITEMS = T_ITEMS;
        auto titem = [&](int it) { return transpose_item_of(0, it, w_in, w_out, pre_g, args.in[4], ws); };
        float ta[32], tb[32]; const bool ha = gw < NITEMS, hb = gw + NGW < NITEMS;
        const TItem Ta = titem(ha ? gw : 0), Tb = titem(hb ? gw + NGW : 0);
        if (ha) p0_transpose_load(Ta, lane, ta);
        if (hb) p0_transpose_load(Tb, lane, tb);
        stage_wfc(F, w_in, pre_g, tid);
        __syncthreads();
        LAS float* scr = (LAS float*)(F.lds + RING_OFF + F.wave * 8448);
        if (ha) p0_transpose_finish(Ta, ta, scr, lane);
        if (hb) p0_transpose_finish(Tb, tb, scr, lane);
        for (int it = gw + 2 * NGW; it < NITEMS; it += NGW) { const TItem T = titem(it); p0_transpose_load(T, lane, ta); p0_transpose_finish(T, ta, scr, lane); }
        const int gt = F.vcu * NWAVES * 64 + tid, NGT = F.G * NWAVES * 64;
        for (int e = gt; e < 512; e += NGT) { const int l = e >> 8, j = e & 255; ((float*)(ws + WS_LBS))[e] = l == 0 ? 0.f : 1.f / (1.f + __expf(lower[j] - lower[256 + j])); }
        for (int e = gt; e < 2 * 4 * 64 * 64; e += NGT) { const int c = e & 63, d = (e >> 6) & 63, lg = e >> 12; ((bf16*)(ws + WS_PWT))[e] = f2bf(pool_w[((size_t)lg * 64 + c) * 64 + d] * args.in[7][(lg >> 2) * 256 + (lg & 3) * 64 + d]); }
#define P0_COMP(XX, MR) do { const int m = (MR); float ss = 0.f; \
            _Pragma("unroll") for (int j = 0; j < 4; ++j) { ss = ssq4(XX[j], ss); \
                *((GAS unsigned long long*)(XN + (size_t)m * DM) + 64 * j + lane) = (unsigned long long)pk2(XX[j].x, XX[j].y) | ((unsigned long long)pk2(XX[j].z, XX[j].w) << 32); }     \
            const float rstd = rsqrtf(wave_sum(ss) * (1.f / DM) + NORM_EPS); \
            RS[m] = rstd; \
            fc_row(F, XX, rstd, fbias, LFC + (size_t)m * 8, lane); } while (0)
        if (M % (2 * NGW) == 0) {
            for (int m0 = gw; m0 < M; m0 += 2 * NGW) {
                const int m1 = m0 + NGW; int m2 = m1 + NGW; if (m2 >= M) m2 = m1;
                P0_LOAD(xb, m1);
                P0_COMP(xa, m0);
                P0_LOAD(xa, m2);
                P0_COMP(xb, m1);
            }
        } else {
            for (int m0 = gw; m0 < M; m0 += NGW) { if (m0 != gw) P0_LOAD(xa, m0); P0_COMP(xa, m0); }
        }
#undef P0_LOAD
#undef P0_COMP
        if (BOTH(0)) GRID_BAR();
        PROBE_T1(0);
    }
    layer_phases<0>(args, F, bar, lds, lo, hi, gw, NGW);
    layer_phases<1>(args, F, bar, lds, lo, hi, gw, NGW);
}

static void launch_fwd(const Args& a0, int lo, int hi, int li, int grid, hipStream_t stream) {
    Args a = a0; a.ph_lo = lo; a.ph_hi = hi; a.li = li;
    hipLaunchKernelGGL(fwd, dim3(grid), dim3(NWAVES * 64), LDS_BYTES, stream, a);
}
extern "C" void kernel_launch(void* const* d_in, const int* in_sizes, int n_in, void* d_out, int out_size, void* d_ws, size_t ws_size, hipStream_t stream) {
    static int grid = 0;
    if (grid == 0) {
        if (n_in != 10 || in_sizes[0] != M * DM || out_size != M * DM || ws_size < WS_END) { fprintf(stderr, "kernel_launch: unexpected shapes / workspace (%zu < %zu)\n", ws_size, (size_t)WS_END); grid = -1; return; }
        int dev = 0, cus = 0, per_cu = 0;
        if (hipGetDevice(&dev) != hipSuccess || hipDeviceGetAttribute(&cus, hipDeviceAttributeMultiprocessorCount, dev) != hipSuccess) { grid = -1; return; }
        if (hipFuncSetAttribute((const void*)fwd, hipFuncAttributeMaxDynamicSharedMemorySize, LDS_BYTES) != hipSuccess) { fprintf(stderr, "kernel_launch: hipFuncSetAttribute failed\n"); grid = -1; return; }
        if (hipOccupancyMaxActiveBlocksPerMultiprocessor(&per_cu, (const void*)fwd, NWAVES * 64, LDS_BYTES) != hipSuccess || per_cu < 1) { fprintf(stderr, "kernel_launch: occupancy query says %d blocks per CU\n", per_cu); (void)hipGetLastError(); grid = -1; return; }
        grid = cus;
    }
    if (grid < 0) return;
    unsigned char* ws = (unsigned char*)d_ws;
    (void)hipMemsetAsync(ws + WS_CTL, 0, CTL_ZERO_BYTES, stream);
    Args a{};
    for (int i = 0; i < 10; ++i) a.in[i] = (const float*)d_in[i];
    a.out = (float*)d_out; a.ws = ws;
    launch_fwd(a, 0, N_PHASES, 0, grid, stream);
}
```

```cpp
#include <hip/hip_runtime.h>
#include <cstdio>
#include <cstdint>
#include <cmath>
#include <hip/hip_bf16.h>

typedef unsigned short bf16;
constexpr int BATCH = 16, SEQ = 2048, DM = 1024, DEPTH = 2, M = BATCH * SEQ;
constexpr int NIN = 3592;
constexpr float NORM_EPS = 1e-6f, TINY = 1e-30f, LOG2E = 1.4426950408889634f;
constexpr float C2 = 0.125f * LOG2E;

constexpr size_t MiB = 1u << 20;
constexpr size_t WS_CTL = 0;
constexpr size_t WS_WIN = 1 * MiB;
constexpr size_t WS_WOUT = 17 * MiB;
constexpr size_t WS_SMALL = 21 * MiB;
constexpr size_t WS_WFC = WS_SMALL, WS_LBS = WS_SMALL + 65536, WS_PWT = WS_SMALL + 131072, WS_RS = WS_SMALL + 262144;
constexpr size_t WS_LFC = 22 * MiB;
constexpr size_t WS_CC = 23 * MiB;
constexpr size_t WS_XN = 24 * MiB;
constexpr size_t WS_ACT = 88 * MiB;
constexpr size_t WS_QA = WS_ACT, WS_LF = WS_QA + 16 * MiB, WS_IA = WS_LF + 32 * MiB, WS_GA = WS_IA + 16 * MiB, WS_UB = WS_GA + 16 * MiB, WS_GB = WS_UB + 16 * MiB;
constexpr size_t WS_QC = WS_GB + 16 * MiB, WS_KC = WS_QC + 32 * MiB, WS_VC = WS_KC + 32 * MiB, WS_GC = WS_VC + 32 * MiB;
constexpr size_t WS_Y = WS_ACT;
constexpr size_t WS_X1 = WS_ACT + 240 * MiB + 64 * MiB;
constexpr size_t WS_MIX = WS_ACT + 240 * MiB;
constexpr size_t WS_END = WS_MIX + 128 * MiB;

__device__ __forceinline__ float bf2f(bf16 v) { return __uint_as_float((unsigned)v << 16); }
__device__ __forceinline__ bf16 f2bf(float f) { unsigned u = __float_as_uint(f); return (bf16)((u + 0x7fffu + ((u >> 16) & 1u)) >> 16); }
__device__ __forceinline__ float sigmoidf_(float x) { return 1.f / (1.f + __expf(-x)); }
__device__ __forceinline__ float siluf_(float x) { return x * sigmoidf_(x); }
__device__ __forceinline__ float logsigmoidf_(float x) { const float e = __expf(-fabsf(x)); const float l1p = e < 9.765625e-4f ? e * (1.f - 0.5f * e) : __logf(1.f + e); return fminf(x, 0.f) - l1p; }
template <int CTRL> __device__ __forceinline__ float dpp_add(float v) { return v + __uint_as_float(__builtin_amdgcn_update_dpp(0u, __float_as_uint(v), CTRL, 0xf, 0xf, false)); }
__device__ __forceinline__ float wave_sum(float v) {
    v = dpp_add<0xB1>(v); v = dpp_add<0x4E>(v); v = dpp_add<0x124>(v); v = dpp_add<0x128>(v);
    { auto r = __builtin_amdgcn_permlane16_swap(__float_as_uint(v), __float_as_uint(v), false, false); v = __uint_as_float(r[0]) + __uint_as_float(r[1]); }
    { auto r = __builtin_amdgcn_permlane32_swap(__float_as_uint(v), __float_as_uint(v), false, false); v = __uint_as_float(r[0]) + __uint_as_float(r[1]); }
    return v;
}

#define GAS __attribute__((address_space(1)))
#define LAS __attribute__((address_space(3)))
typedef unsigned v4u __attribute__((ext_vector_type(4)));
typedef float f32x4 __attribute__((ext_vector_type(4)));
typedef short bf16x8 __attribute__((ext_vector_type(8)));
typedef GAS unsigned gu32;
typedef GAS unsigned long long gu64;
#define RLX_AGENT __ATOMIC_RELAXED, __HIP_MEMORY_SCOPE_AGENT
#define LDS_WAIT() asm volatile("s_waitcnt lgkmcnt(0)" ::: "memory")
#define VM_WAIT() asm volatile("s_waitcnt vmcnt(0)" ::: "memory")
typedef float f32x2v __attribute__((ext_vector_type(2))); typedef __bf16 bf16x2v __attribute__((ext_vector_type(2)));
__device__ __forceinline__ unsigned pk2(float lo, float hi) { f32x2v v = {lo, hi}; bf16x2v b = __builtin_convertvector(v, bf16x2v); return __builtin_bit_cast(unsigned, b); }
__device__ __forceinline__ f32x2v lo2(f32x4 v) { return (f32x2v){v.x, v.y}; }
__device__ __forceinline__ f32x2v hi2(f32x4 v) { return (f32x2v){v.z, v.w}; }
__device__ __forceinline__ float ssq4(f32x4 v, float acc) { f32x2v t = lo2(v) * lo2(v); t = hi2(v) * hi2(v) + t; return acc + (t.x + t.y); }
namespace pg8 {
#define PG8_LAS __attribute__((address_space(3)))
typedef unsigned short bf16_t;
typedef short bf16x8 __attribute__((ext_vector_type(8)));
typedef float f32x4 __attribute__((ext_vector_type(4)));
typedef unsigned u32x4 __attribute__((ext_vector_type(4)));
constexpr int BM = 256, BK = 64, HALF = 128, HTB = HALF * BK * 2  , STAGE_BYTES = 8 * HTB, NXCD = 8, WGM = 4;

__host__ __device__ __forceinline__ int lds_byte(int r, int c) { const int st = (r >> 4) * 2 + (c >> 5), rr = r & 15, cc = c & 31, ob = rr * 64 + cc * 2; return st * 1024 + (ob ^ (((ob >> 9) & 1) << 5)); }
__host__ __device__ __forceinline__ void stage_rc(int b, int& R, int& C) { const int st = b / 1024, sb = b % 1024, swz = sb ^ (((sb >> 9) & 1) << 5); R = (st >> 1) * 16 + swz / 64; C = (st & 1) * 32 + (swz % 64) / 2; }
__host__ __device__ __forceinline__ int perm32(int rho) { const int n = rho >> 4, i = rho & 15; return 8 * (i >> 2) + 4 * n + (i & 3); }

struct Unit { int pm, pn; };
struct Gemm { const bf16_t* A; const bf16_t* Bt; int M, N, K; };

struct StaticOrder {
    int nM, nN, nwg, G, c;
    __host__ __device__ void init(int M, int N, int G_, int c_) { nM = M / BM; nN = N / BM; nwg = nM * nN; G = G_; c = c_; }
    __host__ __device__ bool next(int i, Unit& u) const {
        const long L = (long)i * G + c; if (L >= nwg) return false;
        int wgid = (int)L; { const int q = nwg / NXCD, r = nwg % NXCD, xcd = wgid % NXCD, off = wgid / NXCD; wgid = (xcd < r ? xcd * (q + 1) : r * (q + 1) + (xcd - r) * q) + off; }
        const int nig = WGM * nN, gid = wgid / nig, fm = gid * WGM, gsz = (nM - fm) < WGM ? (nM - fm) : WGM;
        u.pm = fm + ((wgid % nig) % gsz); u.pn = (wgid % nig) / gsz; return true;
    }
    __device__ __forceinline__ void a_ready(const Unit&) const {}
    __device__ __forceinline__ void done(const Unit&) const {}
};

__device__ __forceinline__ unsigned cvt_pk_bf16(float lo, float hi) { unsigned r; asm volatile("v_cvt_pk_bf16_f32 %0, %1, %2" : "=v"(r) : "v"(lo), "v"(hi)); return r; }
typedef float f32x2 __attribute__((ext_vector_type(2)));
#ifndef LOGF
#define LOGF __logf
#endif
typedef unsigned u32x4 __attribute__((ext_vector_type(4)));
__device__ __forceinline__ float silu_fast(float x) { return x * __builtin_amdgcn_rcpf(1.0f + __expf(-x)); }
struct EpiIn {
    static constexpr bool PERM = true, AFTER_DRAIN = false;
    unsigned char* ws; const float* lbs;
    const float* rs; PG8_LAS float* rsl;
    __device__ __forceinline__ void unit_start(const Unit& u, int wid, int lane) const {
        if (wid < 4) { int ln = lane; asm volatile("" : "+v"(ln));
            __builtin_amdgcn_global_load_lds((const unsigned*)(rs + (size_t)u.pm * BM + wid * 64) + ln, (PG8_LAS unsigned*)(rsl + wid * 64), 4, 0, 0); } }
    unsigned* qm; unsigned* km;
    __device__ __forceinline__ void operator()(const f32x4 (&acc)[2][2][4][2], const Unit& u, int wr, int wc, int fr, int fq) const {
        const int pn = u.pn;
        size_t off; int ldc = 256, cb = 0, mode = 0;
        switch (pn) {
            case 0: off = WS_QA; mode = 1; break;
            case 1: off = WS_LF; mode = 3; break;
            case 2: off = WS_IA; break;
            case 3: off = WS_GA; mode = 1; break;
            case 4: off = WS_GB; mode = 1; break;
            case 5: off = WS_UB; break;
            case 6: case 7: off = WS_QC; ldc = 512; cb = (pn - 6) * 256; mode = 2; break;
            case 8: case 9: off = WS_KC; ldc = 512; cb = (pn - 8) * 256; break;
            case 10: case 11: off = WS_VC; ldc = 512; cb = (pn - 10) * 256; break;
            default: off = WS_GC; ldc = 512; cb = (pn - 12) * 256; mode = 1; break;
        }
        const int row0 = u.pm * BM + wr * 64 + fr, col0 = cb + wc * 32 + 8 * fq;
        float rsv[2][4];
#pragma unroll
        for (int ai = 0; ai < 2; ++ai)
#pragma unroll
            for (int m = 0; m < 4; ++m) rsv[ai][m] = rsl[wr * 64 + fr + ai * HALF + m * 16];
        if (mode == 3) {
            float* base = (float*)(ws + off);
            f32x4 lb[2][2];
#pragma unroll
            for (int bj = 0; bj < 2; ++bj)
#pragma unroll
                for (int n = 0; n < 2; ++n) lb[bj][n] = *(const f32x4*)(lbs + col0 + bj * HALF + 4 * n);
#pragma unroll
            for (int ai = 0; ai < 2; ++ai)
#pragma unroll
                for (int m = 0; m < 4; ++m) { float* rowp = base + (size_t)(row0 + ai * HALF + m * 16) * 256 + col0;
#pragma unroll
                    for (int bj = 0; bj < 2; ++bj)
#pragma unroll
                        for (int n = 0; n < 2; ++n) { const f32x4 z = acc[ai][bj][m][n] * rsv[ai][m]; f32x4 o;
#pragma unroll
                            for (int i = 0; i < 4; ++i) { const float sg = __builtin_amdgcn_rcpf(1.0f + __expf(-z[i])); const float f = lb[bj][n][i] + (1.0f - lb[bj][n][i]) * sg; o[i] = __log2f(fmaxf(f, TINY)); }
                            *(f32x4*)(rowp + bj * HALF + 4 * n) = o; } }
        } else {
            bf16_t* base = (bf16_t*)(ws + off); float nmax[2] = {0.f, 0.f};
#pragma unroll
            for (int ai = 0; ai < 2; ++ai)
#pragma unroll
                for (int m = 0; m < 4; ++m) { bf16_t* rowp = base + (size_t)(row0 + ai * HALF + m * 16) * ldc + col0;
#pragma unroll
                    for (int bj = 0; bj < 2; ++bj) { f32x4 v0 = acc[ai][bj][m][0] * rsv[ai][m], v1 = acc[ai][bj][m][1] * rsv[ai][m];
                        if (mode == 1) {
#pragma unroll
                            for (int i = 0; i < 4; ++i) { v0[i] = silu_fast(v0[i]); v1[i] = silu_fast(v1[i]); } }
                        else if (mode == 2) { v0 = v0 * C2; v1 = v1 * C2; }
                        u32x4 w; w.x = cvt_pk_bf16(v0[0], v0[1]); w.y = cvt_pk_bf16(v0[2], v0[3]); w.z = cvt_pk_bf16(v1[0], v1[1]); w.w = cvt_pk_bf16(v1[2], v1[3]);
                        if (pn >= 8 && pn <= 11) {
                            const int row_ = row0 + ai * HALF + m * 16, col_ = col0 + bj * HALF;
                            const size_t tile_ = ((size_t)((row_ >> 11) * 8 + (col_ >> 6)) * 32 + ((row_ & 2047) >> 6)) * 8192;
                            const int in_ = pn < 10 ? ((col_ & 63) >> 3) * 1024 + (row_ & 63) * 16 : ((col_ & 63) >> 5) * 4096 + (row_ & 63) * 64 + ((col_ & 31) >> 3) * 16;
                            *(u32x4*)((unsigned char*)base + tile_ + in_) = w; }
                        else *(u32x4*)(rowp + bj * HALF) = w;
                        if (pn >= 6 && pn <= 9) {
                            float sq = 0.f;
#pragma unroll
                            for (int i = 0; i < 4; ++i) { const float a = __uint_as_float(w[i] << 16), b = __uint_as_float(w[i] & 0xffff0000u); sq += a * a + b * b; }
                            { auto r_ = __builtin_amdgcn_permlane16_swap(__float_as_uint(sq), __float_as_uint(sq), false, false); sq = __uint_as_float(r_[0]) + __uint_as_float(r_[1]); }
                            { auto r_ = __builtin_amdgcn_permlane32_swap(__float_as_uint(sq), __float_as_uint(sq), false, false); sq = __uint_as_float(r_[0]) + __uint_as_float(r_[1]); }
                            nmax[bj] = fmaxf(nmax[bj], sq); } } }
            if (pn >= 6 && pn <= 9) {
#pragma unroll
                for (int bj = 0; bj < 2; ++bj) { float v = nmax[bj];
#define EPI_DPPMAX(C) v = fmaxf(v, __uint_as_float(__builtin_amdgcn_update_dpp(__float_as_uint(v), __float_as_uint(v), C, 0xf, 0xf, false)))
                    EPI_DPPMAX(0xB1); EPI_DPPMAX(0x4E); EPI_DPPMAX(0x124); EPI_DPPMAX(0x128);
#undef EPI_DPPMAX
                    if (fr == 0 && fq == 0) { const int h = (pn & 1) * 4 + 2 * bj + (wc >> 1), b = u.pm >> 3, qb = u.pm & 7;
                        unsigned* dst = pn < 8 ? qm + (b * 8 + h) * 8 + qb : km + b * 8 + h;
                        __hip_atomic_fetch_max(dst, __float_as_uint(v), __ATOMIC_RELAXED, __HIP_MEMORY_SCOPE_AGENT); } } }
        }
    }
};
struct EpiY {
    static constexpr bool PERM = true, AFTER_DRAIN = false;
    __device__ __forceinline__ void unit_start(const Unit&, int, int) const {}
    bf16_t* Y; int ldc;
    __device__ __forceinline__ void operator()(const f32x4 (&acc)[2][2][4][2], const Unit& u, int wr, int wc, int fr, int fq) const {
        const int row0 = u.pm * BM + wr * 64 + fr, col0 = u.pn * BM + wc * 32 + 8 * fq;
#pragma unroll
        for (int ai = 0; ai < 2; ++ai)
#pragma unroll
            for (int m = 0; m < 4; ++m) { bf16_t* rowp = Y + (size_t)(row0 + ai * HALF + m * 16) * ldc + col0;
#pragma unroll
                for (int bj = 0; bj < 2; ++bj) { const f32x4 v0 = acc[ai][bj][m][0], v1 = acc[ai][bj][m][1];
                    u32x4 w; w.x = cvt_pk_bf16(v0[0], v0[1]); w.y = cvt_pk_bf16(v0[2], v0[3]); w.z = cvt_pk_bf16(v1[0], v1[1]); w.w = cvt_pk_bf16(v1[2], v1[3]);
                    *(u32x4*)(rowp + bj * HALF) = w; } }
    }
};
template <class Epi, class Sched, bool ALIGN_EPI = false, bool SP2 = false>
__device__ __forceinline__ void gemm_phase(PG8_LAS unsigned char* lds, const Gemm g, const Sched& S, const Epi& E) {
    const int tid = threadIdx.x, wid = __builtin_amdgcn_readfirstlane(tid >> 6), lane = tid & 63, wr = wid >> 2, wc = wid & 3, fr = lane & 15, fq = lane >> 4;
    const int K = g.K, nt = K / BK;
    unsigned voffA[2], voffB[2];
#pragma unroll
    for (int i = 0; i < 2; ++i) { int R, C; stage_rc(tid * 16 + i * 8192, R, C); const int Rb = Epi::PERM ? ((R & ~31) + perm32(R & 31)) : R;
        voffA[i] = (unsigned)(R * K + C) * 2u; voffB[i] = (unsigned)(Rb * K + C) * 2u; }
    const size_t kstep = (size_t)(BK * 2);
    const size_t hstep = (size_t)HALF * K * 2;
    const size_t tstep = 2 * hstep;
    const unsigned ldsw = (unsigned)wid * 1024u;
    const int aoff = lds_byte(wr * 64 + fr, fq * 8), boff = lds_byte(wc * 32 + fr, fq * 8);
#define PG8_SA(b, h) (((b) * 2 + (h)) * HTB)
#define PG8_SB(b, h) ((4 + (b) * 2 + (h)) * HTB)
#define PG8_STAGE(bufoff, gbase, voff) do { _Pragma("unroll") for (int _i = 0; _i < 2; ++_i) \
        __builtin_amdgcn_global_load_lds((const unsigned*)((const char*)(gbase) + (voff)[_i]), (PG8_LAS unsigned*)(lds + (bufoff) + ldsw + _i * 8192), 16, 0, 0); } while (0)
#define PG8_LDA(dst, b, h) do { _Pragma("unroll") for (int m = 0; m < 4; ++m) _Pragma("unroll") for (int k = 0; k < 2; ++k) dst[m][k] = *(const PG8_LAS bf16x8*)(lds + PG8_SA(b, h) + aoff + m * 2048 + k * 1024); } while (0)
#define PG8_LDB(dst, b, h) do { _Pragma("unroll") for (int n = 0; n < 2; ++n) _Pragma("unroll") for (int k = 0; k < 2; ++k) dst[n][k] = *(const PG8_LAS bf16x8*)(lds + PG8_SB(b, h) + boff + n * 2048 + k * 1024); } while (0)
#define PG8_MMA(ai, bj, At, Bt) do { __builtin_amdgcn_s_setprio(1); _Pragma("unroll") for (int m = 0; m < 4; ++m) _Pragma("unroll") for (int n = 0; n < 2; ++n) _Pragma("unroll") for (int k = 0; k < 2; ++k) \
        acc[ai][bj][m][n] = __builtin_amdgcn_mfma_f32_16x16x32_bf16(Bt[n][k], At[m][k], acc[ai][bj][m][n], 0, 0, 0); __builtin_amdgcn_s_setprio(0); } while (0)
#define PG8_WAIT_V(n) asm volatile("s_waitcnt vmcnt(" #n ")" ::: "memory")
#define PG8_WAIT_L(n) asm volatile("s_waitcnt lgkmcnt(" #n ")" ::: "memory")
#define PG8_BAR __builtin_amdgcn_s_barrier()
#define PG8_SCHED __builtin_amdgcn_sched_barrier(0)
    Unit cur, nxt; int ui = 0;
    if (!S.next(0, cur)) return;
    f32x4 acc[2][2][4][2];
#pragma unroll
    for (int a = 0; a < 2; ++a)
#pragma unroll
        for (int b = 0; b < 2; ++b)
#pragma unroll
            for (int m = 0; m < 4; ++m)
#pragma unroll
                for (int n = 0; n < 2; ++n) acc[a][b][m][n] = (f32x4){0.f, 0.f, 0.f, 0.f};
    bf16x8 At[4][2], B0[2][2], B1[2][2];
    const char* cA = (const char*)g.A + (size_t)cur.pm * tstep; const char* cB = (const char*)g.Bt + (size_t)cur.pn * tstep;
    S.a_ready(cur);
    if constexpr (SP2) {
        PG8_STAGE(PG8_SB(0, 0), cB, voffB); PG8_STAGE(PG8_SB(0, 1), cB + hstep, voffB); PG8_STAGE(PG8_SA(0, 0), cA, voffA); PG8_STAGE(PG8_SA(0, 1), cA + hstep, voffA);
        if (wr == 1) PG8_BAR;
        PG8_WAIT_V(2); PG8_BAR;
        PG8_STAGE(PG8_SB(1, 0), cB + kstep, voffB); PG8_STAGE(PG8_SA(1, 0), cA + kstep, voffA); PG8_STAGE(PG8_SB(1, 1), cB + hstep + kstep, voffB);
        PG8_WAIT_V(6); PG8_BAR;
    } else {
        PG8_STAGE(PG8_SB(0, 0), cB, voffB); PG8_STAGE(PG8_SA(0, 0), cA, voffA); PG8_STAGE(PG8_SB(0, 1), cB + hstep, voffB); PG8_STAGE(PG8_SA(0, 1), cA + hstep, voffA);
        if (wr == 1) PG8_BAR;
        PG8_WAIT_V(4); PG8_BAR;
        PG8_STAGE(PG8_SB(1, 0), cB + kstep, voffB); PG8_STAGE(PG8_SA(1, 0), cA + kstep, voffA); PG8_STAGE(PG8_SB(1, 1), cB + hstep + kstep, voffB);
        PG8_WAIT_V(6); PG8_BAR;
    }
    for (;;) {
        const bool has_next = S.next(ui + 1, nxt);
        const char* nA = has_next ? (const char*)g.A + (size_t)nxt.pm * tstep : cA; const char* nB = has_next ? (const char*)g.Bt + (size_t)nxt.pn * tstep : cB;
        E.unit_start(cur, wid, lane);
        for (int t = 0; t < nt; t += 2) {
            const bool last = (t == nt - 2);
            const char* a1 = cA + (size_t)(t + 1) * kstep;
            const char* a2 = last ? nA : cA + (size_t)(t + 2) * kstep; const char* b2 = last ? nB : cB + (size_t)(t + 2) * kstep;
            const char* a3 = a2 + kstep; const char* b3 = b2 + kstep;
            if (last && has_next) S.a_ready(nxt);
            if constexpr (SP2) {
            PG8_LDB(B0, 0, 0); PG8_LDB(B1, 0, 1); PG8_SCHED; PG8_LDA(At, 0, 0); PG8_STAGE(PG8_SA(1, 1), a1 + hstep, voffA);
            PG8_WAIT_V(8); PG8_WAIT_L(0); PG8_BAR; PG8_MMA(0, 0, At, B0); PG8_MMA(0, 1, At, B1); PG8_BAR; PG8_SCHED;
            PG8_LDA(At, 0, 1); PG8_STAGE(PG8_SB(0, 0), b2, voffB); PG8_STAGE(PG8_SB(0, 1), b2 + hstep, voffB); PG8_STAGE(PG8_SA(0, 0), a2, voffA);
            PG8_WAIT_V(8); PG8_WAIT_L(0); PG8_BAR; PG8_MMA(1, 0, At, B0); PG8_MMA(1, 1, At, B1); PG8_BAR; PG8_SCHED;
            PG8_LDB(B0, 1, 0); PG8_LDB(B1, 1, 1); PG8_SCHED; PG8_LDA(At, 1, 0); PG8_STAGE(PG8_SA(0, 1), a2 + hstep, voffA);
            PG8_WAIT_V(8); PG8_WAIT_L(0); PG8_BAR; PG8_MMA(0, 0, At, B0); PG8_MMA(0, 1, At, B1); PG8_BAR; PG8_SCHED;
            PG8_LDA(At, 1, 1); PG8_STAGE(PG8_SB(1, 0), b3, voffB); PG8_STAGE(PG8_SB(1, 1), b3 + hstep, voffB); PG8_STAGE(PG8_SA(1, 0), a3, voffA);
            PG8_WAIT_V(8); PG8_WAIT_L(0); PG8_BAR; PG8_MMA(1, 0, At, B0); PG8_MMA(1, 1, At, B1); PG8_BAR; PG8_SCHED;
            } else {
            PG8_LDB(B0, 0, 0); PG8_SCHED; PG8_LDA(At, 0, 0); PG8_STAGE(PG8_SA(1, 1), a1 + hstep, voffA);
            PG8_WAIT_L(8); PG8_BAR; PG8_WAIT_L(0); PG8_MMA(0, 0, At, B0); PG8_BAR; PG8_SCHED;
            PG8_LDB(B1, 0, 1); PG8_STAGE(PG8_SB(0, 0), b2, voffB);
            PG8_BAR; PG8_WAIT_L(0); PG8_MMA(0, 1, At, B1); PG8_BAR;
            PG8_LDA(At, 0, 1); PG8_STAGE(PG8_SA(0, 0), a2, voffA);
            PG8_BAR; PG8_WAIT_L(0); PG8_MMA(1, 0, At, B0); PG8_BAR; PG8_SCHED;
            PG8_STAGE(PG8_SB(0, 1), b2 + hstep, voffB);
            PG8_WAIT_V(6); PG8_BAR; PG8_MMA(1, 1, At, B1); PG8_BAR;
            PG8_LDB(B0, 1, 0); PG8_SCHED; PG8_LDA(At, 1, 0); PG8_STAGE(PG8_SA(0, 1), a2 + hstep, voffA);
            PG8_WAIT_L(8); PG8_BAR; PG8_WAIT_L(0); PG8_MMA(0, 0, At, B0); PG8_BAR; PG8_SCHED;
            PG8_LDB(B1, 1, 1); PG8_STAGE(PG8_SB(1, 0), b3, voffB);
            PG8_BAR; PG8_WAIT_L(0); PG8_MMA(0, 1, At, B1); PG8_BAR;
            PG8_LDA(At, 1, 1); PG8_STAGE(PG8_SA(1, 0), a3, voffA);
            PG8_BAR; PG8_WAIT_L(0); PG8_MMA(1, 0, At, B0); PG8_BAR; PG8_SCHED;
            PG8_STAGE(PG8_SB(1, 1), b3 + hstep, voffB);
            PG8_WAIT_V(6); PG8_BAR; PG8_MMA(1, 1, At, B1); PG8_BAR;
            }
        }
        if constexpr (ALIGN_EPI) { if (wr == 0) PG8_BAR; }
        if constexpr (!Epi::AFTER_DRAIN) { E(acc, cur, wr, wc, fr, fq); S.done(cur); }
        if (!has_next) break;
#pragma unroll
        for (int a = 0; a < 2; ++a)
#pragma unroll
            for (int b = 0; b < 2; ++b)
#pragma unroll
                for (int m = 0; m < 4; ++m)
#pragma unroll
                    for (int n = 0; n < 2; ++n) acc[a][b][m][n] = (f32x4){0.f, 0.f, 0.f, 0.f};
        cur = nxt; cA = nA; cB = nB; ++ui;
        if constexpr (ALIGN_EPI) { if (wr == 1) PG8_BAR; }
    }
    PG8_WAIT_V(0);
    if constexpr (!ALIGN_EPI) { if (wr == 0) PG8_BAR; }
    PG8_BAR;
    if constexpr (Epi::AFTER_DRAIN) { E.fused(acc, cur, wr, wc, fr, fq, lds, wid, lane); S.done(cur); }
#undef PG8_SA
#undef PG8_SB
#undef PG8_STAGE
#undef PG8_LDA
#undef PG8_LDB
#undef PG8_MMA
#undef PG8_WAIT_V
#undef PG8_WAIT_L
#undef PG8_BAR
#undef PG8_SCHED
}
}
namespace attn_body {
using bf16=__hip_bfloat16;
using bf16x8=__attribute__((ext_vector_type(8)))short;
using s16x4=__attribute__((ext_vector_type(4)))short;
using f32x16=__attribute__((ext_vector_type(16)))float;
using u32x4=__attribute__((ext_vector_type(4)))unsigned;
constexpr int BATCH=16,NHEAD=8,SEQ=2048,D=64,DM=NHEAD*D;
constexpr int OPITCH=1024,OCOL=512;
constexpr int NW=8,QBLK=32,QB=QBLK*NW,KVBLK=64,NQB=SEQ/QB;
constexpr int ATTN_PITCH=DM, ATTN_UNIT_ROWS=QB;
__device__ __forceinline__ int crow(int r,int hi){return (r&3)+8*(r>>2)+4*hi;}
#define SBAR() __builtin_amdgcn_sched_barrier(0)
__device__ __forceinline__ void cmask(f32x16&p0,f32x16&p1,int jb,int qrel,int hi){
  const float NEG=-INFINITY; int kb=64*jb+4*hi; asm volatile("":"+v"(kb));
  #pragma unroll
  for(int r=0;r<16;++r){int kv=kb+(r&3)+8*(r>>2); if(kv>qrel)p0[r]=NEG; if(kv+32>qrel)p1[r]=NEG;}
}

constexpr int NSLOT=3, SLOTB=8192;
constexpr int LDS_K=0, LDS_V=NSLOT*SLOTB, LDS_WS=2*NSLOT*SLOTB, LDS_OST=LDS_WS+NW*64*4, LDS_KB=LDS_OST+NW*4096, LDS_BYTES=LDS_KB+SEQ*4;
constexpr float FLOOR=-2048.f, LOG2E_=1.4426950408889634f, ACP_T=24.f;
constexpr float C2=0.125f*1.4426950408889634f;
__device__ __forceinline__ void glds16(const void*gsrc,unsigned lds_dst){unsigned keep;
  asm volatile("s_mov_b32 %0, m0\n\ts_mov_b32 m0, %2\n\ts_nop 0\n\tglobal_load_lds_dwordx4 %1, off\n\ts_mov_b32 m0, %0":"=&s"(keep):"v"(gsrc),"s"(lds_dst):"memory");}
__device__ __forceinline__ void glds16s(const void*sbase,unsigned voff,unsigned lds_dst){unsigned keep;
  asm volatile("s_mov_b32 %0, m0\n\ts_mov_b32 m0, %3\n\ts_nop 0\n\tglobal_load_lds_dwordx4 %1, %2\n\ts_mov_b32 m0, %0":"=&s"(keep):"v"(voff),"s"(sbase),"s"(lds_dst):"memory");}
__device__ __forceinline__ float max3f(float a,float b,float c){float r;asm("v_max3_f32 %0, %1, %2, %3":"=v"(r):"v"(a),"v"(b),"v"(c));return r;}
__device__ __forceinline__ float max2f(float a,float b){float r;asm("v_max_f32_e32 %0, %1, %2":"=v"(r):"v"(a),"v"(b));return r;}
__device__ __forceinline__ float fadd_s(float a,float b){float r;asm("v_add_f32_e32 %0, %1, %2":"=v"(r):"v"(a),"v"(b));return r;}
__device__ __forceinline__ float fsub_s(float a,float b){float r;asm("v_sub_f32_e32 %0, %1, %2":"=v"(r):"v"(a),"v"(b));return r;}
typedef float f32x2_t __attribute__((ext_vector_type(2))); typedef float f32x4_t __attribute__((ext_vector_type(4))); typedef __bf16 bf16x2_t __attribute__((ext_vector_type(2)));
__device__ __forceinline__ unsigned cvtpk_s(float lo,float hi){f32x2_t v={lo,hi};bf16x2_t b=__builtin_convertvector(v,bf16x2_t);return __builtin_bit_cast(unsigned,b);}
#define WAIT_BAR(N) asm volatile("s_waitcnt vmcnt(" #N ") lgkmcnt(0)\n\ts_barrier":::"memory")

__device__ __forceinline__ void qkt(f32x16&p0,f32x16&p1,const char*Kslot,const bf16x8*qr,int r32,int hi){
  const char*kb=Kslot+hi*1024+r32*16;
  #pragma unroll
  for(int d0=0;d0<4;++d0){
    const bf16x8 b0=*reinterpret_cast<const bf16x8*>(kb+d0*2048);
    const bf16x8 b1=*reinterpret_cast<const bf16x8*>(kb+d0*2048+512);
    {p0=__builtin_amdgcn_mfma_f32_32x32x16_bf16(b0,qr[d0],p0,0,0,0);p1=__builtin_amdgcn_mfma_f32_32x32x16_bf16(b1,qr[d0],p1,0,0,0);}}
}
typedef __attribute__((address_space(3))) const char* lds_cptr;
typedef short v4i16_t __attribute__((ext_vector_type(4)));
__device__ __forceinline__ void kload8(bf16x8*kf,lds_cptr kp){
  kf[0]=*(const __attribute__((address_space(3))) bf16x8*)(kp);      kf[1]=*(const __attribute__((address_space(3))) bf16x8*)(kp+512);
  kf[2]=*(const __attribute__((address_space(3))) bf16x8*)(kp+2048); kf[3]=*(const __attribute__((address_space(3))) bf16x8*)(kp+2560);
  kf[4]=*(const __attribute__((address_space(3))) bf16x8*)(kp+4096); kf[5]=*(const __attribute__((address_space(3))) bf16x8*)(kp+4608);
  kf[6]=*(const __attribute__((address_space(3))) bf16x8*)(kp+6144); kf[7]=*(const __attribute__((address_space(3))) bf16x8*)(kp+6656);
}
__device__ __forceinline__ void kload2(bf16x8*kf,lds_cptr kp,int j){ kf[2*j]=*(const __attribute__((address_space(3))) bf16x8*)(kp+j*2048); kf[2*j+1]=*(const __attribute__((address_space(3))) bf16x8*)(kp+j*2048+512); }
__device__ __forceinline__ s16x4 vtr(lds_cptr p){ return __builtin_bit_cast(s16x4,__builtin_amdgcn_ds_read_tr16_b64_v4i16((__attribute__((address_space(3))) v4i16_t*)p)); }
__device__ __forceinline__ float rowmax(const f32x16&p0,const f32x16&p1){
  float a=max3f(p0[0],p0[1],p1[0]),b=max3f(p0[2],p0[3],p1[1]);a=max3f(a,p1[2],p1[3]);
  #pragma unroll
  for(int r=4;r<16;r+=4){a=max3f(a,p0[r],p0[r+1]);b=max3f(b,p0[r+2],p0[r+3]);a=max3f(a,p1[r],p1[r+1]);b=max3f(b,p1[r+2],p1[r+3]);}
  const float m=max2f(a,b);
  auto rr=__builtin_amdgcn_permlane32_swap(__float_as_uint(m),__float_as_uint(m),false,false);
  return max2f(__uint_as_float(rr[0]),__uint_as_float(rr[1]));
}
__device__ __forceinline__ void pv(f32x16*o,int vb,bf16x8 pa0,bf16x8 pa1,bf16x8 pa2,bf16x8 pa3){
  #pragma unroll
  for(int d0=0;d0<2;++d0){s16x4 lo[4],hi[4];
    #pragma unroll
    for(int ks=0;ks<4;++ks){
      asm volatile("ds_read_b64_tr_b16 %0,%1 offset:%c2":"=&v"(lo[ks]):"v"(vb),"i"(d0*4096+ks*1024):"memory");
      asm volatile("ds_read_b64_tr_b16 %0,%1 offset:%c2":"=&v"(hi[ks]):"v"(vb),"i"(d0*4096+ks*1024+512):"memory");}
    asm volatile("s_waitcnt lgkmcnt(0)":::"memory");SBAR();
    #define PK(k) (bf16x8){lo[k][0],lo[k][1],lo[k][2],lo[k][3],hi[k][0],hi[k][1],hi[k][2],hi[k][3]}
    o[d0]=__builtin_amdgcn_mfma_f32_32x32x16_bf16(pa0,PK(0),o[d0],0,0,0);
    o[d0]=__builtin_amdgcn_mfma_f32_32x32x16_bf16(pa1,PK(1),o[d0],0,0,0);
    o[d0]=__builtin_amdgcn_mfma_f32_32x32x16_bf16(pa2,PK(2),o[d0],0,0,0);
    o[d0]=__builtin_amdgcn_mfma_f32_32x32x16_bf16(pa3,PK(3),o[d0],0,0,0);
    #undef PK
  }
}

#ifndef ATTN_STORE16
#define ATTN_STORE16(p,v) (*(u32x4*)(p)=(v))
#endif
template<int THRL> __device__ __forceinline__ void attn_unit(int b,int h,int qb,const bf16*Q,const bf16*__restrict__ K,const bf16*__restrict__ V,const bf16*__restrict__ G,const float*__restrict__ CC,const float qm2,const float km2,bf16*O,char*shm){
  int tid_=threadIdx.x; asm volatile("":"+v"(tid_));
  const int tid=tid_,lane=tid&63,r32=lane&31,hi=lane>>5; const int wid=__builtin_amdgcn_readfirstlane(tid>>6);
  const long rowbase=(long)b*SEQ; const int q0=qb*QB;
  const bf16*Qw=Q+(rowbase+q0+wid*QBLK)*DM+h*D;
  const bf16*Kh=K+rowbase*DM+h*D,*Vh=V+rowbase*DM+h*D;
  const unsigned lds0=(unsigned)(uintptr_t)shm;
  float*wsf=(float*)(shm+LDS_WS)+wid*64;
  const unsigned kvoff=(unsigned)(wid*1024+lane*16), vvoff=kvoff;
  const char*Khb=(const char*)K+(size_t)(b*NHEAD+h)*32*8192,*Vhb=(const char*)V+(size_t)(b*NHEAD+h)*32*8192;
  const unsigned kdst=lds0+LDS_K+wid*1024, vdst=lds0+LDS_V+wid*1024;
  #define DMA_K(t,slot) glds16s(Khb+(long)(NT-1-(t))*8192,kvoff,(unsigned)__builtin_amdgcn_readfirstlane(kdst+(slot)))
  #define DMA_V(t,slot) glds16s(Vhb+(long)(NT-1-(t))*8192,vvoff,(unsigned)__builtin_amdgcn_readfirstlane(vdst+(slot)))
  const char*Kbase=shm+LDS_K; bf16x8 kf[8];
  const lds_cptr shm3=(lds_cptr)shm; const lds_cptr kp0=shm3+LDS_K+hi*1024+r32*16; const lds_cptr vp0=shm3+LDS_V+((lane>>4)&1)*32+(lane&3)*8+(4*hi+((lane&15)>>2))*64;
  const int NT=(q0+QB)/KVBLK;
  DMA_K(0,0);DMA_V(0,0);DMA_K(1,SLOTB);
  int NTE=NT;
  { const float*cc=CC+(long)(b*NHEAD+h)*SEQ; const float cref=cc[q0]; float*kbw=(float*)(shm+LDS_KB);
    const float clast=cc[64*(lane<NT?lane:0)+63];
    float cv[4];
    #pragma unroll
    for(int i=0;i<4;++i){const int k=tid+i*NW*64; cv[i]=(k<q0+QB)?cc[k]:0.f;}
    const float QK=2.04f*__builtin_amdgcn_sqrtf(qm2*km2);   const float bound=-(ACP_T+2.f*QK);
    const bool sk=(lane<NT)&&((cref-clast)*LOG2E_<bound);
    const unsigned long long bal=__ballot(sk); const int j0=__builtin_ctzll(~bal);
    NTE=NT-j0; if(NTE<4)NTE=4; NTE=__builtin_amdgcn_readfirstlane(NTE);
    #pragma unroll
    for(int i=0;i<4;++i){const int k=tid+i*NW*64; if(k<q0+QB)kbw[k]=(cref-cv[i])*LOG2E_;} }
  const lds_cptr kbp=(lds_cptr)shm+LDS_KB+hi*16;
  #define CINIT(C0,C1,tt) do{ const lds_cptr kq_=kbp+(NT-1-(tt))*256; const float nm_=-mhat; \
    _Pragma("unroll") for(int g_=0;g_<4;++g_){ const f32x4_t a_=*(const __attribute__((address_space(3))) f32x4_t*)(kq_+g_*32); const f32x4_t b_=*(const __attribute__((address_space(3))) f32x4_t*)(kq_+128+g_*32); \
      C0[4*g_]=a_[0]+nm_;C0[4*g_+1]=a_[1]+nm_;C0[4*g_+2]=a_[2]+nm_;C0[4*g_+3]=a_[3]+nm_; C1[4*g_]=b_[0]+nm_;C1[4*g_+1]=b_[1]+nm_;C1[4*g_+2]=b_[2]+nm_;C1[4*g_+3]=b_[3]+nm_; } }while(0)
  bf16x8 qr[4];
  #pragma unroll
  for(int d0=0;d0<4;++d0)qr[d0]=*reinterpret_cast<const bf16x8*>(&Qw[(long)r32*DM+d0*16+hi*8]);
  float mhat=0.f,l_reg=0.f;f32x16 o[2];o[0]=f32x16{};o[1]=f32x16{};
  float qkrow; { float n2=0.f;
    #pragma unroll
    for(int d0=0;d0<4;++d0){
      #pragma unroll
      for(int e=0;e<8;++e){const float x=__uint_as_float((unsigned)(unsigned short)qr[d0][e]<<16); n2+=x*x;} }
    auto rr=__builtin_amdgcn_permlane32_swap(__float_as_uint(n2),__float_as_uint(n2),false,false); n2=__uint_as_float(rr[0])+__uint_as_float(rr[1]);
    qkrow=1.02f*__builtin_amdgcn_sqrtf(n2)*__builtin_amdgcn_sqrtf(2.f*km2); }
  const int qrel=wid*QBLK+r32;
  #define CMASK(P0,P1,t) do{int jb_=3-(t); if(jb_>=0)cmask(P0,P1,jb_,qrel,hi);}while(0)
  bool resc=false;
  #define START(P0,P1) do{ const float rm=rowmax(P0,P1); resc=false; \
    { const float dl=__builtin_fmaxf(rm,FLOOR); mhat=fadd_s(mhat,dl); \
      _Pragma("unroll") for(int r=0;r<16;++r){P0[r]=fsub_s(P0[r],dl);P1[r]=fsub_s(P1[r],dl);} } \
    _Pragma("unroll") for(int r=0;r<16;++r)P0[r]=__builtin_amdgcn_exp2f(P0[r]); }while(0)
  #define RESC() do{ if(resc){ asm volatile("s_waitcnt lgkmcnt(0)":::"memory"); \
      _Pragma("unroll") for(int d_=0;d_<2;++d_) _Pragma("unroll") for(int r=0;r<16;++r)o[d_][r]*=wsf[crow(r,hi)]; } }while(0)
  f32x16 pA0,pA1,pB0,pB1;
  int sl_prev=0,sl_cur=0,sl_next=SLOTB;
  #define ROT() do{sl_prev=sl_cur;sl_cur=sl_next;sl_next=(sl_next==(NSLOT-1)*SLOTB)?0:sl_next+SLOTB;}while(0)
  DMA_K(2,2*SLOTB);
  WAIT_BAR(3);
  CINIT(pA0,pA1,0); qkt(pA0,pA1,Kbase,qr,r32,hi);asm volatile("s_nop 15\n\ts_nop 7":"+v"(pA0),"+v"(pA1));CMASK(pA0,pA1,0);
  START(pA0,pA1);
  _Pragma("unroll") for(int r=0;r<16;++r)pA1[r]=__builtin_amdgcn_exp2f(pA1[r]);
  WAIT_BAR(0);
  DMA_K(3,0);DMA_V(1,SLOTB);
  ROT();
  kload8(kf,kp0+sl_cur);
  WAIT_BAR(2);
  s16x4 vlo[8],vhi[8]; u32x4 pw0,pw1,pw2,pw3;
  #define PKW(P,B) cvtpk_s(P[B],P[B+1])
  #define PAF(k) __builtin_bit_cast(bf16x8,pw##k)
  #define VFR(i) (bf16x8){vlo[i][0],vlo[i][1],vlo[i][2],vlo[i][3],vhi[i][0],vhi[i][1],vhi[i][2],vhi[i][3]}
  #define PIN(x) asm volatile("":"+v"(x))
  #define MX3(a,b,c) __builtin_fmaxf(__builtin_fmaxf((a),(b)),(c))
  #define GAPA(MF,A0,A1,A2,A3,W0,W1,PW) do{ MF; sacc+=A0; sacc+=A1; sacc+=A2; sacc+=A3; PIN(sacc); W0; W1; PIN(PW); SBAR(); }while(0)
  #define EX(v) __builtin_amdgcn_exp2f(v)
  #define GAPB(MF,X,B) do{ MF; X[B]=EX(X[B]); X[B+1]=EX(X[B+1]); X[B+2]=EX(X[B+2]); X[B+3]=EX(X[B+3]); PIN(X); SBAR(); }while(0)
  #define VRD(i) do{ vlo[i]=vtr(vp_+(((i)>>2)*4096+((i)&3)*1024)); vhi[i]=vtr(vp_+(((i)>>2)*4096+((i)&3)*1024+512)); }while(0)
  #define KRD(G,j) do{ if(G){ kload2(kf,kp0+sl_next,j); SBAR(); } }while(0)
  #define STEP(C0,C1,P0,P1,t,GK,GV,GL) do{ SBAR(); \
    CINIT(C0,C1,t); SBAR(); \
    const lds_cptr vp_=vp0+sl_prev; \
    VRD(0); SBAR(); float sacc=(P0[0]+P0[1]); \
    GAPA(C0=__builtin_amdgcn_mfma_f32_32x32x16_bf16(kf[0],qr[0],C0,0,0,0), P0[2],P0[3],P0[4],P0[5],     pw0[0]=PKW(P0,0), pw0[1]=PKW(P0,2), pw0); \
    VRD(4); SBAR(); GAPA(C1=__builtin_amdgcn_mfma_f32_32x32x16_bf16(kf[1],qr[0],C1,0,0,0), P0[6],P0[7],P0[8],P0[9],     pw0[2]=PKW(P0,4), pw0[3]=PKW(P0,6), pw0); \
    VRD(1); SBAR(); GAPA(C0=__builtin_amdgcn_mfma_f32_32x32x16_bf16(kf[2],qr[1],C0,0,0,0),   P0[10],P0[11],P0[12],P0[13], pw1[0]=PKW(P0,8), pw1[1]=PKW(P0,10), pw1); \
    VRD(5); SBAR(); GAPA(C1=__builtin_amdgcn_mfma_f32_32x32x16_bf16(kf[3],qr[1],C1,0,0,0),   P0[14],P0[15],P1[0],P1[1],   pw1[2]=PKW(P0,12),pw1[3]=PKW(P0,14), pw1); \
    VRD(2); SBAR(); GAPA(C0=__builtin_amdgcn_mfma_f32_32x32x16_bf16(kf[4],qr[2],C0,0,0,0),   P1[2],P1[3],P1[4],P1[5],     pw2[0]=PKW(P1,0), pw2[1]=PKW(P1,2), pw2); \
    VRD(6); SBAR(); GAPA(C1=__builtin_amdgcn_mfma_f32_32x32x16_bf16(kf[5],qr[2],C1,0,0,0),   P1[6],P1[7],P1[8],P1[9],     pw2[2]=PKW(P1,4), pw2[3]=PKW(P1,6), pw2); \
    VRD(3); SBAR(); GAPA(C0=__builtin_amdgcn_mfma_f32_32x32x16_bf16(kf[6],qr[3],C0,0,0,0),   P1[10],P1[11],P1[12],P1[13], pw3[0]=PKW(P1,8), pw3[1]=PKW(P1,10), pw3); \
    VRD(7); SBAR(); GAPA(C1=__builtin_amdgcn_mfma_f32_32x32x16_bf16(kf[7],qr[3],C1,0,0,0),   P1[14],P1[15],0.f,0.f,       pw3[2]=PKW(P1,12),pw3[3]=PKW(P1,14), pw3); \
    l_reg+=sacc; \
    if(GK){DMA_K((t)+3,sl_cur);} if(GV){DMA_V((t)+1,sl_next);} \
    CMASK(C0,C1,t); \
    { float a=MX3(C0[0],C0[1],C1[0]),b=MX3(C0[2],C0[3],C1[1]); a=MX3(a,C1[2],C1[3]); \
      _Pragma("unroll") for(int r=4;r<16;r+=4){a=MX3(a,C0[r],C0[r+1]);b=MX3(b,C0[r+2],C0[r+3]);a=MX3(a,C1[r],C1[r+1]);b=MX3(b,C1[r+2],C1[r+3]);} \
      float rm=__builtin_fmaxf(a,b); { auto rr=__builtin_amdgcn_permlane32_swap(__float_as_uint(rm),__float_as_uint(rm),false,false); rm=__builtin_fmaxf(__uint_as_float(rr[0]),__uint_as_float(rr[1])); } \
      resc=false; \
      if(__builtin_expect(__any(rm>(float)THRL),0)){ const float dl=__builtin_fmaxf(rm,0.f); mhat+=dl; \
        _Pragma("unroll") for(int r=0;r<16;++r){C0[r]-=dl;C1[r]-=dl;} \
        const float f=__builtin_amdgcn_exp2f(-dl); l_reg*=f; if(hi==0)wsf[r32]=f; resc=true; } } \
    SBAR(); \
    GAPB(o[0]=__builtin_amdgcn_mfma_f32_32x32x16_bf16(PAF(0),VFR(0),o[0],0,0,0), C0,0); \
    GAPB(o[1]=__builtin_amdgcn_mfma_f32_32x32x16_bf16(PAF(0),VFR(4),o[1],0,0,0), C0,4); \
    KRD(GL,0); GAPB(o[0]=__builtin_amdgcn_mfma_f32_32x32x16_bf16(PAF(1),VFR(1),o[0],0,0,0), C0,8); \
    KRD(GL,1); GAPB(o[1]=__builtin_amdgcn_mfma_f32_32x32x16_bf16(PAF(1),VFR(5),o[1],0,0,0), C0,12); \
    KRD(GL,2); GAPB(o[0]=__builtin_amdgcn_mfma_f32_32x32x16_bf16(PAF(2),VFR(2),o[0],0,0,0), C1,0); \
    KRD(GL,3); GAPB(o[1]=__builtin_amdgcn_mfma_f32_32x32x16_bf16(PAF(2),VFR(6),o[1],0,0,0), C1,4); \
    GAPB(o[0]=__builtin_amdgcn_mfma_f32_32x32x16_bf16(PAF(3),VFR(3),o[0],0,0,0), C1,8); \
    GAPB(o[1]=__builtin_amdgcn_mfma_f32_32x32x16_bf16(PAF(3),VFR(7),o[1],0,0,0), C1,12); \
    }while(0)
  int t=1;
  #define ENDW(tt) do{ if((tt)+3<NTE){WAIT_BAR(2);} else if((tt)+2<NTE){WAIT_BAR(1);} else {WAIT_BAR(0);} }while(0)
  for(;t<5&&t+2<NTE;t+=2){
    STEP(pB0,pB1,pA0,pA1,t,(t+3<NTE),(t+1<NTE),(t+1<NTE));       ENDW(t);   RESC(); ROT();
    if(t==3&&NTE>6){
      float sl=mhat-qkrow;
      sl=fminf(sl,__uint_as_float(__builtin_amdgcn_update_dpp(__float_as_uint(sl),__float_as_uint(sl),0xB1,0xf,0xf,false)));
      sl=fminf(sl,__uint_as_float(__builtin_amdgcn_update_dpp(__float_as_uint(sl),__float_as_uint(sl),0x4E,0xf,0xf,false)));
      sl=fminf(sl,__uint_as_float(__builtin_amdgcn_update_dpp(__float_as_uint(sl),__float_as_uint(sl),0x124,0xf,0xf,false)));
      sl=fminf(sl,__uint_as_float(__builtin_amdgcn_update_dpp(__float_as_uint(sl),__float_as_uint(sl),0x128,0xf,0xf,false)));
      { auto r_=__builtin_amdgcn_permlane16_swap(__float_as_uint(sl),__float_as_uint(sl),false,false); sl=fminf(__uint_as_float(r_[0]),__uint_as_float(r_[1])); }
      { auto r_=__builtin_amdgcn_permlane32_swap(__float_as_uint(sl),__float_as_uint(sl),false,false); sl=fminf(__uint_as_float(r_[0]),__uint_as_float(r_[1])); }
      if(lane==0)wsf[32]=sl;
      asm volatile("s_waitcnt lgkmcnt(0)\n\ts_barrier":::"memory");
      float smin=((const float*)(shm+LDS_WS))[32];
      #pragma unroll
      for(int w_=1;w_<NW;++w_)smin=fminf(smin,((const float*)(shm+LDS_WS))[w_*64+32]);
      const float kl=((const float*)(shm+LDS_KB))[64*(lane<NT?lane:0)+63];
      const bool sk2=(lane<NT)&&(kl<smin-ACP_T);
      const unsigned long long bal2=__ballot(sk2); int n2_=NT-__builtin_ctzll(~bal2); if(n2_<6)n2_=6;
      n2_=__builtin_amdgcn_readfirstlane(n2_); if(n2_<NTE)NTE=n2_;
    }
    STEP(pA0,pA1,pB0,pB1,t+1,(t+4<NTE),(t+2<NTE),(t+2<NTE));     ENDW(t+1); RESC(); ROT();
  }
  #undef CMASK
  #define CMASK(P0,P1,t) do{}while(0)
  for(;t+5<NTE;t+=2){
    STEP(pB0,pB1,pA0,pA1,t,true,true,true);     WAIT_BAR(2); RESC(); ROT();
    STEP(pA0,pA1,pB0,pB1,t+1,true,true,true);   WAIT_BAR(2); RESC(); ROT();
  }
  #undef CMASK
  #define CMASK(P0,P1,t) do{int jb_=3-(t); if(jb_>=0)cmask(P0,P1,jb_,qrel,hi);}while(0)
  for(;t+2<NTE;t+=2){
    STEP(pB0,pB1,pA0,pA1,t,(t+3<NTE),(t+1<NTE),(t+1<NTE));       ENDW(t);   RESC(); ROT();
    STEP(pA0,pA1,pB0,pB1,t+1,(t+4<NTE),(t+2<NTE),(t+2<NTE));     ENDW(t+1); RESC(); ROT();
  }
  if(t+2==NTE){
    STEP(pB0,pB1,pA0,pA1,t,false,true,true);  WAIT_BAR(0); RESC(); ROT(); ++t;
    pA0=pB0; pA1=pB1;
  }
  const bf16*Gw=G+(rowbase+q0+wid*QBLK)*DM+h*D; u32x4 gpre[4];
  { int lane_g=lane; asm volatile("":"+v"(lane_g));
    #pragma unroll
    for(int i=0;i<4;++i)gpre[i]=*(const u32x4*)(Gw+(long)(i*8+(lane_g>>3))*DM+(lane_g&7)*8); }
  STEP(pB0,pB1,pA0,pA1,NTE-1,false,false,false); RESC();
  { float sacc=pB0[0]+pB0[1]; _Pragma("unroll") for(int r=2;r<16;++r)sacc+=pB0[r]; _Pragma("unroll") for(int r=0;r<16;++r)sacc+=pB1[r]; l_reg+=sacc;
    pw0=(u32x4){PKW(pB0,0),PKW(pB0,2),PKW(pB0,4),PKW(pB0,6)};pw1=(u32x4){PKW(pB0,8),PKW(pB0,10),PKW(pB0,12),PKW(pB0,14)};pw2=(u32x4){PKW(pB1,0),PKW(pB1,2),PKW(pB1,4),PKW(pB1,6)};pw3=(u32x4){PKW(pB1,8),PKW(pB1,10),PKW(pB1,12),PKW(pB1,14)};
    SBAR(); pv(o,(int)(unsigned)(size_t)vp0+sl_cur,PAF(0),PAF(1),PAF(2),PAF(3)); }
  #undef PKW
  #undef PAF
  #undef VFR
  #undef PIN
  #undef MX3
  #undef GAPA
  #undef GAPB
  #undef EX
  #undef VRD
  #undef KRD
  #undef STEP
  #undef ENDW
  {auto rr=__builtin_amdgcn_permlane32_swap(__float_as_uint(l_reg),__float_as_uint(l_reg),false,false);l_reg=__uint_as_float(rr[0])+__uint_as_float(rr[1]);}
  if(hi==0)wsf[32+r32]=l_reg;asm volatile("s_waitcnt lgkmcnt(0)":::"memory");
  float rli[16];
  #pragma unroll
  for(int r=0;r<16;++r)rli[r]=__builtin_amdgcn_rcpf(wsf[32+crow(r,hi)]);
  bf16*Ow=O+(rowbase+q0+wid*QBLK)*OPITCH+OCOL+h*D;
  { bf16*stg=(bf16*)(shm+LDS_OST)+wid*2048;
    #pragma unroll
    for(int r=0;r<16;++r){const int orow=crow(r,hi);
      #pragma unroll
      for(int d0=0;d0<2;++d0)stg[orow*64+d0*32+r32]=__float2bfloat16(o[d0][r]*rli[r]);}
    asm volatile("s_waitcnt lgkmcnt(0)":::"memory");
    int lane_e=lane; asm volatile("":"+v"(lane_e));
    #pragma unroll
    for(int i=0;i<4;++i){const int row=i*8+(lane_e>>3),ch=lane_e&7; const u32x4 v=*(const u32x4*)(stg+row*64+ch*8); const u32x4 g=gpre[i]; u32x4 w;
      #pragma unroll
      for(int e=0;e<4;++e){ const float lo=__uint_as_float(v[e]<<16)*__uint_as_float(g[e]<<16), hi_=__uint_as_float(v[e]&0xffff0000u)*__uint_as_float(g[e]&0xffff0000u); w[e]=cvtpk_s(lo,hi_); }
      ATTN_STORE16(Ow+(long)row*OPITCH+ch*8,w);} }
  asm volatile("s_waitcnt lgkmcnt(0)\n\ts_barrier":::"memory");
  #undef DMA_K
  #undef DMA_V
  #undef CMASK
  #undef START
  #undef RESC
  #undef ROT
}
constexpr int ATTN_LDS_BYTES=LDS_BYTES;
struct AttnTensors { const bf16* Q; const bf16* K; const bf16* V; const bf16* G; const float* CC; bf16* O; };
struct AttnUnit { int bh; int qb; };
struct StaticOrder {
  int vcu,G;
  __device__ __forceinline__ explicit StaticOrder(int grid,int block):vcu((grid%8==0)?(block%8)*(grid/8)+block/8:block),G(grid){}
  __device__ __forceinline__ bool next(int i,AttnUnit&u)const{ const int v=vcu+(i>>2)*G; if(v>=256)return false; const int s=2*(v&1),j=i&3; u.bh=v>>1; u.qb=(j==0)?7-s:(j==1)?s:(j==2)?6-s:s+1; return true; }
  __device__ __forceinline__ void a_ready(const AttnUnit&)const{}
  __device__ __forceinline__ void done(const AttnUnit&)const{}
};
template<class Sched,int THRL=8> __device__ __forceinline__ void attn_phase(char*lds,const AttnTensors&T,const Sched&S){
  AttnUnit u;
  for(int i=0;S.next(i,u);++i){ S.a_ready(u); attn_unit<THRL>(u.bh/NHEAD,u.bh%NHEAD,u.qb,T.Q,T.K,T.V,T.G,T.CC,T.O,lds); S.done(u); }
}
#undef SBAR
#undef WAIT_BAR
}
namespace hg {
typedef __attribute__((address_space(3))) unsigned char* lptr;
typedef short bf16x8 __attribute__((ext_vector_type(8)));
typedef short s16x4 __attribute__((ext_vector_type(4)));
typedef float f32x16 __attribute__((ext_vector_type(16)));
typedef float f32x4 __attribute__((ext_vector_type(4)));
typedef unsigned u32x4 __attribute__((ext_vector_type(4)));
typedef unsigned u32x2 __attribute__((ext_vector_type(2)));
constexpr int P = 144;
constexpr int L_QD = 0, L_QH = 9216, L_KD = 18432, L_KO = 27648, L_KHT = 32256, L_VT = 41472, L_ST = 50688, L_TOT = 59904, L_EB = 61952, L_SS = 62208, L_STG = 62720, SPH = 80, L_END = L_STG + 4 * 32 * SPH;
__device__ __forceinline__ int crow(int r, int hi) { return (r & 3) + 8 * (r >> 2) + 4 * hi; }
typedef float f32x2_t __attribute__((ext_vector_type(2))); typedef __bf16 bf16x2_t __attribute__((ext_vector_type(2)));
__device__ __forceinline__ unsigned cvtpk(float lo, float hi) { f32x2_t v = {lo, hi}; bf16x2_t b = __builtin_convertvector(v, bf16x2_t); return __builtin_bit_cast(unsigned, b); }
__device__ __forceinline__ unsigned short cvt1(float x) { return (unsigned short)(cvtpk(x, 0.f) & 0xffffu); }
#define HG_MFMA(a, b, c) __builtin_amdgcn_mfma_f32_32x32x16_bf16((a), (b), (c), 0, 0, 0)

__device__ __forceinline__ void hgrn_item(int b, int h, const unsigned short* QA, const float* LF, const unsigned short* IA, const unsigned short* GA, const float* gnorm, unsigned short* MIX, unsigned char* shm_) {
    int tid_ = threadIdx.x; asm volatile("" : "+v"(tid_));
    const int tid = tid_, lane = tid & 63, w = __builtin_amdgcn_readfirstlane(tid >> 6), r = lane & 31, hh = lane >> 5;
    const lptr shm = (lptr)shm_;
    const int colh = h * 64 + lane;
    for (int e = tid; e < 64 * P / 4; e += 512) ((__attribute__((address_space(3))) unsigned*)(shm + L_ST))[e] = 0u;
    f32x16 S = {};
    const bool outw = w < 4; const int I = (w >> 1) & 1, vt = w & 1, dt = (w >> 1) & 1;
    float nlf[8]; unsigned short nq[8], nv[8];
    { const size_t m0 = (size_t)b * SEQ + 8 * w;
#pragma unroll
      for (int i = 0; i < 8; ++i) { nlf[i] = LF[(m0 + i) * 256 + colh]; nq[i] = QA[(m0 + i) * 256 + colh]; nv[i] = IA[(m0 + i) * 256 + colh]; } }
    for (int c = 0; c < SEQ / 64; ++c) {
        const size_t row0 = (size_t)b * SEQ + c * 64;
        float l2[8]; unsigned short qv[8], vv[8];
#pragma unroll
        for (int i = 0; i < 8; ++i) { l2[i] = nlf[i]; qv[i] = nq[i]; vv[i] = nv[i]; }
        float cs[8]; { float s = 0.f;
#pragma unroll
            for (int i = 0; i < 8; ++i) { s += l2[i]; cs[i] = s; } }
        ((__attribute__((address_space(3))) float*)(shm + L_TOT))[w * 64 + lane] = cs[7];
        __syncthreads();
        float pre = 0.f, r1 = 0.f, blast = 0.f;
#pragma unroll
        for (int j = 0; j < 8; ++j) { const float t = ((__attribute__((address_space(3))) const float*)(shm + L_TOT))[j * 64 + lane]; if (j < w) pre += t; if (j < 4) r1 += t; blast += t; }
        const float er1 = __builtin_amdgcn_exp2f(r1), rI = (w >= 4) ? r1 : 0.f, e1 = (w >= 4) ? er1 : 1.0f, e2 = __builtin_amdgcn_exp2f(blast - rI);
        unsigned khp[4];
#pragma unroll
        for (int i = 0; i < 8; i += 2) {
            float kh2[2];
#pragma unroll
            for (int ii = 0; ii < 2; ++ii) {
                const int t = i + ii; const float bt = pre + cs[t]; const float f = __builtin_amdgcn_exp2f(l2[t]); const float k = 1.0f - f; const float q = __uint_as_float((unsigned)qv[t] << 16);
                const float qd = q * __builtin_amdgcn_exp2f(bt - rI), qh = qd * e1, kd = k * __builtin_amdgcn_exp2f(rI - bt);
                kh2[ii] = kd * e2;
                const int ro = (8 * w + t) * P + lane * 2;
                *(__attribute__((address_space(3))) unsigned short*)(shm + L_QD + ro) = cvt1(qd);
                *(__attribute__((address_space(3))) unsigned short*)(shm + L_QH + ro) = cvt1(qh);
                *(__attribute__((address_space(3))) unsigned short*)(shm + L_KD + ro) = cvt1(kd);
                if (w < 4) *(__attribute__((address_space(3))) unsigned short*)(shm + L_KO + ro) = cvt1(kd * er1);
            }
            khp[i >> 1] = cvtpk(kh2[0], kh2[1]);
        }
        *(__attribute__((address_space(3))) u32x4*)(shm + L_KHT + lane * P + w * 16) = (u32x4){khp[0], khp[1], khp[2], khp[3]};
        *(__attribute__((address_space(3))) u32x4*)(shm + L_VT + lane * P + w * 16) = (u32x4){(unsigned)vv[0] | ((unsigned)vv[1] << 16), (unsigned)vv[2] | ((unsigned)vv[3] << 16), (unsigned)vv[4] | ((unsigned)vv[5] << 16), (unsigned)vv[6] | ((unsigned)vv[7] << 16)};
        if (w == 0) ((__attribute__((address_space(3))) float*)(shm + L_EB))[lane] = __builtin_amdgcn_exp2f(blast);
        if (c + 1 < SEQ / 64) { const size_t m0 = row0 + 64 + 8 * w;
#pragma unroll
            for (int i = 0; i < 8; ++i) { nlf[i] = LF[(m0 + i) * 256 + colh]; nq[i] = QA[(m0 + i) * 256 + colh]; nv[i] = IA[(m0 + i) * 256 + colh]; } }
        __syncthreads();
        f32x16 OT = {}; u32x4 gt[2];
        if (outw) {
            { const unsigned short* gp = GA + (row0 + 32 * I + (lane >> 2)) * 256 + h * 64 + 32 * vt + (lane & 3) * 8;
              gt[0] = *(const u32x4*)gp; gt[1] = *(const u32x4*)(gp + 16 * 256); }
#pragma unroll
            for (int J = 0; J < 2; ++J) {
                if (J <= I) {
                    const bool diag = (J == I);
                    const lptr kb = diag ? (shm + L_KD + (32 * J + r) * P + hh * 16) : (shm + L_KO + r * P + hh * 16);
                    const lptr qb = shm + L_QD + (32 * I + r) * P + hh * 16;
                    f32x16 XT = {};
#pragma unroll
                    for (int kk = 0; kk < 4; ++kk) XT = HG_MFMA(*(__attribute__((address_space(3))) const bf16x8*)(kb + kk * 32), *(__attribute__((address_space(3))) const bf16x8*)(qb + kk * 32), XT);
                    if (diag) {
#pragma unroll
                        for (int g = 0; g < 16; ++g) if (crow(g, hh) > r) XT[g] = 0.f;
                    }
                    const lptr vb = shm + L_VT + (32 * vt + r) * P + (32 * J + 4 * hh) * 2;
#pragma unroll
                    for (int sp = 0; sp < 2; ++sp) {
                        const u32x4 xb = {cvtpk(XT[8 * sp], XT[8 * sp + 1]), cvtpk(XT[8 * sp + 2], XT[8 * sp + 3]), cvtpk(XT[8 * sp + 4], XT[8 * sp + 5]), cvtpk(XT[8 * sp + 6], XT[8 * sp + 7])};
                        const u32x2 a0 = *(__attribute__((address_space(3))) const u32x2*)(vb + sp * 32), a1 = *(__attribute__((address_space(3))) const u32x2*)(vb + sp * 32 + 16);
                        const u32x4 av = {a0[0], a0[1], a1[0], a1[1]};
                        OT = HG_MFMA(__builtin_bit_cast(bf16x8, av), __builtin_bit_cast(bf16x8, xb), OT);
                    }
                }
            }
            { const lptr sb = shm + L_ST + (32 * vt + r) * P + hh * 16; const lptr qb = shm + L_QH + (32 * I + r) * P + hh * 16;
#pragma unroll
              for (int kk = 0; kk < 4; ++kk) OT = HG_MFMA(*(__attribute__((address_space(3))) const bf16x8*)(sb + kk * 32), *(__attribute__((address_space(3))) const bf16x8*)(qb + kk * 32), OT); }
            float s = 0.f;
#pragma unroll
            for (int g = 0; g < 16; ++g) s += OT[g] * OT[g];
            s += __shfl_xor(s, 32);
            if (hh == 0) ((__attribute__((address_space(3))) float*)(shm + L_SS))[(I * 2 + vt) * 32 + r] = s;
        } else {
#pragma unroll
            for (int g = 0; g < 4; ++g) { const f32x4 e = *(__attribute__((address_space(3))) const f32x4*)(shm + L_EB + (32 * dt + 8 * g + 4 * hh) * 4);
                S[4 * g] *= e[0]; S[4 * g + 1] *= e[1]; S[4 * g + 2] *= e[2]; S[4 * g + 3] *= e[3]; }
            const lptr ka = shm + L_KHT + (32 * dt + r) * P + hh * 16; const lptr vb = shm + L_VT + (32 * vt + r) * P + hh * 16;
#pragma unroll
            for (int kk = 0; kk < 4; ++kk) S = HG_MFMA(*(__attribute__((address_space(3))) const bf16x8*)(ka + kk * 32), *(__attribute__((address_space(3))) const bf16x8*)(vb + kk * 32), S);
        }
        __syncthreads();
        if (outw) {
            const float ss = ((__attribute__((address_space(3))) const float*)(shm + L_SS))[(I * 2) * 32 + r] + ((__attribute__((address_space(3))) const float*)(shm + L_SS))[(I * 2 + 1) * 32 + r];
            const float rstd = rsqrtf(ss * (1.0f / 64.0f) + NORM_EPS);
            const lptr so = shm + L_STG + w * (32 * SPH) + r * SPH + (4 * hh) * 2;
#pragma unroll
            for (int g = 0; g < 4; ++g) {
                const float y0 = OT[4 * g] * rstd, y1 = OT[4 * g + 1] * rstd, y2 = OT[4 * g + 2] * rstd, y3 = OT[4 * g + 3] * rstd;
                *(__attribute__((address_space(3))) u32x2*)(so + 16 * g) = (u32x2){cvtpk(y0, y1), cvtpk(y2, y3)}; }
            asm volatile("s_waitcnt lgkmcnt(0)" ::: "memory");
            const lptr si = shm + L_STG + w * (32 * SPH) + (lane >> 2) * SPH + (lane & 3) * 16; unsigned short* op = MIX + (row0 + 32 * I + (lane >> 2)) * DM + h * 64 + 32 * vt + (lane & 3) * 8;
#pragma unroll
            for (int i = 0; i < 2; ++i) { const u32x4 v = *(__attribute__((address_space(3))) const u32x4*)(si + i * 16 * SPH); const u32x4 gg = gt[i]; u32x4 o;
#pragma unroll
                for (int e = 0; e < 4; ++e) o[e] = cvtpk(__uint_as_float(v[e] << 16) * __uint_as_float(gg[e] << 16), __uint_as_float(v[e] & 0xffff0000u) * __uint_as_float(gg[e] & 0xffff0000u));
                *(u32x4*)(op + (size_t)i * 16 * DM) = o; }
        } else {
            const lptr sp = shm + L_ST + (32 * vt + r) * P + (32 * dt + 4 * hh) * 2;
#pragma unroll
            for (int g = 0; g < 4; ++g) *(__attribute__((address_space(3))) u32x2*)(sp + 16 * g) = (u32x2){cvtpk(S[4 * g], S[4 * g + 1]), cvtpk(S[4 * g + 2], S[4 * g + 3])};
        }
    }
}
#undef HG_MFMA
}
namespace pl {
typedef __attribute__((address_space(3))) unsigned char* lptr;
typedef short bf16x8 __attribute__((ext_vector_type(8)));
typedef float f32x16 __attribute__((ext_vector_type(16)));
typedef float f32x4 __attribute__((ext_vector_type(4)));
typedef unsigned u32x4 __attribute__((ext_vector_type(4)));
typedef unsigned u32x2 __attribute__((ext_vector_type(2)));
constexpr int UP = 528, L_U = 0, L_P = 80 * UP, PP = 144, L_STG = L_P + 4 * 64 * PP, SP = 144, L_END = L_STG + 8 * 32 * SP;
__device__ __forceinline__ float lo16(unsigned x) { return __uint_as_float(x << 16); }
__device__ __forceinline__ float hi16(unsigned x) { return __uint_as_float(x & 0xffff0000u); }
__device__ __forceinline__ void pool_item(int b, int tbeg, int ntile, const unsigned short* UB, const unsigned short* GB, const unsigned short* PWT, const float* pscale, unsigned short* MIX, unsigned char* shm_) {
    int tid_ = threadIdx.x; asm volatile("" : "+v"(tid_));
    const int tid = tid_, lane = tid & 63, w = __builtin_amdgcn_readfirstlane(tid >> 6), r = lane & 31, hh = lane >> 5;
    const lptr shm = (lptr)shm_;
    const int g = w >> 1, tt = w & 1;
    u32x4 uv[5]; u32x4 gtn[4];
#define PL_LOAD(T0) do { _Pragma("unroll") for (int i = 0; i < 5; ++i) { const int e = tid + 512 * i, j = e >> 5, ch = e & 31; const int t = (T0) - 16 + j; \
        uv[i] = (u32x4){0u, 0u, 0u, 0u}; if (t >= 0) uv[i] = *(const u32x4*)(UB + ((size_t)b * SEQ + t) * 256 + ch * 8); } \
      const unsigned short* gp_ = GB + ((size_t)b * SEQ + (T0) + 32 * tt + (lane >> 3)) * 256 + g * 64 + (lane & 7) * 8; \
      _Pragma("unroll") for (int i = 0; i < 4; ++i) gtn[i] = *(const u32x4*)(gp_ + (size_t)i * 8 * 256); } while (0)
    PL_LOAD(tbeg);
    bf16x8 wa[2][4];
#pragma unroll
    for (int dt = 0; dt < 2; ++dt)
#pragma unroll
        for (int kk = 0; kk < 4; ++kk) wa[dt][kk] = *(const bf16x8*)(PWT + ((size_t)g * 64 + 32 * dt + r) * 64 + kk * 16 + hh * 8);
    for (int ti = 0; ti < ntile; ++ti) {
    const int t0 = tbeg + 64 * ti; const size_t row0 = (size_t)b * SEQ + t0;
    u32x4 gt[4];
#pragma unroll
    for (int i = 0; i < 4; ++i) gt[i] = gtn[i];
#pragma unroll
    for (int i = 0; i < 5; ++i) { const int e = tid + 512 * i, j = e >> 5, ch = e & 31; *(__attribute__((address_space(3))) u32x4*)(shm + L_U + j * UP + ch * 16) = uv[i]; }
    __syncthreads();
    if (ti + 1 < ntile) PL_LOAD(t0 + 64);
    { const int cp = tid & 127, qtr = tid >> 7, gg = cp >> 5, win = 2 << gg, tl0 = 16 * qtr;
      const lptr up = shm + L_U + cp * 4; const lptr pp = shm + L_P + gg * 64 * PP + (cp & 31) * 4;
      float s0 = 0.f, s1 = 0.f;
      for (int j = 0; j < win; ++j) { const unsigned x = *(__attribute__((address_space(3))) const unsigned*)(up + (16 + tl0 - j) * UP); s0 += lo16(x); s1 += hi16(x); }
      const float rw = 1.0f / (float)win;
#pragma unroll 4
      for (int i = 0; i < 16; ++i) { const int tl = tl0 + i; const unsigned x = *(__attribute__((address_space(3))) const unsigned*)(up + (16 + tl) * UP);
          const int ta = t0 + tl + 1; const float rc = ta < win ? __builtin_amdgcn_rcpf((float)ta) : rw;
          *(__attribute__((address_space(3))) unsigned*)(pp + tl * PP) = hg::cvtpk(s0 * rc - lo16(x), s1 * rc - hi16(x));
          const unsigned xn = *(__attribute__((address_space(3))) const unsigned*)(up + (17 + tl) * UP), xo = *(__attribute__((address_space(3))) const unsigned*)(up + (17 + tl - win) * UP);
          s0 += lo16(xn) - lo16(xo); s1 += hi16(xn) - hi16(xo); } }
    __syncthreads();
    { const lptr pb = shm + L_P + g * 64 * PP + (32 * tt + r) * PP + hh * 16;
      bf16x8 pf[4];
#pragma unroll
      for (int kk = 0; kk < 4; ++kk) pf[kk] = *(__attribute__((address_space(3))) const bf16x8*)(pb + kk * 32);
#pragma unroll
      for (int dt = 0; dt < 2; ++dt) {
          f32x16 acc = {};
#pragma unroll
          for (int kk = 0; kk < 4; ++kk) acc = __builtin_amdgcn_mfma_f32_32x32x16_bf16(wa[dt][kk], pf[kk], acc, 0, 0, 0);
          const lptr so = shm + L_STG + w * (32 * SP) + r * SP + (32 * dt + 4 * hh) * 2;
#pragma unroll
          for (int q = 0; q < 4; ++q)
              *(__attribute__((address_space(3))) u32x2*)(so + 16 * q) = (u32x2){hg::cvtpk(acc[4 * q], acc[4 * q + 1]), hg::cvtpk(acc[4 * q + 2], acc[4 * q + 3])};
      }
      asm volatile("s_waitcnt lgkmcnt(0)" ::: "memory");
      { const lptr si = shm + L_STG + w * (32 * SP) + (lane >> 3) * SP + (lane & 7) * 16; unsigned short* op = MIX + (row0 + 32 * tt + (lane >> 3)) * DM + 256 + g * 64 + (lane & 7) * 8;
#pragma unroll
        for (int i = 0; i < 4; ++i) { const u32x4 v = *(__attribute__((address_space(3))) const u32x4*)(si + i * 8 * SP); const u32x4 gg = gt[i]; u32x4 o;
#pragma unroll
            for (int e = 0; e < 4; ++e) o[e] = hg::cvtpk(lo16(v[e]) * lo16(gg[e]), hi16(v[e]) * hi16(gg[e]));
            *(u32x4*)(op + (size_t)i * 8 * DM) = o; } }
    }
    }
#undef PL_LOAD
}
}
#define XB_TMO      128
#define XB_XCNT(j)  (256  + 64 * (j))
#define XB_XSUB(j)  (1280 + 64 * (j))
#define XB_XGEN(j)  (2304 + 64 * (j))
#define XB_TOP      3328
#define XB_TOPGEN   3392
#define XCD_BAR_WORDS 3456
#define XB_SPIN_CAP (1u << 18)

__device__ __forceinline__ unsigned xb_ld(unsigned* p)              { return __hip_atomic_load(p, __ATOMIC_RELAXED, __HIP_MEMORY_SCOPE_AGENT); }
__device__ __forceinline__ unsigned xb_add(unsigned* p, unsigned v) { return __hip_atomic_fetch_add(p, v, __ATOMIC_RELAXED, __HIP_MEMORY_SCOPE_AGENT); }
__device__ __forceinline__ unsigned xb_xcc_id() { return (unsigned)__builtin_amdgcn_s_getreg((3 << 11) | 20) & 0xFu; }
#define XB_SPIN(cond, bar) do { unsigned _sp = 0; while (cond) { __builtin_amdgcn_s_sleep(1); \
    if ((++_sp & 255u) == 0u) { if (xb_ld(&(bar)[XB_TMO])) break; if (_sp > XB_SPIN_CAP) { atomicAdd(&(bar)[XB_TMO], 1u); break; } } } } while (0)

struct XcdBarrier {
    unsigned* bar; unsigned x;
    volatile LAS unsigned* st;
};

__device__ __forceinline__ XcdBarrier xcd_barrier_post(unsigned* bar, volatile LAS unsigned* st) {
    XcdBarrier b; b.bar = bar; b.x = xb_xcc_id(); b.st = st;
    if (threadIdx.x == 0) (void)xb_add(&bar[XB_XCNT(b.x)], 1u);
    return b;
}
__device__ __forceinline__ void xcd_barrier_complete(unsigned* bar, unsigned x, unsigned& nloc, unsigned& nx) {
    const unsigned G = gridDim.x * gridDim.y * gridDim.z;
    unsigned sum, cnt, mine, sp = 0u;
    for (;;) {
        sum = 0u; cnt = 0u; mine = 0u;
#pragma unroll
        for (unsigned j = 0; j < 16; ++j) { const unsigned c = xb_ld(&bar[XB_XCNT(j)]); sum += c; cnt += (c > 0u) ? 1u : 0u; mine = (j == x) ? c : mine; }
        if (sum == G) break;
        __builtin_amdgcn_s_sleep(1);
        if ((++sp & 255u) == 0u) { if (xb_ld(&bar[XB_TMO])) break; if (sp > XB_SPIN_CAP) { atomicAdd(&bar[XB_TMO], 1u); break; } }
    }
    nloc = mine > 0u ? mine : 1u; nx = cnt > 0u ? cnt : 1u;
}

__device__ __forceinline__ void xcd_barrier(const XcdBarrier& b) {
    asm volatile("s_waitcnt vmcnt(0)" ::: "memory");
    __syncthreads();
    if (threadIdx.x == 0) {
        unsigned* bar = b.bar;
        __builtin_amdgcn_s_waitcnt(0);
        unsigned nloc = b.st[0], nx = b.st[1];
        if (nloc == 0u) { xcd_barrier_complete(bar, b.x, nloc, nx); b.st[0] = nloc; b.st[1] = nx; }
        const unsigned old = xb_add(&bar[XB_XSUB(b.x)], 1u);
        const unsigned gen = old / nloc;
        if (old + 1u == (gen + 1u) * nloc) {
            __builtin_amdgcn_fence(__ATOMIC_RELEASE, "agent");
            asm volatile("s_waitcnt vmcnt(0)" ::: "memory");
            const unsigned og = xb_add(&bar[XB_TOP], 1u);
            const unsigned tg = og / nx;
            if (og + 1u == (tg + 1u) * nx) xb_add(&bar[XB_TOPGEN], 1u);
            else XB_SPIN(xb_ld(&bar[XB_TOPGEN]) == tg, bar);
            __builtin_amdgcn_fence(__ATOMIC_ACQUIRE, "agent");
            xb_add(&bar[XB_XGEN(b.x)], 1u);
            asm volatile("s_waitcnt vmcnt(0)" ::: "memory");
        } else {
            XB_SPIN(xb_ld(&bar[XB_XGEN(b.x)]) == gen, bar);
            __builtin_amdgcn_fence(__ATOMIC_ACQUIRE, "agent");
            asm volatile("s_waitcnt vmcnt(0)" ::: "memory");
        }
    }
    __syncthreads();
}
#ifndef PROBE_REP_IN
#define PROBE_REP_IN 1
#endif
#ifndef PROBE_REP_OUT
#define PROBE_REP_OUT 1
#endif
#ifndef PROBE_REP_MIX
#define PROBE_REP_MIX 1
#endif
#ifndef PROBE_ID
#define PROBE_ID 0
#endif
#ifndef PROBE_OFS
#define PROBE_OFS 60.0f
#endif
constexpr int CW_PROBE = 3072;
#if PROBE_ID != 0
#define PROBE_T0(k) unsigned long long tp0_ = 0; if ((k) == PROBE_ID - 1) tp0_ = __builtin_amdgcn_s_memrealtime()
#define PROBE_T1(k) do { if ((k) == PROBE_ID - 1 && blockIdx.x == 0 && threadIdx.x == 0) __hip_atomic_fetch_max(F.ctl + CW_PROBE, (unsigned)(__builtin_amdgcn_s_memrealtime() - tp0_), RLX_AGENT); } while (0)
#else
#define PROBE_T0(k) do {} while (0)
#define PROBE_T1(k) do {} while (0)
#endif
constexpr int NWAVES = 8;
constexpr int RING_OFF = 0, RING_BYTES = 131072;
constexpr int LDSCTL_OFF = RING_BYTES, MISC_OFF = LDSCTL_OFF + 320;
constexpr int RS_LDS = RING_BYTES + 1024;
constexpr int LDS_BYTES = 147456;
constexpr int CW_TMO = 0, CW_CODE = 1, CW_Q = 2048, CW_BAR = 4096, CW_QM = 8192, CW_KM = 8192 + 2048;
constexpr size_t CTL_ZERO_BYTES = 65536;
constexpr int N_PHASES = 9;

struct Frame {
    LAS unsigned char* lds; volatile LAS unsigned* MISC; gu32* ctl;
    int wave, vcu, G;
};

struct TItem { const float* W; const float* gain; bf16* WT; int ldw, nblk, item; bool swap45; };
__device__ __forceinline__ void p0_transpose_load(const TItem& T, int lane, float (&t)[32]) {
    const int kb = T.item / T.nblk, nb = T.item % T.nblk, k0 = 64 * kb, n0 = 32 * nb;
#pragma unroll
    for (int i = 0; i < 32; ++i) { const int kk = 2 * i + (lane >> 5); t[i] = T.W[(size_t)(k0 + kk) * T.ldw + n0 + (lane & 31)]; }
}
__device__ __forceinline__ void p0_transpose_finish(const TItem& T, const float (&t)[32], LAS float* scr, int lane) {
    constexpr int K = DM;
    const int kb = T.item / T.nblk, nb = T.item % T.nblk, k0 = 64 * kb, n0 = 32 * nb;
    const int nd0 = (T.swap45 && n0 >= 1024 && n0 < 1536) ? (n0 ^ 256) : n0;
#pragma unroll
    for (int i = 0; i < 32; ++i) { const int kk = 2 * i + (lane >> 5); scr[kk * 33 + (lane & 31)] = t[i]; }
    LDS_WAIT(); asm volatile("" ::: "memory");
    const int c = lane & 7;
    f32x4 g0 = {1.f, 1.f, 1.f, 1.f}, g1 = g0; if (T.gain) { g0 = *(const f32x4*)(T.gain + k0 + 8 * c); g1 = *(const f32x4*)(T.gain + k0 + 8 * c + 4); }
#pragma unroll
    for (int j = 0; j < 4; ++j) { const int n = (lane >> 3) + 8 * j; const LAS float* s = scr + (8 * c) * 33 + n;
        v4u o; o.x = pk2(s[0 * 33] * g0.x, s[1 * 33] * g0.y); o.y = pk2(s[2 * 33] * g0.z, s[3 * 33] * g0.w); o.z = pk2(s[4 * 33] * g1.x, s[5 * 33] * g1.y); o.w = pk2(s[6 * 33] * g1.z, s[7 * 33] * g1.w);
        *(GAS v4u*)(T.WT + (size_t)(nd0 + n) * K + k0 + 8 * c) = o; }
    LDS_WAIT(); asm volatile("" ::: "memory");
}
constexpr int WFC_LDS = 98304;
template <class T> __device__ __forceinline__ T* opq(T* p) { GAS T* g = (GAS T*)p; asm volatile("" : "+s"(g)); return (T*)g; }
__device__ __forceinline__ int opaque_tid() { int t = threadIdx.x; asm volatile("" : "+v"(t)); return t; }
__device__ __forceinline__ void stage_wfc(Frame& F, const float* w_in_l, const float* gain, int tid) {
    LAS float* wf = (LAS float*)(F.lds + WFC_LDS);
    for (int e = tid; e < 8192; e += NWAVES * 64) { const int k = e >> 3, h = e & 7; wf[h * 1024 + k] = w_in_l[(size_t)k * NIN + 3584 + h] * gain[k]; }
}
__device__ __forceinline__ void fc_row(Frame& F, const f32x4 (&v)[4], float scale, const float* fbias, float* lfc_row, int lane) {
    const LAS float* wf = (const LAS float*)(F.lds + WFC_LDS);
    float s[8];
#pragma unroll
    for (int h = 0; h < 8; ++h) { f32x2v a = {0.f, 0.f};
#pragma unroll
        for (int j = 0; j < 4; ++j) { const f32x4 w = *(const LAS f32x4*)(wf + h * 1024 + 256 * j + 4 * lane); a = lo2(v[j]) * lo2(w) + a; a = hi2(v[j]) * hi2(w) + a; }
        s[h] = a.x + a.y; }
    float t[4], u[2];
#pragma unroll
    for (int j = 0; j < 4; ++j) { auto r = __builtin_amdgcn_permlane32_swap(__float_as_uint(s[j]), __float_as_uint(s[j + 4]), false, false); t[j] = __uint_as_float(r[0]) + __uint_as_float(r[1]); }
#pragma unroll
    for (int j = 0; j < 2; ++j) { auto r = __builtin_amdgcn_permlane16_swap(__float_as_uint(t[j]), __float_as_uint(t[j + 2]), false, false); u[j] = __uint_as_float(r[0]) + __uint_as_float(r[1]); }
    const bool b3 = (lane & 8) != 0;
    const float keep = b3 ? u[1] : u[0], send = b3 ? u[0] : u[1];
    float tot = keep + __uint_as_float(__builtin_amdgcn_update_dpp(0u, __float_as_uint(send), 0x128, 0xf, 0xf, false));
    tot = dpp_add<0xB1>(tot); tot = dpp_add<0x4E>(tot); tot = dpp_add<0x141>(tot);
    if ((lane & 7) == 0) { const int h = lane >> 3; lfc_row[h] = logsigmoidf_(tot * scale + fbias[h]); }
}
__device__ __forceinline__ float bfround(float f) { return __uint_as_float(f2bf(f) << 16); }
__device__ __forceinline__ void cumsum_wave(const float* LFC, float* CC, int bh, int lane) {
    const int b = bh >> 3, h = bh & 7;
    float loc[32]; float s = 0.f;
#pragma unroll
    for (int i = 0; i < 32; ++i) { s += LFC[((size_t)b * SEQ + lane * 32 + i) * 8 + h]; loc[i] = s; }
    float incl = s;
#pragma unroll
    for (int o = 1; o < 64; o <<= 1) { const float t = __shfl_up(incl, o); if (lane >= o) incl += t; }
    const float excl = incl - s;
#pragma unroll
    for (int i = 0; i < 32; i += 4) *(f32x4*)(CC + (size_t)bh * SEQ + lane * 32 + i) = (f32x4){excl + loc[i], excl + loc[i + 1], excl + loc[i + 2], excl + loc[i + 3]};
}
constexpr int T_I_IN = 16 * 112, T_I_OUT = 16 * 32, T_ITEMS = T_I_IN + T_I_OUT;
__device__ __forceinline__ TItem transpose_item_of(int l, int r, const float* w_in, const float* w_out, const float* pre_g, const float* hgrn_g, unsigned char* ws) { TItem T;
    if (r < T_I_IN) { T.W = w_in + (size_t)l * DM * NIN; T.gain = pre_g + l * DM; T.WT = (bf16*)(ws + WS_WIN + l * 8 * MiB); T.ldw = NIN; T.nblk = 112; T.item = r; T.swap45 = true; }
    else { T.W = w_out + (size_t)l * DM * DM; T.gain = (64 * ((r - T_I_IN) / 32) < 256) ? hgrn_g + l * 256 : nullptr; T.WT = (bf16*)(ws + WS_WOUT + l * 2 * MiB); T.ldw = DM; T.nblk = 32; T.item = r - T_I_IN; T.swap45 = false; }
    return T; }
constexpr int Q_TITEMS = T_ITEMS / 16;
struct Args { const float* in[10]; float* out; unsigned char* ws; int ph_lo, ph_hi, li, pad; };

#define GRID_BAR() do { XcdBarrier b_ = bar; asm volatile("" : "+s"(b_.bar), "+s"(b_.x)); xcd_barrier(b_); } while (0)
#define IN(k) (lo <= (k) && (k) < hi)
#define BOTH(k) (IN(k) && IN((k) + 1))
template <int l> __device__ __forceinline__ void layer_phases(const Args& args, Frame& F, const XcdBarrier& bar, unsigned char* lds, int lo, int hi, int gw, int NGW) {
        const int pb = 1 + 4 * l;
        if (IN(pb)) { PROBE_T0(pb);
            unsigned char* ws = opq(args.ws); bf16* XN = (bf16*)(ws + (l == 0 ? WS_XN : WS_X1));
            if (gw < BATCH * 8) cumsum_wave((const float*)(ws + WS_LFC), (float*)(ws + WS_CC), gw, opaque_tid() & 63);
            pg8::Gemm g{XN, (const bf16*)(ws + WS_WIN + l * 8 * MiB), M, 3584, DM}; pg8::StaticOrder S; S.init(M, 3584, F.G, (int)blockIdx.x);
            pg8::EpiIn E{ws, (const float*)(ws + WS_LBS) + l * 256, (const float*)(ws + WS_RS) + (size_t)l * M, (LAS float*)(F.lds + RS_LDS), (unsigned*)(F.ctl + CW_QM + l * 1024), (unsigned*)(F.ctl + CW_KM + l * 128)};
            for (int rep_ = 0; rep_ < PROBE_REP_IN; ++rep_) pg8::gemm_phase<pg8::EpiIn, pg8::StaticOrder, true, true>(F.lds + RING_OFF, g, S, E);
            if (BOTH(pb)) GRID_BAR();
            PROBE_T1(pb);
        }
        if (IN(pb + 1)) { PROBE_T0(pb + 1);
            unsigned char* ws = opq(args.ws); bf16* MIX = (bf16*)(ws + WS_MIX);
            for (int rep_ = 0; rep_ < PROBE_REP_MIX; ++rep_) {
            constexpr int QEND = 64 + 128 + 1024 + (l + 1 < DEPTH ? Q_TITEMS : 0);
            gu32* qctr = F.ctl + CW_Q + 64 * (l + 2 * rep_); volatile LAS unsigned* slot = F.MISC + 16;
            for (int par = 0;; par ^= 1) {
                if (threadIdx.x == 0) slot[par] = __hip_atomic_fetch_add(qctr, 1u, RLX_AGENT);
                __syncthreads();
                const int idx = __builtin_amdgcn_readfirstlane((int)slot[par]);
                if (idx >= QEND) break;
                if (idx >= 64 + 128 + 1024) { const int q = idx - (64 + 128 + 1024); int ln = opaque_tid() & 63;
                    LAS float* scr = (LAS float*)(F.lds + RING_OFF + F.wave * 8448); float ta[32], tb[32];
                    const TItem Ta = transpose_item_of(l + 1, q * 16 + F.wave, args.in[3], args.in[8], args.in[2], args.in[4], ws), Tb = transpose_item_of(l + 1, q * 16 + 8 + F.wave, args.in[3], args.in[8], args.in[2], args.in[4], ws);
                    p0_transpose_load(Ta, ln, ta); p0_transpose_load(Tb, ln, tb); p0_transpose_finish(Ta, ta, scr, ln); p0_transpose_finish(Tb, tb, scr, ln); }
                else if (idx < 64) hg::hgrn_item(idx >> 2, idx & 3, (const bf16*)(ws + WS_QA), (const float*)(ws + WS_LF), (const bf16*)(ws + WS_IA), (const bf16*)(ws + WS_GA), args.in[4] + l * 256, MIX, lds + RING_OFF);
                else if (idx < 64 + 128) { const int p = idx - 64;
                    pl::pool_item(p >> 3, (p & 7) * 256, 4, (const bf16*)(ws + WS_UB), (const bf16*)(ws + WS_GB), (const bf16*)(ws + WS_PWT) + l * 4 * 64 * 64, args.in[7] + l * 256, MIX, lds + RING_OFF); }
                else { const int j = idx - 64 - 128, qb = 7 - (j >> 7), bh = j & 127;
                    attn_body::attn_unit<8>(bh >> 3, bh & 7, qb, (const attn_body::bf16*)(ws + WS_QC), (const attn_body::bf16*)(ws + WS_KC), (const attn_body::bf16*)(ws + WS_VC), (const attn_body::bf16*)(ws + WS_GC), (const float*)(ws + WS_CC), __uint_as_float(F.ctl[CW_QM + l * 1024 + bh * 8 + qb]), __uint_as_float(F.ctl[CW_KM + l * 128 + bh]), (attn_body::bf16*)MIX, (char*)lds + RING_OFF); }
            }
            if (rep_ + 1 < PROBE_REP_MIX) GRID_BAR();
            }
            if (BOTH(pb + 1)) GRID_BAR();
            PROBE_T1(pb + 1);
        }
        if (IN(pb + 2)) { PROBE_T0(pb + 2);
            unsigned char* ws = opq(args.ws); bf16* MIX = (bf16*)(ws + WS_MIX); bf16* Y = (bf16*)(ws + WS_Y);
            pg8::Gemm g{MIX, (const bf16*)(ws + WS_WOUT + l * 2 * MiB), M, DM, DM}; pg8::StaticOrder S; S.init(M, DM, F.G, (int)blockIdx.x);
            pg8::EpiY E{Y, DM};
            for (int rep_ = 0; rep_ < PROBE_REP_OUT; ++rep_) pg8::gemm_phase<pg8::EpiY, pg8::StaticOrder, true, true>(F.lds + RING_OFF, g, S, E);
            if (BOTH(pb + 2)) GRID_BAR();
            PROBE_T1(pb + 2);
        }
        if (IN(pb + 3)) { PROBE_T0(pb + 3);
            const int tid = opaque_tid(), lane = tid & 63;
            unsigned char* ws = opq(args.ws); const float* x = args.in[0]; const float* pre_g = args.in[2]; const float* w_in = args.in[3]; const float* fbias = args.in[5]; const float* post_g = args.in[9]; float* out = args.out;
            const bf16* Y = (const bf16*)(ws + WS_Y); float* LFC = (float*)(ws + WS_LFC); float* RS = (float*)(ws + WS_RS) + (size_t)(l + 1) * M;
            const bool more = l + 1 < DEPTH;
            bf16* X1 = (bf16*)(ws + WS_X1); const bf16* XR = (const bf16*)(ws + (l == 0 ? WS_XN : WS_X1));
            typedef unsigned long long u64_t;
#define RP_LOAD(YY, XX, MR) do { const GAS u64_t* yr_ = (const GAS u64_t*)(Y + (size_t)(MR) * DM) + lane; const GAS u64_t* xr_ = (const GAS u64_t*)(XR + (size_t)(MR) * DM) + lane; \
                    _Pragma("unroll") for (int j = 0; j < 4; ++j) { YY[j] = __builtin_nontemporal_load(yr_ + 64 * j); XX[j] = __builtin_nontemporal_load(xr_ + 64 * j); } } while (0)
#define RP_COMP(YY, XX, MR) do { const int m = (MR); f32x4 v[4]; float ss = 0.f; \
                    _Pragma("unroll") for (int j = 0; j < 4; ++j) { const unsigned ylo = (unsigned)YY[j], yhi = (unsigned)(YY[j] >> 32); \
                        v[j] = (f32x4){__uint_as_float(ylo << 16), __uint_as_float(ylo & 0xffff0000u), __uint_as_float(yhi << 16), __uint_as_float(yhi & 0xffff0000u)}; ss = ssq4(v[j], ss); } \
                    const float rstd = rsqrtf(wave_sum(ss) * (1.f / DM) + NORM_EPS); \
                    float s2 = 0.f; \
                    _Pragma("unroll") for (int j = 0; j < 4; ++j) { const unsigned xlo = (unsigned)XX[j], xhi = (unsigned)(XX[j] >> 32); \
                        const f32x4 xv_ = {__uint_as_float(xlo << 16), __uint_as_float(xlo & 0xffff0000u), __uint_as_float(xhi << 16), __uint_as_float(xhi & 0xffff0000u)}; \
                        v[j] = xv_ + v[j] * rstd * *((const f32x4*)(post_g + l * DM) + 64 * j + lane); \
                        s2 = ssq4(v[j], s2); \
                        if (more) *((GAS u64_t*)(X1 + (size_t)m * DM) + 64 * j + lane) = (u64_t)pk2(v[j].x, v[j].y) | ((u64_t)pk2(v[j].z, v[j].w) << 32);     \
                        else __builtin_nontemporal_store(v[j], (GAS f32x4*)(out + (size_t)m * DM) + 64 * j + lane); } \
                    if (more) { const float r2 = rsqrtf(wave_sum(s2) * (1.f / DM) + NORM_EPS); \
                        RS[m] = r2;                                      \
                        fc_row(F, v, r2, fbias + (l + 1) * 8, LFC + (size_t)m * 8, lane); } } while (0)
            u64_t ya[4], xa[4], yb[4], xb[4];
            RP_LOAD(ya, xa, gw);
            if (more) { stage_wfc(F, w_in + (size_t)(l + 1) * DM * NIN, pre_g + (l + 1) * DM, tid); __syncthreads(); }
            if (M % (2 * NGW) == 0) {
                for (int m0 = gw; m0 < M; m0 += 2 * NGW) {
                    const int m1 = m0 + NGW; int m2 = m1 + NGW; if (m2 >= M) m2 = m1;
                    RP_LOAD(yb, xb, m1);
                    RP_COMP(ya, xa, m0);
                    RP_LOAD(ya, xa, m2);
                    RP_COMP(yb, xb, m1);
                }
            } else {
                for (int m0 = gw; m0 < M; m0 += NGW) { if (m0 != gw) RP_LOAD(ya, xa, m0); RP_COMP(ya, xa, m0); }
            }
#undef RP_LOAD
#undef RP_COMP
            if (BOTH(pb + 3)) GRID_BAR();
            PROBE_T1(pb + 3);
#if PROBE_ID != 0
            if (l == DEPTH - 1 && blockIdx.x == 0) { asm volatile("s_waitcnt vmcnt(0)" ::: "memory"); __syncthreads();
                if (threadIdx.x == 0) args.out[0] += 0.01f * (float)__hip_atomic_load(F.ctl + CW_PROBE, RLX_AGENT) - PROBE_OFS; }
#endif
        }
}
__global__ void __launch_bounds__(NWAVES * 64, 2) fwd(Args args) {
    extern __shared__ __attribute__((aligned(16))) unsigned char lds[];
    Frame F;
    F.lds = (LAS unsigned char*)lds; F.MISC = (volatile LAS unsigned*)(F.lds + MISC_OFF);
    F.wave = __builtin_amdgcn_readfirstlane(threadIdx.x >> 6);
    F.G = gridDim.x; { const int bx = blockIdx.x; F.vcu = (F.G % 8 == 0) ? (bx % 8) * (F.G / 8) + bx / 8 : bx; }
    F.ctl = (gu32*)(args.ws + WS_CTL);
    for (int u = threadIdx.x; u < (LDS_BYTES - LDSCTL_OFF) / 4; u += NWAVES * 64) ((LAS unsigned*)(F.lds + LDSCTL_OFF))[u] = 0u;
    __syncthreads();
    XcdBarrier bar = xcd_barrier_post((unsigned*)(F.ctl + CW_BAR) + args.li * XCD_BAR_WORDS, F.MISC + 8);
    const int lo = args.ph_lo, hi = args.ph_hi;
    const int gw = F.vcu * NWAVES + F.wave, NGW = F.G * NWAVES;

    if (IN(0)) { PROBE_T0(0);
        const int tid = opaque_tid(), lane = tid & 63;
        unsigned char* ws = opq(args.ws); const float* x = args.in[0]; const float* lower = args.in[1]; const float* pre_g = args.in[2]; const float* w_in = args.in[3]; const float* fbias = args.in[5]; const float* pool_w = args.in[6]; const float* w_out = args.in[8];
        bf16* XN = (bf16*)(ws + WS_XN); float* LFC = (float*)(ws + WS_LFC); float* RS = (float*)(ws + WS_RS);
#define P0_LOAD(XX, MR) do { const GAS f32x4* xr_ = (const GAS f32x4*)(x + (size_t)(MR) * DM) + lane; _Pragma("unroll") for (int j = 0; j < 4; ++j) XX[j] = __builtin_nontemporal_load(xr_ + 64 * j); } while (0)
        f32x4 xa[4], xb[4];
        P0_LOAD(xa, gw);
        stage_wfc(F, w_in, pre_g, tid);
        __syncthreads();
        LAS float* scr = (LAS float*)(F.lds + RING_OFF + F.wave * 8448);
        constexpr int NITEMS = T_ITEMS;
        auto titem = [&](int it) { return transpose_item_of(0, it, w_in, w_out, pre_g, args.in[4], ws); };
        for (int it = gw; it < NITEMS; it += 3 * NGW) {
            float ta[32], tb[32], tc[32];
            const bool hb = it + NGW < NITEMS, hc = it + 2 * NGW < NITEMS;
            const TItem Ta = titem(it), Tb = titem(hb ? it + NGW : it), Tc = titem(hc ? it + 2 * NGW : it);
            p0_transpose_load(Ta, lane, ta); if (hb) p0_transpose_load(Tb, lane, tb); if (hc) p0_transpose_load(Tc, lane, tc);
            p0_transpose_finish(Ta, ta, scr, lane); if (hb) p0_transpose_finish(Tb, tb, scr, lane); if (hc) p0_transpose_finish(Tc, tc, scr, lane);
        }
        const int gt = F.vcu * NWAVES * 64 + tid, NGT = F.G * NWAVES * 64;
        for (int e = gt; e < 512; e += NGT) { const int l = e >> 8, j = e & 255; ((float*)(ws + WS_LBS))[e] = l == 0 ? 0.f : 1.f / (1.f + __expf(lower[j] - lower[256 + j])); }
        for (int e = gt; e < 2 * 4 * 64 * 64; e += NGT) { const int c = e & 63, d = (e >> 6) & 63, lg = e >> 12; ((bf16*)(ws + WS_PWT))[e] = f2bf(pool_w[((size_t)lg * 64 + c) * 64 + d] * args.in[7][(lg >> 2) * 256 + (lg & 3) * 64 + d]); }
#define P0_COMP(XX, MR) do { const int m = (MR); float ss = 0.f; \
            _Pragma("unroll") for (int j = 0; j < 4; ++j) { ss = ssq4(XX[j], ss); \
                *((GAS unsigned long long*)(XN + (size_t)m * DM) + 64 * j + lane) = (unsigned long long)pk2(XX[j].x, XX[j].y) | ((unsigned long long)pk2(XX[j].z, XX[j].w) << 32); }     \
            const float rstd = rsqrtf(wave_sum(ss) * (1.f / DM) + NORM_EPS); \
            RS[m] = rstd; \
            fc_row(F, XX, rstd, fbias, LFC + (size_t)m * 8, lane); } while (0)
        if (M % (2 * NGW) == 0) {
            for (int m0 = gw; m0 < M; m0 += 2 * NGW) {
                const int m1 = m0 + NGW; int m2 = m1 + NGW; if (m2 >= M) m2 = m1;
                P0_LOAD(xb, m1);
                P0_COMP(xa, m0);
                P0_LOAD(xa, m2);
                P0_COMP(xb, m1);
            }
        } else {
            for (int m0 = gw; m0 < M; m0 += NGW) { if (m0 != gw) P0_LOAD(xa, m0); P0_COMP(xa, m0); }
        }
#undef P0_LOAD
#undef P0_COMP
        if (BOTH(0)) GRID_BAR();
        PROBE_T1(0);
    }
    layer_phases<0>(args, F, bar, lds, lo, hi, gw, NGW);
    layer_phases<1>(args, F, bar, lds, lo, hi, gw, NGW);
}

static void launch_fwd(const Args& a0, int lo, int hi, int li, int grid, hipStream_t stream) {
    Args a = a0; a.ph_lo = lo; a.ph_hi = hi; a.li = li;
    hipLaunchKernelGGL(fwd, dim3(grid), dim3(NWAVES * 64), LDS_BYTES, stream, a);
}
extern "C" void kernel_launch(void* const* d_in, const int* in_sizes, int n_in, void* d_out, int out_size, void* d_ws, size_t ws_size, hipStream_t stream) {
    static int grid = 0;
    if (grid == 0) {
        if (n_in != 10 || in_sizes[0] != M * DM || out_size != M * DM || ws_size < WS_END) { fprintf(stderr, "kernel_launch: unexpected shapes / workspace (%zu < %zu)\n", ws_size, (size_t)WS_END); grid = -1; return; }
        int dev = 0, cus = 0, per_cu = 0;
        if (hipGetDevice(&dev) != hipSuccess || hipDeviceGetAttribute(&cus, hipDeviceAttributeMultiprocessorCount, dev) != hipSuccess) { grid = -1; return; }
        if (hipFuncSetAttribute((const void*)fwd, hipFuncAttributeMaxDynamicSharedMemorySize, LDS_BYTES) != hipSuccess) { fprintf(stderr, "kernel_launch: hipFuncSetAttribute failed\n"); grid = -1; return; }
        if (hipOccupancyMaxActiveBlocksPerMultiprocessor(&per_cu, (const void*)fwd, NWAVES * 64, LDS_BYTES) != hipSuccess || per_cu < 1) { fprintf(stderr, "kernel_launch: occupancy query says %d blocks per CU\n", per_cu); (void)hipGetLastError(); grid = -1; return; }
        grid = cus;
    }
    if (grid < 0) return;
    unsigned char* ws = (unsigned char*)d_ws;
    (void)hipMemsetAsync(ws + WS_CTL, 0, CTL_ZERO_BYTES, stream);
    Args a{};
    for (int i = 0; i < 10; ++i) a.in[i] = (const float*)d_in[i];
    a.out = (float*)d_out; a.ws = ws;
    launch_fwd(a, 0, N_PHASES, 0, grid, stream);
}
```
